# Optimizing an MI355X kernel written in HIP

```python
import jax, jax.numpy as jnp
from jax import lax
import numpy as np

D_MODEL = 2048
BATCH = 8
SEQ = 2048
DEPTH = 2

EPS = 1e-6
D_FF = 4 * D_MODEL
GLA_HEADS = 4
GLA_DK = 128
GLA_DV = 256
GLA_GATE_RANK = 16
GLA_GATE_TAU = 16.0
GLA_CHUNK = 64
MOBA_HEADS = 8
MOBA_HD = 128
MOBA_BLOCK = 256
MOBA_TOPK = 3
MOBA_Q_CHUNK = 16
FOX_HEADS = 8
FOX_HD = 128
FOX_Q_BLOCK = 128
HGRN_HEADS = 8
HGRN_DK = 128
HGRN_DV = 128
HGRN_CHUNK = 64
EVEN_SIZES = (GLA_HEADS * GLA_DK, GLA_HEADS * GLA_DK, GLA_HEADS * GLA_DV, GLA_HEADS * GLA_DV, GLA_GATE_RANK,
              MOBA_HEADS * MOBA_HD, MOBA_HEADS * MOBA_HD, MOBA_HEADS * MOBA_HD)
EVEN_IN = 4 * GLA_HEADS * GLA_DK // 2 + 2 * GLA_HEADS * GLA_DV + GLA_GATE_RANK + 3 * MOBA_HEADS * MOBA_HD
EVEN_MIX = GLA_HEADS * GLA_DV + MOBA_HEADS * MOBA_HD
ODD_SIZES = (FOX_HEADS * FOX_HD, FOX_HEADS * FOX_HD, FOX_HEADS * FOX_HD, FOX_HEADS,
             HGRN_HEADS * HGRN_DK, HGRN_HEADS * HGRN_DK, HGRN_HEADS * HGRN_DV, HGRN_HEADS * HGRN_DV)
ODD_IN = 3 * FOX_HEADS * FOX_HD + FOX_HEADS + 2 * HGRN_HEADS * HGRN_DK + 2 * HGRN_HEADS * HGRN_DV
ODD_MIX = FOX_HEADS * FOX_HD + HGRN_HEADS * HGRN_DV
N_EVEN = (DEPTH + 1) // 2
N_ODD = DEPTH // 2

kernel_name = "hybrid_gla_moba_fox_hgrn2_trunk"

F32 = jnp.float32


def rms_norm(x, g):
    xf = x.astype(F32)
    y = xf * lax.rsqrt(jnp.mean(xf * xf, axis=-1, keepdims=True) + EPS)
    return (y * g.astype(F32)).astype(x.dtype)


def _split(u, sizes):
    out, o = [], 0
    for s in sizes:
        out.append(u[..., o:o + s])
        o += s
    return out


def _heads(t, n):
    B, S, _ = t.shape
    return t.reshape(B, S, n, -1).transpose(0, 2, 1, 3)


def _merge(t):
    B, H, S, d = t.shape
    return t.transpose(0, 2, 1, 3).reshape(B, S, H * d)


def alibi_slopes(n):
    return jnp.exp2(-8.0 * jnp.arange(1, n + 1, dtype=F32) / n)


def chunked_gated_linear_attention(q, k, v, log_g, chunk):
    B, H, S, dk = q.shape
    dv = v.shape[-1]
    n = S // chunk

    def to_chunks(t):
        return jnp.moveaxis(t.reshape(B, H, n, chunk, t.shape[-1]), 2, 0)

    qc, kc, vc = to_chunks(q), to_chunks(k), to_chunks(v)
    bc = jnp.cumsum(to_chunks(log_g.astype(F32)), axis=3)
    causal = jnp.tril(jnp.ones((chunk, chunk), dtype=bool))

    def step(state, inp):
        q_, k_, v_, b_ = inp
        b_last = b_[:, :, -1:, :]
        o_inter = jnp.einsum('bhtd,bhde->bhte', q_ * jnp.exp(b_), state)
        diff = b_[:, :, :, None, :] - b_[:, :, None, :, :]
        decay = jnp.exp(jnp.where(causal[:, :, None], diff, -jnp.inf))
        scores = jnp.einsum('bhtd,bhsd,bhtsd->bhts', q_, k_, decay)
        o = o_inter + jnp.einsum('bhts,bhse->bhte', scores, v_)
        state = jnp.exp(b_last[:, :, 0, :, None]) * state + jnp.einsum(
            'bhsd,bhse->bhde', k_ * jnp.exp(b_last - b_), v_)
        return state, o

    init = jnp.zeros((B, H, dk, dv), F32)
    _, o = lax.scan(step, init, (qc, kc, vc, bc))
    return jnp.moveaxis(o, 0, 2).reshape(B, H, S, dv)


def gla_mixer(q, k, v, g, gate_lr, w2, b2, out_gain):
    qh = _heads(q, GLA_HEADS) * (GLA_DK ** -0.5)
    kh = _heads(k, GLA_HEADS)
    vh = _heads(v, GLA_HEADS)
    log_a = jax.nn.log_sigmoid((gate_lr @ w2 + b2).astype(F32)) / GLA_GATE_TAU
    o = chunked_gated_linear_attention(qh, kh, vh, _heads(log_a, GLA_HEADS), GLA_CHUNK)
    o = rms_norm(o, out_gain)
    return (_merge(o) * jax.nn.silu(g.astype(F32))).astype(g.dtype)


def moba_mixer(q, k, v):
    qh = _heads(q, MOBA_HEADS) * (MOBA_HD ** -0.5)
    kh = _heads(k, MOBA_HEADS)
    vh = _heads(v, MOBA_HEADS)
    B, H, S, d = qh.shape
    BLK, CQ = MOBA_BLOCK, MOBA_Q_CHUNK
    nb = -(-S // BLK)
    sp = nb * BLK
    pad = ((0, 0), (0, 0), (0, sp - S), (0, 0))
    qp, kp, vp = jnp.pad(qh, pad), jnp.pad(kh, pad), jnp.pad(vh, pad)
    kb = kp.reshape(B, H, nb, BLK, d)
    vb = vp.reshape(B, H, nb, BLK, d)
    k_mean = jnp.mean(kb.astype(F32), axis=3)
    qblk = jnp.arange(sp) // BLK
    gate = jnp.einsum('bhtd,bhnd->bhtn', qp.astype(F32), k_mean)
    past = jnp.arange(nb)[None, :] < qblk[:, None]
    gate = jnp.where(past, gate, -jnp.inf)
    topk = min(MOBA_TOPK, nb)
    _, sel = lax.top_k(gate, topk)
    slopes = alibi_slopes(H)
    sl5 = slopes.reshape(1, H, 1, 1, 1)
    sl4 = slopes.reshape(1, H, 1, 1)
    b_ix = jnp.arange(B)[:, None, None, None]
    h_ix = jnp.arange(H)[None, :, None, None]
    offs = jnp.arange(BLK)

    def chunk_attend(c):
        t0 = c * CQ
        t = t0 + jnp.arange(CQ)
        j = t0 // BLK
        q_c = lax.dynamic_slice_in_dim(qp, t0, CQ, axis=2)
        idx = lax.dynamic_slice_in_dim(sel, t0, CQ, axis=2)
        k_sel = kb[b_ix, h_ix, idx]
        v_sel = vb[b_ix, h_ix, idx]
        s_sel = idx[..., None] * BLK + offs
        logit_sel = (jnp.einsum('bhqd,bhqjkd->bhqjk', q_c, k_sel).astype(F32)
                     - sl5 * (t[:, None, None] - s_sel).astype(F32))
        logit_sel = jnp.where(idx[..., None] < j, logit_sel, -jnp.inf)
        k_own = lax.dynamic_slice_in_dim(kp, j * BLK, BLK, axis=2)
        v_own = lax.dynamic_slice_in_dim(vp, j * BLK, BLK, axis=2)
        s_own = j * BLK + offs
        logit_own = (jnp.einsum('bhqd,bhkd->bhqk', q_c, k_own).astype(F32)
                     - sl4 * (t[:, None] - s_own[None, :]).astype(F32))
        logit_own = jnp.where(s_own[None, :] <= t[:, None], logit_own, -jnp.inf)
        logits = jnp.concatenate([logit_sel.reshape(B, H, CQ, topk * BLK), logit_own], axis=-1)
        p = jax.nn.softmax(logits, axis=-1)
        p_sel = p[..., :topk * BLK].reshape(B, H, CQ, topk, BLK)
        p_own = p[..., topk * BLK:]
        return (jnp.einsum('bhqjk,bhqjke->bhqe', p_sel, v_sel)
                + jnp.einsum('bhqk,bhke->bhqe', p_own, v_own))

    o = lax.map(chunk_attend, jnp.arange(sp // CQ))
    o = jnp.moveaxis(o, 0, 2).reshape(B, H, sp, d)[:, :, :S]
    return o


def fox_mixer(q, k, v, f_logit, f_bias):
    qh = _heads(q, FOX_HEADS) * (FOX_HD ** -0.5)
    kh = _heads(k, FOX_HEADS)
    vh = _heads(v, FOX_HEADS)
    B, H, S, d = qh.shape
    log_f = jax.nn.log_sigmoid((f_logit + f_bias).astype(F32))
    c = jnp.cumsum(log_f, axis=1).transpose(0, 2, 1)
    outs = []
    for i in range(S // FOX_Q_BLOCK):
        lo, hi = i * FOX_Q_BLOCK, (i + 1) * FOX_Q_BLOCK
        logits = (jnp.einsum('bhqd,bhkd->bhqk', qh[:, :, lo:hi], kh[:, :, :hi]).astype(F32)
                  + c[:, :, lo:hi, None] - c[:, :, None, :hi])
        causal = jnp.arange(lo, hi)[:, None] >= jnp.arange(hi)[None, :]
        p = jax.nn.softmax(jnp.where(causal, logits, -jnp.inf), axis=-1)
        outs.append(jnp.einsum('bhqk,bhkd->bhqd', p, vh[:, :, :hi]))
    return jnp.concatenate(outs, axis=2)


def hgrn2_mixer(q, f_logit, i, g, lower_bound, out_gain):
    f = lower_bound + (1.0 - lower_bound) * jax.nn.sigmoid(f_logit.astype(F32))
    log_f = jnp.log(f)
    k = 1.0 - f
    qa = jax.nn.silu(q)
    o = chunked_gated_linear_attention(_heads(qa, HGRN_HEADS), _heads(k, HGRN_HEADS),
                                       _heads(i, HGRN_HEADS), _heads(log_f, HGRN_HEADS), HGRN_CHUNK)
    o = rms_norm(o, out_gain)
    return (_merge(o) * jax.nn.silu(g.astype(F32))).astype(g.dtype)


def sqrelu_mlp(x, w_up, w_down):
    return jnp.square(jax.nn.relu(x @ w_up)) @ w_down


def setup_inputs(seed: int = 0) -> dict:
    key = jax.random.key(seed)
    ks = jax.random.split(key, 24)

    def nrm(k, shape, scale):
        return jax.random.normal(k, shape, F32) * scale

    def gain(k, shape):
        return 1.0 + 0.02 * jax.random.normal(k, shape, F32)

    return {
        "x": nrm(ks[0], (BATCH, SEQ, D_MODEL), 1.0),
        "ev_norm_mix": gain(ks[1], (N_EVEN, D_MODEL)),
        "ev_w_in": nrm(ks[2], (N_EVEN, D_MODEL, EVEN_IN), D_MODEL ** -0.5),
        "ev_gla_gate_w2": nrm(ks[3], (N_EVEN, GLA_GATE_RANK, GLA_HEADS * GLA_DK), GLA_GATE_RANK ** -0.5),
        "ev_gla_gate_b": nrm(ks[4], (N_EVEN, GLA_HEADS * GLA_DK), 0.1),
        "ev_gla_out_norm": gain(ks[5], (N_EVEN, GLA_DV)),
        "ev_w_out": nrm(ks[6], (N_EVEN, EVEN_MIX, D_MODEL), EVEN_MIX ** -0.5),
        "ev_norm_mlp": gain(ks[7], (N_EVEN, D_MODEL)),
        "ev_w_up": nrm(ks[8], (N_EVEN, D_MODEL, D_FF), D_MODEL ** -0.5),
        "ev_w_down": nrm(ks[9], (N_EVEN, D_FF, D_MODEL), D_FF ** -0.5),
        "od_norm_mix": gain(ks[10], (N_ODD, D_MODEL)),
        "od_w_in": nrm(ks[11], (N_ODD, D_MODEL, ODD_IN), D_MODEL ** -0.5),
        "od_fox_fgate_b": nrm(ks[12], (N_ODD, FOX_HEADS), 0.1),
        "od_hgrn_out_norm": gain(ks[13], (N_ODD, HGRN_DV)),
        "od_w_out": nrm(ks[14], (N_ODD, ODD_MIX, D_MODEL), ODD_MIX ** -0.5),
        "od_norm_mlp": gain(ks[15], (N_ODD, D_MODEL)),
        "od_w_up": nrm(ks[16], (N_ODD, D_MODEL, D_FF), D_MODEL ** -0.5),
        "od_w_down": nrm(ks[17], (N_ODD, D_FF, D_MODEL), D_FF ** -0.5),
        "hgrn_lb_raw": nrm(ks[18], (DEPTH, HGRN_HEADS * HGRN_DK), 0.1),
        "final_norm": gain(ks[19], (D_MODEL,)),
    }


def reference(x, ev_norm_mix, ev_w_in, ev_gla_gate_w2, ev_gla_gate_b, ev_gla_out_norm, ev_w_out,
              ev_norm_mlp, ev_w_up, ev_w_down, od_norm_mix, od_w_in, od_fox_fgate_b, od_hgrn_out_norm,
              od_w_out, od_norm_mlp, od_w_up, od_w_down, hgrn_lb_raw, final_norm):
    lb_soft = jax.nn.softmax(hgrn_lb_raw.astype(F32), axis=0)
    lb_all = jnp.cumsum(lb_soft, axis=0) - lb_soft[0]

    h = x
    for layer in range(DEPTH):
        e = layer // 2
        if layer % 2 == 0:
            u = rms_norm(h, ev_norm_mix[e]) @ ev_w_in[e]
            gq, gk, gv, gg, glr, mq, mk, mv = _split(u, EVEN_SIZES)
            a = gla_mixer(gq, gk, gv, gg, glr, ev_gla_gate_w2[e], ev_gla_gate_b[e], ev_gla_out_norm[e])
            b = _merge(moba_mixer(mq, mk, mv)).astype(a.dtype)
            mix = jnp.concatenate([a, b], axis=-1) @ ev_w_out[e]
            h = h + mix.astype(h.dtype)
            h = h + sqrelu_mlp(rms_norm(h, ev_norm_mlp[e]), ev_w_up[e], ev_w_down[e]).astype(h.dtype)
        else:
            u = rms_norm(h, od_norm_mix[e]) @ od_w_in[e]
            fq, fk, fv, ff, hq, hf, hi, hg = _split(u, ODD_SIZES)
            c = _merge(fox_mixer(fq, fk, fv, ff, od_fox_fgate_b[e]))
            d = hgrn2_mixer(hq, hf, hi, hg, lb_all[layer], od_hgrn_out_norm[e])
            mix = jnp.concatenate([c.astype(d.dtype), d], axis=-1) @ od_w_out[e]
            h = h + mix.astype(h.dtype)
            h = h + sqrelu_mlp(rms_norm(h, od_norm_mlp[e]), od_w_up[e], od_w_down[e]).astype(h.dtype)
    return rms_norm(h, final_norm)
```

```cpp
#include <hip/hip_runtime.h>
#include <cstdio>
#include <cstdint>
#include <cmath>
__device__ __forceinline__ int otid() { int t = threadIdx.x; asm volatile("" : "+v"(t)); return t; }
#define ONE_LAUNCH 1
namespace pg8 {
#define PG8_LAS __attribute__((address_space(3)))
typedef unsigned short bf16_t;
typedef short bf16x8 __attribute__((ext_vector_type(8)));
typedef float f32x4 __attribute__((ext_vector_type(4)));
typedef unsigned u32x4 __attribute__((ext_vector_type(4)));
constexpr int BM = 256, BK = 64, HALF = 128, HTB = HALF * BK * 2  , STAGE_BYTES = 8 * HTB, NXCD = 8, WGM = 8;

__host__ __device__ __forceinline__ int lds_byte(int r, int c) { const int st = (r >> 4) * 2 + (c >> 5), rr = r & 15, cc = c & 31, ob = rr * 64 + cc * 2; return st * 1024 + (ob ^ (((ob >> 9) & 1) << 5)); }
__host__ __device__ __forceinline__ void stage_rc(int b, int& R, int& C) { const int st = b / 1024, sb = b % 1024, swz = sb ^ (((sb >> 9) & 1) << 5); R = (st >> 1) * 16 + swz / 64; C = (st & 1) * 32 + (swz % 64) / 2; }
__host__ __device__ __forceinline__ int perm32(int rho) { const int n = rho >> 4, i = rho & 15; return 8 * (i >> 2) + 4 * n + (i & 3); }

struct Unit { int pm, pn; };
struct Gemm { const bf16_t* A; const bf16_t* Bt; int M, N, K; int sp; int atile; };

struct StaticOrder {
    int nM, nN, nwg, G, c;
    __host__ __device__ void init(int M, int N, int G_, int c_) { nM = M / BM; nN = N / BM; nwg = nM * nN; G = G_; c = c_; }
    __host__ __device__ __forceinline__ bool next(int i, Unit& u) const {
        const long L = (long)i * G + c; if (L >= nwg) return false;
        int wgid = (int)L; { const int q = nwg / NXCD, r = nwg % NXCD, xcd = wgid % NXCD, off = wgid / NXCD; wgid = (xcd < r ? xcd * (q + 1) : r * (q + 1) + (xcd - r) * q) + off; }
        const int nig = WGM * nN, gid = wgid / nig, fm = gid * WGM, gsz = (nM - fm) < WGM ? (nM - fm) : WGM;
        u.pm = fm + ((wgid % nig) % gsz); u.pn = (wgid % nig) / gsz; return true;
    }
    __device__ __forceinline__ void a_ready(const Unit&) const {}
    __device__ __forceinline__ void done(const Unit&) const {}
};
__device__ __forceinline__ unsigned cvt_pk_bf16(float lo, float hi) { unsigned r; asm volatile("v_cvt_pk_bf16_f32 %0, %1, %2" : "=v"(r) : "v"(lo), "v"(hi)); return r; }
#define EPI_FENCE() asm volatile("" ::: "memory")
__host__ __device__ __forceinline__ unsigned atile_off(int R, int C) { return (unsigned)(((((R >> 6) * 2 + (C >> 5)) * 4 + ((R >> 4) & 3)) * 1024) + (((R & 15) * 4 + ((C >> 3) & 3)) * 16) + (C & 7) * 2); }
constexpr float RMS_EPS = 1e-6f;
template <int ACT, bool TILED> struct EpiScale {
    static constexpr bool PERM = true, AFTER_DRAIN = false;
    bf16_t* O; int ldc; const float* rowss; int row_base;
    const PG8_LAS float* tab; int tab_pm;
    __device__ __forceinline__ void operator()(const f32x4 (&acc)[2][2][4][2], const Unit& u, int wr, int wc, int fr, int fq) const {
        const int lrow0 = u.pm * BM + wr * 64 + fr; const int col0 = u.pn * BM + wc * 32 + 8 * fq;
        float rsv[2][4];
        if (u.pm == tab_pm) {
#pragma unroll
            for (int ai = 0; ai < 2; ++ai)
#pragma unroll
                for (int m = 0; m < 4; ++m) rsv[ai][m] = tab[wr * 64 + fr + ai * HALF + m * 16];
        } else {
#pragma unroll
            for (int ai = 0; ai < 2; ++ai)
#pragma unroll
                for (int m = 0; m < 4; ++m) { const f32x4* pp = (const f32x4*)(rowss + (size_t)(row_base + lrow0 + ai * HALF + m * 16) * 32 + 8 * fq); const f32x4 t0 = pp[0], t1 = pp[1];
                    float s = ((t0[0] + t0[1]) + (t0[2] + t0[3])) + ((t1[0] + t1[1]) + (t1[2] + t1[3]));
                    s += __shfl_xor(s, 16); s += __shfl_xor(s, 32); rsv[ai][m] = __builtin_amdgcn_rsqf(s * (1.0f / 2048.0f) + RMS_EPS); EPI_FENCE(); }
        }
#pragma unroll
        for (int ai = 0; ai < 2; ++ai)
#pragma unroll
            for (int m = 0; m < 4; ++m) { const int lrow = lrow0 + ai * HALF + m * 16;
                const float rs = rsv[ai][m];
                bf16_t* rowp = O + (size_t)lrow * ldc + col0;
#pragma unroll
                for (int bj = 0; bj < 2; ++bj) { f32x4 v0 = acc[ai][bj][m][0] * rs, v1 = acc[ai][bj][m][1] * rs;
                    if (ACT == 1) {
#pragma unroll
                        for (int e = 0; e < 4; ++e) { const float a = fmaxf(v0[e], 0.f), b = fmaxf(v1[e], 0.f); v0[e] = a * a; v1[e] = b * b; } }
                    u32x4 w; w.x = cvt_pk_bf16(v0[0], v0[1]); w.y = cvt_pk_bf16(v0[2], v0[3]); w.z = cvt_pk_bf16(v1[0], v1[1]); w.w = cvt_pk_bf16(v1[2], v1[3]);
                    if (TILED) *(u32x4*)((unsigned char*)O + ((size_t)(u.pm * 2 + ai) * (ldc >> 6) + (u.pn * 4 + bj * 2 + (wc >> 1))) * 16384 + ((wr * 2 + (wc & 1)) * 4 + m) * 1024 + (fr * 4 + fq) * 16) = w;
                    else *(u32x4*)(rowp + bj * HALF) = w; } }
    }
};
struct EpiSqRelu {
    static constexpr bool PERM = true, AFTER_DRAIN = false;
    bf16_t* O; int ldc;
    __device__ __forceinline__ void operator()(const f32x4 (&acc)[2][2][4][2], const Unit& u, int wr, int wc, int fr, int fq) const {
        const int ktn = ldc >> 6;
#pragma unroll
        for (int ai = 0; ai < 2; ++ai)
#pragma unroll
            for (int bj = 0; bj < 2; ++bj) { unsigned char* tile = (unsigned char*)O + ((size_t)(u.pm * 2 + ai) * ktn + (u.pn * 4 + bj * 2 + (wc >> 1))) * 16384 + ((wr * 2 + (wc & 1)) * 4) * 1024 + (fr * 4 + fq) * 16;
#pragma unroll
                for (int m = 0; m < 4; ++m) { f32x4 v0 = acc[ai][bj][m][0], v1 = acc[ai][bj][m][1];
#pragma unroll
                    for (int e = 0; e < 4; ++e) { float a, b; asm("v_max_f32_e32 %0, 0, %1" : "=v"(a) : "v"(v0[e])); asm("v_max_f32_e32 %0, 0, %1" : "=v"(b) : "v"(v1[e])); v0[e] = a * a; v1[e] = b * b; }
                    u32x4 w; w.x = cvt_pk_bf16(v0[0], v0[1]); w.y = cvt_pk_bf16(v0[2], v0[3]); w.z = cvt_pk_bf16(v1[0], v1[1]); w.w = cvt_pk_bf16(v1[2], v1[3]);
                    *(u32x4*)(tile + m * 1024) = w; } }
    }
};
struct EpiSqReluNS {
    static constexpr bool PERM = true, AFTER_DRAIN = false;
    bf16_t* O; int ldc;
    __device__ __forceinline__ void operator()(const f32x4 (&acc)[2][2][4][2], const Unit& u, int wr, int wc, int fr, int fq) const {
        const int lrow0 = u.pm * BM + wr * 64 + fr; const int col0 = u.pn * BM + wc * 32 + 8 * fq;
#pragma unroll
        for (int ai = 0; ai < 2; ++ai)
#pragma unroll
            for (int m = 0; m < 4; ++m) { bf16_t* rowp = O + (size_t)(lrow0 + ai * HALF + m * 16) * ldc + col0;
#pragma unroll
                for (int bj = 0; bj < 2; ++bj) { f32x4 v0 = acc[ai][bj][m][0], v1 = acc[ai][bj][m][1];
#pragma unroll
                    for (int e = 0; e < 4; ++e) { float a, b; asm("v_max_f32_e32 %0, 0, %1" : "=v"(a) : "v"(v0[e])); asm("v_max_f32_e32 %0, 0, %1" : "=v"(b) : "v"(v1[e])); v0[e] = a * a; v1[e] = b * b; }
                    u32x4 w; w.x = cvt_pk_bf16(v0[0], v0[1]); w.y = cvt_pk_bf16(v0[2], v0[3]); w.z = cvt_pk_bf16(v1[0], v1[1]); w.w = cvt_pk_bf16(v1[2], v1[3]);
                    *(u32x4*)(O + (((size_t)(u.pm * 32 + u.pn) * 8 + (wr * 4 + wc)) * 16 + (ai * 8 + m * 2 + bj)) * 512 + (fq * 16 + fr) * 8) = w;     } }
    }
};
template <bool F32IN, bool RS2> struct EpiResid {
    static constexpr bool PERM = true, AFTER_DRAIN = false;
    const void* hin; bf16_t* hout; float* rowss; int row_base; const float* rowss_in;
    __device__ __forceinline__ void operator()(const f32x4 (&acc)[2][2][4][2], const Unit& u, int wr, int wc, int fr, int fq) const {
        const int row0 = row_base + u.pm * BM + wr * 64 + fr; const int col0 = u.pn * BM + wc * 32 + 8 * fq;
        const size_t tb0 = ((size_t)((row_base >> 7) + u.pm * 2) * 32 + (u.pn * 4 + (wc >> 1))) * 16384 + ((wr * 2 + (wc & 1)) * 4) * 1024 + (fr * 4 + fq) * 16;
#define EPI_TOFF(ai_, m_, bj_) (tb0 + ((size_t)(ai_) * 32 + (bj_) * 2) * 16384 + (m_) * 1024)
        float rs2[2][4];
        if (RS2) { f32x4 pr[2][4][2];
#pragma unroll
            for (int ai = 0; ai < 2; ++ai)
#pragma unroll
                for (int m = 0; m < 4; ++m) { const f32x4* pp = (const f32x4*)(rowss_in + (size_t)(row0 + ai * HALF + m * 16) * 32 + 8 * fq); pr[ai][m][0] = pp[0]; pr[ai][m][1] = pp[1]; }
            EPI_FENCE();
#pragma unroll
            for (int ai = 0; ai < 2; ++ai)
#pragma unroll
                for (int m = 0; m < 4; ++m) { const f32x4 t0 = pr[ai][m][0], t1 = pr[ai][m][1]; float sq = ((t0[0] + t0[1]) + (t0[2] + t0[3])) + ((t1[0] + t1[1]) + (t1[2] + t1[3]));
                    sq += __shfl_xor(sq, 16); sq += __shfl_xor(sq, 32); rs2[ai][m] = __builtin_amdgcn_rcpf(sq * (1.0f / 2048.0f) + RMS_EPS); }
        }
        f32x4 hb[2][2][2][2];
#define EPI_LOAD(buf, k) do { _Pragma("unroll") for (int q_ = 0; q_ < 2; ++q_) { const int ai_ = (k) >> 1, m_ = 2 * ((k) & 1) + q_;                                                                          \
            _Pragma("unroll") for (int bj = 0; bj < 2; ++bj) {                                                                                                                                                  \
                if (F32IN) { const float* p_ = (const float*)hin + (size_t)(row0 + ai_ * HALF + m_ * 16) * 2048 + col0 + bj * HALF; hb[buf][q_][bj][0] = *(const f32x4*)p_; hb[buf][q_][bj][1] = *(const f32x4*)(p_ + 4); } \
                else { const u32x4 t_ = *(const u32x4*)((const unsigned char*)hin + EPI_TOFF(ai_, m_, bj));                                                                                                   \
                       hb[buf][q_][bj][0] = (f32x4){__uint_as_float(t_.x << 16), __uint_as_float(t_.x & 0xffff0000u), __uint_as_float(t_.y << 16), __uint_as_float(t_.y & 0xffff0000u)};                         \
                       hb[buf][q_][bj][1] = (f32x4){__uint_as_float(t_.z << 16), __uint_as_float(t_.z & 0xffff0000u), __uint_as_float(t_.w << 16), __uint_as_float(t_.w & 0xffff0000u)}; } } } } while (0)
        EPI_LOAD(0, 0); EPI_FENCE();
#pragma unroll
        for (int k = 0; k < 4; ++k) {
            if (k < 3) { if (k & 1) EPI_LOAD(0, k + 1); else EPI_LOAD(1, k + 1); }
            EPI_FENCE();
#pragma unroll
            for (int q = 0; q < 2; ++q) { const int ai = k >> 1, m = 2 * (k & 1) + q; const int row = row0 + ai * HALF + m * 16; float ss = 0.f;
#pragma unroll
                for (int bj = 0; bj < 2; ++bj) {
                    const f32x4 v0 = (RS2 ? acc[ai][bj][m][0] * rs2[ai][m] : acc[ai][bj][m][0]) + hb[k & 1][q][bj][0], v1 = (RS2 ? acc[ai][bj][m][1] * rs2[ai][m] : acc[ai][bj][m][1]) + hb[k & 1][q][bj][1];
                    u32x4 p; p.x = cvt_pk_bf16(v0[0], v0[1]); p.y = cvt_pk_bf16(v0[2], v0[3]); p.z = cvt_pk_bf16(v1[0], v1[1]); p.w = cvt_pk_bf16(v1[2], v1[3]);
                    *(u32x4*)((unsigned char*)hout + EPI_TOFF(ai, m, bj)) = p;
                    const float r0 = __uint_as_float(p.x << 16), r1 = __uint_as_float(p.x & 0xffff0000u), r2 = __uint_as_float(p.y << 16), r3 = __uint_as_float(p.y & 0xffff0000u);
                    const float r4 = __uint_as_float(p.z << 16), r5 = __uint_as_float(p.z & 0xffff0000u), r6 = __uint_as_float(p.w << 16), r7 = __uint_as_float(p.w & 0xffff0000u);
                    ss += ((r0 * r0 + r1 * r1) + (r2 * r2 + r3 * r3)) + ((r4 * r4 + r5 * r5) + (r6 * r6 + r7 * r7)); }
                ss += __shfl_xor(ss, 16); ss += __shfl_xor(ss, 32);
                if (fq == 0) rowss[(size_t)row * 32 + u.pn * 4 + wc] = ss; }
            EPI_FENCE();
        }
#undef EPI_LOAD
#undef EPI_TOFF
    }
};
struct EpiNull {
    static constexpr bool PERM = true, AFTER_DRAIN = false;
    __device__ __forceinline__ void operator()(const f32x4 (&acc)[2][2][4][2], const Unit&, int, int, int, int) const {
#pragma unroll
        for (int ai = 0; ai < 2; ++ai)
#pragma unroll
            for (int bj = 0; bj < 2; ++bj)
#pragma unroll
                for (int m = 0; m < 4; ++m)
#pragma unroll
                    for (int n = 0; n < 2; ++n) asm volatile("" :: "v"(acc[ai][bj][m][n]));
    }
};
template <class Epi, class Sched, bool ALIGN_EPI = false, bool SP2 = false>
__device__ __forceinline__ void gemm_phase(PG8_LAS unsigned char* lds, const Gemm g, const Sched& S, const Epi& E) {
    const int tid = otid(), wid = __builtin_amdgcn_readfirstlane(tid >> 6), lane = tid & 63, wr = wid >> 2, wc = wid & 3, fr = lane & 15, fq = lane >> 4;
    const int K = g.K, nt = K / BK;
    unsigned voffA[2], voffB[2];
#pragma unroll
    for (int i = 0; i < 2; ++i) { int R, C; stage_rc(tid * 16 + i * 8192, R, C); const int Rb = Epi::PERM ? ((R & ~31) + perm32(R & 31)) : R;
        voffA[i] = g.atile ? atile_off(R, C) : (unsigned)(R * K + C) * 2u; voffB[i] = (unsigned)(Rb * K + C) * 2u; }
    const size_t kstepB = (size_t)(BK * 2), kstepA = g.atile ? (size_t)16384 : kstepB;
    const size_t hstepB = (size_t)HALF * K * 2, hstepA = hstepB;
    const size_t tstepB = 2 * hstepB, tstepA = 2 * hstepA;
    const unsigned ldsw = (unsigned)wid * 1024u;
    const int aoff = lds_byte(wr * 64 + fr, fq * 8), boff = lds_byte(wc * 32 + fr, fq * 8);
#define PG8_SA(b, h) (((b) * 2 + (h)) * HTB)
#define PG8_SB(b, h) ((4 + (b) * 2 + (h)) * HTB)
#define PG8_STAGE(bufoff, gbase, voff) do { _Pragma("unroll") for (int _i = 0; _i < 2; ++_i) \
        __builtin_amdgcn_global_load_lds((const unsigned*)((const char*)(gbase) + (voff)[_i]), (PG8_LAS unsigned*)(lds + (bufoff) + ldsw + _i * 8192), 16, 0, 0); } while (0)
#define PG8_LDA(dst, b, h) do { _Pragma("unroll") for (int m = 0; m < 4; ++m) _Pragma("unroll") for (int k = 0; k < 2; ++k) dst[m][k] = *(const PG8_LAS bf16x8*)(lds + PG8_SA(b, h) + aoff + m * 2048 + k * 1024); } while (0)
#define PG8_LDB(dst, b, h) do { _Pragma("unroll") for (int n = 0; n < 2; ++n) _Pragma("unroll") for (int k = 0; k < 2; ++k) dst[n][k] = *(const PG8_LAS bf16x8*)(lds + PG8_SB(b, h) + boff + n * 2048 + k * 1024); } while (0)
#define PG8_MMA(ai, bj, At, Bt) do { __builtin_amdgcn_s_setprio(1); _Pragma("unroll") for (int m = 0; m < 4; ++m) _Pragma("unroll") for (int n = 0; n < 2; ++n) _Pragma("unroll") for (int k = 0; k < 2; ++k) \
        acc[ai][bj][m][n] = __builtin_amdgcn_mfma_f32_16x16x32_bf16(Bt[n][k], At[m][k], acc[ai][bj][m][n], 0, 0, 0); __builtin_amdgcn_s_setprio(0); } while (0)
#define PG8_WAIT_V(n) asm volatile("s_waitcnt vmcnt(" #n ")" ::: "memory")
#define PG8_WAIT_L(n) asm volatile("s_waitcnt lgkmcnt(" #n ")" ::: "memory")
#define PG8_BAR __builtin_amdgcn_s_barrier()
#define PG8_SCHED __builtin_amdgcn_sched_barrier(0)
    Unit cur, nxt; int ui = 0;
    if (!S.next(0, cur)) return;
    f32x4 acc[2][2][4][2];
#pragma unroll
    for (int a = 0; a < 2; ++a)
#pragma unroll
        for (int b = 0; b < 2; ++b)
#pragma unroll
            for (int m = 0; m < 4; ++m)
#pragma unroll
                for (int n = 0; n < 2; ++n) acc[a][b][m][n] = (f32x4){0.f, 0.f, 0.f, 0.f};
    bf16x8 At[4][2], B0[2][2], B1[2][2];
    const char* cA = (const char*)g.A + (size_t)(g.sp ? 0 : cur.pm) * tstepA; const char* cB = (const char*)g.Bt + (size_t)(g.sp ? 0 : cur.pn) * tstepB;
    S.a_ready(cur);
    if constexpr (SP2) {
        PG8_STAGE(PG8_SB(0, 0), cB, voffB); PG8_STAGE(PG8_SB(0, 1), cB + hstepB, voffB); PG8_STAGE(PG8_SA(0, 0), cA, voffA); PG8_STAGE(PG8_SA(0, 1), cA + hstepA, voffA);
        if (wr == 1) PG8_BAR;
        PG8_WAIT_V(2); PG8_BAR;
        PG8_STAGE(PG8_SB(1, 0), cB + kstepB, voffB); PG8_STAGE(PG8_SA(1, 0), cA + kstepA, voffA); PG8_STAGE(PG8_SB(1, 1), cB + hstepB + kstepB, voffB);
        PG8_WAIT_V(6); PG8_BAR;
    } else {
        PG8_STAGE(PG8_SB(0, 0), cB, voffB); PG8_STAGE(PG8_SA(0, 0), cA, voffA); PG8_STAGE(PG8_SB(0, 1), cB + hstepB, voffB); PG8_STAGE(PG8_SA(0, 1), cA + hstepA, voffA);
        if (wr == 1) PG8_BAR;
        PG8_WAIT_V(4); PG8_BAR;
        PG8_STAGE(PG8_SB(1, 0), cB + kstepB, voffB); PG8_STAGE(PG8_SA(1, 0), cA + kstepA, voffA); PG8_STAGE(PG8_SB(1, 1), cB + hstepB + kstepB, voffB);
        PG8_WAIT_V(6); PG8_BAR;
    }
    for (;;) {
        const bool has_next = S.next(ui + 1, nxt);
        const char* nA = has_next ? (const char*)g.A + (size_t)(g.sp ? 0 : nxt.pm) * tstepA : cA; const char* nB = has_next ? (const char*)g.Bt + (size_t)(g.sp ? 0 : nxt.pn) * tstepB : cB;
        for (int t = 0; t < nt; t += 2) {
            const bool last = (t == nt - 2);
            const char* a1 = cA + (size_t)(t + 1) * kstepA;
            const char* a2 = last ? nA : cA + (size_t)(t + 2) * kstepA; const char* b2 = last ? nB : cB + (size_t)(t + 2) * kstepB;
            const char* a3 = a2 + kstepA; const char* b3 = b2 + kstepB;
            if (last && has_next) S.a_ready(nxt);
            if constexpr (SP2) {
            PG8_LDB(B0, 0, 0); PG8_LDB(B1, 0, 1); PG8_SCHED; PG8_LDA(At, 0, 0); PG8_STAGE(PG8_SA(1, 1), a1 + hstepA, voffA);
            PG8_WAIT_V(8); PG8_WAIT_L(0); PG8_BAR; PG8_MMA(0, 0, At, B0); PG8_MMA(0, 1, At, B1); PG8_BAR; PG8_SCHED;
            PG8_LDA(At, 0, 1); PG8_STAGE(PG8_SB(0, 0), b2, voffB); PG8_STAGE(PG8_SB(0, 1), b2 + hstepB, voffB); PG8_STAGE(PG8_SA(0, 0), a2, voffA);
            PG8_WAIT_V(8); PG8_WAIT_L(0); PG8_BAR; PG8_MMA(1, 0, At, B0); PG8_MMA(1, 1, At, B1); PG8_BAR; PG8_SCHED;
            PG8_LDB(B0, 1, 0); PG8_LDB(B1, 1, 1); PG8_SCHED; PG8_LDA(At, 1, 0); PG8_STAGE(PG8_SA(0, 1), a2 + hstepA, voffA);
            PG8_WAIT_V(8); PG8_WAIT_L(0); PG8_BAR; PG8_MMA(0, 0, At, B0); PG8_MMA(0, 1, At, B1); PG8_BAR; PG8_SCHED;
            PG8_LDA(At, 1, 1); PG8_STAGE(PG8_SB(1, 0), b3, voffB); PG8_STAGE(PG8_SB(1, 1), b3 + hstepB, voffB); PG8_STAGE(PG8_SA(1, 0), a3, voffA);
            PG8_WAIT_V(8); PG8_WAIT_L(0); PG8_BAR; PG8_MMA(1, 0, At, B0); PG8_MMA(1, 1, At, B1); PG8_BAR; PG8_SCHED;
            } else {
            PG8_LDB(B0, 0, 0); PG8_SCHED; PG8_LDA(At, 0, 0); PG8_STAGE(PG8_SA(1, 1), a1 + hstepA, voffA);
            PG8_WAIT_L(8); PG8_BAR; PG8_WAIT_L(0); PG8_MMA(0, 0, At, B0); PG8_BAR; PG8_SCHED;
            PG8_LDB(B1, 0, 1); PG8_STAGE(PG8_SB(0, 0), b2, voffB);
            PG8_BAR; PG8_WAIT_L(0); PG8_MMA(0, 1, At, B1); PG8_BAR;
            PG8_LDA(At, 0, 1); PG8_STAGE(PG8_SA(0, 0), a2, voffA);
            PG8_BAR; PG8_WAIT_L(0); PG8_MMA(1, 0, At, B0); PG8_BAR; PG8_SCHED;
            PG8_STAGE(PG8_SB(0, 1), b2 + hstepB, voffB);
            PG8_WAIT_V(6); PG8_BAR; PG8_MMA(1, 1, At, B1); PG8_BAR;
            PG8_LDB(B0, 1, 0); PG8_SCHED; PG8_LDA(At, 1, 0); PG8_STAGE(PG8_SA(0, 1), a2 + hstepA, voffA);
            PG8_WAIT_L(8); PG8_BAR; PG8_WAIT_L(0); PG8_MMA(0, 0, At, B0); PG8_BAR; PG8_SCHED;
            PG8_LDB(B1, 1, 1); PG8_STAGE(PG8_SB(1, 0), b3, voffB);
            PG8_BAR; PG8_WAIT_L(0); PG8_MMA(0, 1, At, B1); PG8_BAR;
            PG8_LDA(At, 1, 1); PG8_STAGE(PG8_SA(1, 0), a3, voffA);
            PG8_BAR; PG8_WAIT_L(0); PG8_MMA(1, 0, At, B0); PG8_BAR; PG8_SCHED;
            PG8_STAGE(PG8_SB(1, 1), b3 + hstepB, voffB);
            PG8_WAIT_V(6); PG8_BAR; PG8_MMA(1, 1, At, B1); PG8_BAR;
            }
        }
        if constexpr (ALIGN_EPI) { if (wr == 0) PG8_BAR; }
        if constexpr (!Epi::AFTER_DRAIN) { E(acc, cur, wr, wc, fr, fq); S.done(cur); }
        if (!has_next) break;
#pragma unroll
        for (int a = 0; a < 2; ++a)
#pragma unroll
            for (int b = 0; b < 2; ++b)
#pragma unroll
                for (int m = 0; m < 4; ++m)
#pragma unroll
                    for (int n = 0; n < 2; ++n) acc[a][b][m][n] = (f32x4){0.f, 0.f, 0.f, 0.f};
        cur = nxt; cA = nA; cB = nB; ++ui;
        if constexpr (ALIGN_EPI) { if (wr == 1) PG8_BAR; }
    }
    PG8_WAIT_V(0);
    if constexpr (!ALIGN_EPI) { if (wr == 0) PG8_BAR; }
    PG8_BAR;
    if constexpr (Epi::AFTER_DRAIN) { E.fused(acc, cur, wr, wc, fr, fq, lds, wid, lane); S.done(cur); }
#undef PG8_SA
#undef PG8_SB
#undef PG8_STAGE
#undef PG8_LDA
#undef PG8_LDB
#undef PG8_MMA
#undef PG8_WAIT_V
#undef PG8_WAIT_L
#undef PG8_BAR
#undef PG8_SCHED
}
}

#ifndef MLP_SPLIT
#define MLP_SPLIT 2
#endif
constexpr int NB = 8, SEQ = 2048, DM = 2048, MTOK = NB * SEQ, DFF = 8192, MHALF = MTOK / MLP_SPLIT;
constexpr int NU0 = 6144, NU1 = 7168;
constexpr int LD_IN0 = 6160, LD_IN1 = 7176;
constexpr int C0_GQ = 0, C0_GK = 512, C0_GV = 1024, C0_GG = 2048, C0_MQ = 3072, C0_MK = 4096, C0_MV = 5120;
constexpr int C1_FQ = 0, C1_FK = 1024, C1_FV = 2048, C1_HQ = 3072, C1_HF = 4096, C1_HI = 5120, C1_HG = 6144;
constexpr float EPS = 1e-6f;
constexpr float QSCALE = 0.08838834764831845f;
constexpr size_t MiB = 1u << 20;
constexpr size_t WS_CTL = 0, CTL_ZERO_BYTES = 65536;
constexpr size_t WS_ROWSS = 1 * MiB;
constexpr size_t WS_GLR = 3 * MiB;
constexpr size_t WS_FF = 4 * MiB;
constexpr size_t WS_KMEAN = 4 * MiB + 512 * 1024;
constexpr size_t WS_DSC = 4 * MiB + 768 * 1024;
constexpr size_t WS_CFOX = 5 * MiB;
constexpr size_t WS_WIN0 = 6 * MiB, WS_WOUT0 = 30 * MiB, WS_WUP0 = 38 * MiB, WS_WDN0 = 70 * MiB;
constexpr size_t WS_WIN1 = 102 * MiB, WS_WOUT1 = 130 * MiB, WS_WUP1 = 138 * MiB, WS_WDN1 = 170 * MiB;
constexpr size_t WS_U = 202 * MiB;
constexpr size_t WS_BCUM = WS_U + 192 * MiB;
constexpr size_t WS_HFIN = WS_WIN0, WS_HID = WS_U;
constexpr size_t OUT_H16 = 64 * MiB;
constexpr size_t WS_P = 426 * MiB;
constexpr size_t WS_S = 490 * MiB;
constexpr size_t WS_ROWSS2 = 506 * MiB;
constexpr size_t WS_END = 508 * MiB;
constexpr int CW_BAR = 4096;
constexpr int LDS_BYTES = 147456, MISC_OFF = LDS_BYTES - 256;
constexpr int NWAVES = 8;

#define GAS __attribute__((address_space(1)))
#define LAS __attribute__((address_space(3)))
typedef unsigned short bf16;
typedef unsigned u32x4 __attribute__((ext_vector_type(4)));
typedef unsigned u32x2 __attribute__((ext_vector_type(2)));
typedef float f32x4 __attribute__((ext_vector_type(4)));
typedef float f32x2 __attribute__((ext_vector_type(2)));
typedef float f32x16 __attribute__((ext_vector_type(16)));
typedef short bf16x8 __attribute__((ext_vector_type(8)));
typedef short s16x4 __attribute__((ext_vector_type(4)));
typedef __bf16 bf16x2_t __attribute__((ext_vector_type(2)));
#define LDS_WAIT() asm volatile("s_waitcnt lgkmcnt(0)" ::: "memory")
__device__ __forceinline__ float bf2f(unsigned short b) { return __uint_as_float((unsigned)b << 16); }
__device__ __forceinline__ unsigned cvtpk(float lo, float hi) { f32x2 v = {lo, hi}; bf16x2_t b = __builtin_convertvector(v, bf16x2_t); return __builtin_bit_cast(unsigned, b); }
__device__ __forceinline__ unsigned short f2bf(float f) { return (unsigned short)(cvtpk(f, 0.f) & 0xffffu); }
__device__ __forceinline__ float wave_sum(float v) {
#pragma unroll
    for (int o = 1; o < 64; o <<= 1) v += __shfl_xor(v, o);
    return v;
}
__device__ __forceinline__ float wave_max(float v) {
#pragma unroll
    for (int o = 1; o < 64; o <<= 1) v = fmaxf(v, __shfl_xor(v, o));
    return v;
}
__device__ __forceinline__ float log_sigmoid(float z) { return fminf(z, 0.f) - log1pf(expf(-fabsf(z))); }
__device__ __forceinline__ float sigmoidf(float z) { return 1.0f / (1.0f + expf(-z)); }
__device__ __forceinline__ int crow(int r, int hi) { return (r & 3) + 8 * (r >> 2) + 4 * hi; }
#ifndef UTILED
#define UTILED 1
#endif
__device__ __forceinline__ size_t UOFF(int tok, int col, int pitch) {
#if UTILED
    return ((size_t)((tok >> 7) * (pitch >> 6) + (col >> 6)) << 13) + (pg8::atile_off(tok & 127, col & 63) >> 1);
#else
    return (size_t)tok * pitch + col;
#endif
}
__device__ __forceinline__ size_t TOFF(int row, int col) { return ((size_t)((row >> 7) * 32 + (col >> 6)) << 13) + (pg8::atile_off(row & 127, col & 63) >> 1); }
struct Args { const float* in[20]; float* out; unsigned char* ws; int ph_lo, ph_hi, variant, pad; };
typedef const __attribute__((address_space(4))) Args* KArgsP;
__device__ __forceinline__ KArgsP kargs() { KArgsP p = (KArgsP)__builtin_amdgcn_kernarg_segment_ptr(); asm volatile("" : "+s"(p)); return p; }
#define XB_TMO      128
#define XB_XCNT(j)  (256  + 64 * (j))
#define XB_XSUB(j)  (1280 + 64 * (j))
#define XB_XGEN(j)  (2304 + 64 * (j))
#define XB_TOP      3328
#define XB_TOPGEN   3392
#define XCD_BAR_WORDS 3456
#define XB_SPIN_CAP (1u << 18)

__device__ __forceinline__ unsigned xb_ld(unsigned* p)              { return __hip_atomic_load(p, __ATOMIC_RELAXED, __HIP_MEMORY_SCOPE_AGENT); }
__device__ __forceinline__ unsigned xb_add(unsigned* p, unsigned v) { return __hip_atomic_fetch_add(p, v, __ATOMIC_RELAXED, __HIP_MEMORY_SCOPE_AGENT); }
__device__ __forceinline__ unsigned xb_xcc_id() { return (unsigned)__builtin_amdgcn_s_getreg((3 << 11) | 20) & 0xFu; }
#define XB_SPIN(cond, bar) do { unsigned _sp = 0; while (cond) { __builtin_amdgcn_s_sleep(1); \
    if ((++_sp & 255u) == 0u) { if (xb_ld(&(bar)[XB_TMO])) break; if (_sp > XB_SPIN_CAP) { atomicAdd(&(bar)[XB_TMO], 1u); break; } } } } while (0)

struct XcdBarrier {
    unsigned* bar; unsigned x;
    volatile LAS unsigned* st;
};

__device__ __forceinline__ XcdBarrier xcd_barrier_post(unsigned* bar, volatile LAS unsigned* st) {
    XcdBarrier b; b.bar = bar; b.x = xb_xcc_id(); b.st = st;
    if (threadIdx.x == 0) (void)xb_add(&bar[XB_XCNT(b.x)], 1u);
    return b;
}
__device__ __forceinline__ void xcd_barrier_complete(unsigned* bar, unsigned x, unsigned& nloc, unsigned& nx) {
    const unsigned G = gridDim.x * gridDim.y * gridDim.z;
    unsigned sum, cnt, mine, sp = 0u;
    for (;;) {
        sum = 0u; cnt = 0u; mine = 0u;
#pragma unroll
        for (unsigned j = 0; j < 16; ++j) { const unsigned c = xb_ld(&bar[XB_XCNT(j)]); sum += c; cnt += (c > 0u) ? 1u : 0u; mine = (j == x) ? c : mine; }
        if (sum == G) break;
        __builtin_amdgcn_s_sleep(1);
        if ((++sp & 255u) == 0u) { if (xb_ld(&bar[XB_TMO])) break; if (sp > XB_SPIN_CAP) { atomicAdd(&bar[XB_TMO], 1u); break; } }
    }
    nloc = mine > 0u ? mine : 1u; nx = cnt > 0u ? cnt : 1u;
}

__device__ __forceinline__ void xcd_barrier(const XcdBarrier& b) {
    asm volatile("s_waitcnt vmcnt(0)" ::: "memory");
    __syncthreads();
    if (threadIdx.x == 0) {
        unsigned* bar = b.bar;
        __builtin_amdgcn_s_waitcnt(0);
        unsigned nloc = b.st[0], nx = b.st[1];
        if (nloc == 0u) { xcd_barrier_complete(bar, b.x, nloc, nx); b.st[0] = nloc; b.st[1] = nx; }
        const unsigned old = xb_add(&bar[XB_XSUB(b.x)], 1u);
        const unsigned gen = old / nloc;
        if (old + 1u == (gen + 1u) * nloc) {
            __builtin_amdgcn_fence(__ATOMIC_RELEASE, "agent");
            asm volatile("s_waitcnt vmcnt(0)" ::: "memory");
            const unsigned og = xb_add(&bar[XB_TOP], 1u);
            const unsigned tg = og / nx;
            if (og + 1u == (tg + 1u) * nx) xb_add(&bar[XB_TOPGEN], 1u);
            else XB_SPIN(xb_ld(&bar[XB_TOPGEN]) == tg, bar);
            __builtin_amdgcn_fence(__ATOMIC_ACQUIRE, "agent");
            xb_add(&bar[XB_XGEN(b.x)], 1u);
            asm volatile("s_waitcnt vmcnt(0)" ::: "memory");
        } else {
            XB_SPIN(xb_ld(&bar[XB_XGEN(b.x)]) == gen, bar);
            __builtin_amdgcn_fence(__ATOMIC_ACQUIRE, "agent");
            asm volatile("s_waitcnt vmcnt(0)" ::: "memory");
        }
    }
    __syncthreads();
}

#ifndef PROLOGUE_NT
#define PROLOGUE_NT 0
#endif
#if PROLOGUE_NT
#define NT_LOAD4(p) __builtin_nontemporal_load(p)
#else
#define NT_LOAD4(p) (*(p))
#endif

struct TrItem { const float* src; const float* gain; bf16* dst; int ld, K; };
__device__ __forceinline__ TrItem tr_decode(KArgsP K, int r) {
    unsigned char* ws = K->ws; TrItem t;
#define TJ(idx, gidx, ld_, co_, nc_, K_, off_, ro_) { const int items_ = ((K_) / 64) * ((nc_) / 32); if (r < items_) { const int nblk = (nc_) / 32, kb = r / nblk, nb = r % nblk, k0 = 64 * kb, n0 = 32 * nb; \
        t.src = K->in[idx] + (size_t)k0 * (ld_) + (co_) + n0; t.gain = (gidx) >= 0 ? K->in[(gidx) >= 0 ? (gidx) : 0] + k0 : nullptr; t.dst = (bf16*)(ws + (off_)) + (size_t)((ro_) + n0) * (K_) + k0; t.ld = (ld_); t.K = (K_); return t; } r -= items_; }
    TJ(2, 1, LD_IN0, 0, 3072, 2048, WS_WIN0, 0)
    TJ(2, 1, LD_IN0, 3088, 3072, 2048, WS_WIN0, 3072)
    TJ(6, -1, 2048, 0, 2048, 2048, WS_WOUT0, 0)
    TJ(8, 7, 8192, 0, 8192, 2048, WS_WUP0, 0)
    TJ(9, -1, 2048, 0, 2048, 8192, WS_WDN0, 0)
    TJ(11, 10, LD_IN1, 0, 3072, 2048, WS_WIN1, 0)
    TJ(11, 10, LD_IN1, 3080, 4096, 2048, WS_WIN1, 3072)
    TJ(14, -1, 2048, 0, 2048, 2048, WS_WOUT1, 0)
    TJ(16, 15, 8192, 0, 8192, 2048, WS_WUP1, 0)
    TJ(17, -1, 2048, 0, 2048, 8192, WS_WDN1, 0)
#undef TJ
    t.src = nullptr; t.gain = nullptr; t.dst = nullptr; t.ld = 0; t.K = 0; return t;
}
#define TR_LOAD(t, tv) do { _Pragma("unroll") for (int i = 0; i < 8; ++i) tv[i] = NT_LOAD4((const f32x4*)((t).src + (size_t)(8 * i + (lane >> 3)) * (t).ld + 4 * (lane & 7))); } while (0)
__device__ __forceinline__ void tr_process(const TrItem& t, const f32x4 (&tv)[8], LAS float* scr, int lane) {
#pragma unroll
    for (int i = 0; i < 8; ++i) { LAS float* d_ = scr + (8 * i + (lane >> 3)) * 33 + 4 * (lane & 7); d_[0] = tv[i][0]; d_[1] = tv[i][1]; d_[2] = tv[i][2]; d_[3] = tv[i][3]; }
    const int c = lane & 7;
    f32x4 g0 = {1.f, 1.f, 1.f, 1.f}, g1 = g0;
    if (t.gain) { g0 = *(const f32x4*)(t.gain + 8 * c); g1 = *(const f32x4*)(t.gain + 8 * c + 4); }
    LDS_WAIT(); asm volatile("" ::: "memory");
#pragma unroll
    for (int j = 0; j < 4; ++j) { const int n = (lane >> 3) + 8 * j; const LAS float* s = scr + (8 * c) * 33 + n;
        u32x4 o; o.x = cvtpk(s[0 * 33] * g0[0], s[1 * 33] * g0[1]); o.y = cvtpk(s[2 * 33] * g0[2], s[3 * 33] * g0[3]); o.z = cvtpk(s[4 * 33] * g1[0], s[5 * 33] * g1[1]); o.w = cvtpk(s[6 * 33] * g1[2], s[7 * 33] * g1[3]);
        *(GAS u32x4*)(t.dst + (size_t)n * t.K + 8 * c) = o; }
    LDS_WAIT(); asm volatile("" ::: "memory");
}
__device__ __forceinline__ void phase_transposes(LAS unsigned char* lds, KArgsP K, int G, int wave, int lane) {
    LAS float* scr = (LAS float*)(lds + wave * 16384);
    const int gw = blockIdx.x * NWAVES + wave, NGW = G * NWAVES;
    constexpr int TOTAL = 2 * (32 * 96) + 32 * 64 + 32 * 256 + 128 * 64 + 32 * 96 + 32 * 128 + 32 * 64 + 32 * 256 + 128 * 64;
    int it = gw; if (it >= TOTAL) return;
    f32x4 ta[8], tb[8];
    TrItem j0 = tr_decode(K, it), j1; TR_LOAD(j0, ta);
    for (;;) {
        const int it1 = it + NGW; const bool h1 = it1 < TOTAL;
        if (h1) { j1 = tr_decode(K, it1); TR_LOAD(j1, tb); }
        asm volatile("" ::: "memory");
        tr_process(j0, ta, scr, lane);
        if (!h1) break;
        const int it2 = it1 + NGW; const bool h2 = it2 < TOTAL;
        if (h2) { j0 = tr_decode(K, it2); TR_LOAD(j0, ta); }
        asm volatile("" ::: "memory");
        tr_process(j1, tb, scr, lane);
        if (!h2) break;
        it = it2;
    }
}
__device__ __forceinline__ void phase_norm0(LAS unsigned char* lds, KArgsP K, int G, int tid, int wave, int lane) {
    unsigned char* ws = K->ws; const float* x = K->in[0]; const float* g0 = K->in[1]; const float* win = K->in[2]; const float* w2 = K->in[3]; const float* gb = K->in[4];
    bf16* xn = (bf16*)((unsigned char*)K->out + OUT_H16); float* rowss = (float*)(ws + WS_ROWSS); float* glr = (float*)(ws + WS_GLR); float* bcum = (float*)(ws + WS_BCUM);
    LAS float* WT = (LAS float*)lds;
    LAS float* glr_s = (LAS float*)(lds + 131072);
    if ((int)blockIdx.x >= MTOK / 64) return;
    for (int idx = tid; idx < 2048 * 4; idx += 512) { const int k = idx >> 2, j4 = idx & 3; const f32x4 v = *(const f32x4*)(win + (size_t)k * LD_IN0 + 3072 + 4 * j4) * g0[k];
        WT[(4 * j4 + 0) * 2048 + k] = v[0]; WT[(4 * j4 + 1) * 2048 + k] = v[1]; WT[(4 * j4 + 2) * 2048 + k] = v[2]; WT[(4 * j4 + 3) * 2048 + k] = v[3]; }
    float w2c[16];
#pragma unroll
    for (int r = 0; r < 16; ++r) w2c[r] = w2[r * 512 + tid];
    const float bc = gb[tid];
    __syncthreads();
    for (int item = blockIdx.x; item < MTOK / 64; item += G) {
        const int r0 = item * 64;
        for (int i = 0; i < 8; i += 2) {
            const int row = r0 + 8 * wave + i;
            f32x4 va[8], vb[8]; float ssa = 0.f, ssb = 0.f;
#pragma unroll
            for (int jj = 0; jj < 8; ++jj) { va[jj] = NT_LOAD4((const f32x4*)(x + (size_t)row * DM) + 64 * jj + lane); vb[jj] = NT_LOAD4((const f32x4*)(x + (size_t)(row + 1) * DM) + 64 * jj + lane); }
            asm volatile("" ::: "memory");
#pragma unroll
            for (int jj = 0; jj < 8; ++jj) { ssa += (va[jj][0] * va[jj][0] + va[jj][1] * va[jj][1]) + (va[jj][2] * va[jj][2] + va[jj][3] * va[jj][3]); ssb += (vb[jj][0] * vb[jj][0] + vb[jj][1] * vb[jj][1]) + (vb[jj][2] * vb[jj][2] + vb[jj][3] * vb[jj][3]); }
#pragma unroll
            for (int jj = 0; jj < 8; ++jj) { u32x2 pa, pb; pa.x = cvtpk(va[jj][0], va[jj][1]); pa.y = cvtpk(va[jj][2], va[jj][3]); pb.x = cvtpk(vb[jj][0], vb[jj][1]); pb.y = cvtpk(vb[jj][2], vb[jj][3]);
                *(u32x2*)(xn + TOFF(row, 256 * jj + 4 * lane)) = pa; *(u32x2*)(xn + TOFF(row + 1, 256 * jj + 4 * lane)) = pb; }
            float acca[16], accb[16];
#pragma unroll 2
            for (int j = 0; j < 16; ++j) { float a = 0.f, b = 0.f;
#pragma unroll
                for (int jj = 0; jj < 8; ++jj) { const f32x4 w = *(const LAS f32x4*)(WT + j * 2048 + 256 * jj + 4 * lane);
                    a += (va[jj][0] * w[0] + va[jj][1] * w[1]) + (va[jj][2] * w[2] + va[jj][3] * w[3]); b += (vb[jj][0] * w[0] + vb[jj][1] * w[1]) + (vb[jj][2] * w[2] + vb[jj][3] * w[3]); }
                acca[j] = a; accb[j] = b; }
#pragma unroll
            for (int st = 0; st < 4; ++st) { const int half = 8 >> st; const unsigned um = 0u - (((unsigned)lane >> st) & 1u);
#pragma unroll
                for (int q = 0; q < 8; ++q) if (q < half) {
                    const unsigned alo = __float_as_uint(acca[q]), ahi = __float_as_uint(acca[q + half]), blo = __float_as_uint(accb[q]), bhi = __float_as_uint(accb[q + half]);
                    const float sa = __uint_as_float((alo & um) | (ahi & ~um)), sb = __uint_as_float((blo & um) | (bhi & ~um));
                    const float ka = __uint_as_float((ahi & um) | (alo & ~um)), kb = __uint_as_float((bhi & um) | (blo & ~um));
                    acca[q] = ka + __shfl_xor(sa, 1 << st); accb[q] = kb + __shfl_xor(sb, 1 << st); } }
            float ta = acca[0], tb = accb[0];
            ta += __shfl_xor(ta, 16); ta += __shfl_xor(ta, 32); tb += __shfl_xor(tb, 16); tb += __shfl_xor(tb, 32);
            ssa = wave_sum(ssa); ssb = wave_sum(ssb);
            const float rsa = 1.0f / sqrtf(ssa * (1.0f / DM) + EPS), rsb = 1.0f / sqrtf(ssb * (1.0f / DM) + EPS);
            const int col = ((lane & 1) << 3) | ((lane & 2) << 1) | ((lane & 4) >> 1) | ((lane & 8) >> 3);
            if (lane < 16) { glr_s[(8 * wave + i) * 16 + col] = ta * rsa; glr[(size_t)row * 16 + col] = ta * rsa; glr_s[(8 * wave + i + 1) * 16 + col] = tb * rsb; glr[(size_t)(row + 1) * 16 + col] = tb * rsb; }
            if (lane < 32) { rowss[(size_t)row * 32 + lane] = (lane == 0) ? ssa : 0.f; rowss[(size_t)(row + 1) * 32 + lane] = (lane == 0) ? ssb : 0.f; }
        }
        __syncthreads();
        float run = 0.f;
        for (int t = 0; t < 64; ++t) { float z = bc;
#pragma unroll
            for (int q = 0; q < 4; ++q) { const f32x4 gq = *(const LAS f32x4*)(glr_s + t * 16 + 4 * q); z += (gq[0] * w2c[4 * q] + gq[1] * w2c[4 * q + 1]) + (gq[2] * w2c[4 * q + 2] + gq[3] * w2c[4 * q + 3]); }
            run += (fminf(z, 0.f) - __logf(1.0f + __expf(-fabsf(z)))) * (1.0f / 16.0f); bcum[(size_t)(r0 + t) * 512 + tid] = run; }
        __syncthreads();
    }
}
__device__ __forceinline__ void phase_final_norm(const bf16* h16, float* out, const float* g, const float* rowss, int G, int wave, int lane) {
    f32x4 gv[8];
#pragma unroll
    for (int jj = 0; jj < 8; ++jj) gv[jj] = ((const f32x4*)g)[64 * jj + lane];
    for (int row = blockIdx.x * NWAVES + wave; row < MTOK; row += G * NWAVES) {
        float s = lane < 32 ? rowss[(size_t)row * 32 + lane] : 0.f;
        u32x2 hv[8];
#pragma unroll
        for (int jj = 0; jj < 8; ++jj) hv[jj] = *(const u32x2*)(h16 + TOFF(row, 256 * jj + 4 * lane));
        asm volatile("" ::: "memory");
        s = wave_sum(s);
        const float rs = 1.0f / sqrtf(s * (1.0f / DM) + EPS);
        f32x4* orow = (f32x4*)(out + (size_t)row * DM);
#pragma unroll
        for (int jj = 0; jj < 8; ++jj) { const f32x4 v = {__uint_as_float(hv[jj].x << 16), __uint_as_float(hv[jj].x & 0xffff0000u), __uint_as_float(hv[jj].y << 16), __uint_as_float(hv[jj].y & 0xffff0000u)};
            orow[64 * jj + lane] = v * rs * gv[jj]; }
    }
}
__device__ __forceinline__ void phase_kmean(LAS unsigned char* lds, const bf16* u, float* kmean, int G, int tid) {
    LAS float* red = (LAS float*)lds;
    const int c8 = tid & 15, tg = tid >> 4;
    for (int item = blockIdx.x; item < 512; item += G) {
        const int n = item & 7, bh = item >> 3, b = bh >> 3, h = bh & 7;
        float a[8] = {0, 0, 0, 0, 0, 0, 0, 0}; bf16x8 kv[8];
#pragma unroll
        for (int i = 0; i < 8; ++i) { const int tok = b * SEQ + n * 256 + tg * 8 + i; kv[i] = *(const bf16x8*)(u + UOFF(tok, C0_MK + h * 128 + 8 * c8, NU0)); }
        asm volatile("" ::: "memory");
#pragma unroll
        for (int i = 0; i < 8; ++i)
#pragma unroll
            for (int e = 0; e < 8; ++e) a[e] += bf2f((unsigned short)kv[i][e]);
#pragma unroll
        for (int e = 0; e < 8; ++e) red[tg * 128 + 8 * c8 + e] = a[e];
        __syncthreads();
        if (tid < 128) { float s = 0.f; for (int g = 0; g < 32; ++g) s += red[g * 128 + tid]; kmean[(size_t)item * 128 + tid] = s * (1.0f / 256.0f); }
        __syncthreads();
    }
}
__device__ __forceinline__ void phase_ff(LAS unsigned char* lds, const float* win1, const float* gain, const bf16* xn, const float* rowss, float* ff, int G, int tid, int wave, int lane) {
    LAS float* WT = (LAS float*)lds;
    if ((int)blockIdx.x >= MTOK / 64) return;
    for (int idx = tid; idx < 2048 * 2; idx += 512) { const int k = idx >> 1, j4 = idx & 1; const f32x4 v = *(const f32x4*)(win1 + (size_t)k * LD_IN1 + 3072 + 4 * j4) * gain[k];
        WT[(4 * j4 + 0) * 2048 + k] = v[0]; WT[(4 * j4 + 1) * 2048 + k] = v[1]; WT[(4 * j4 + 2) * 2048 + k] = v[2]; WT[(4 * j4 + 3) * 2048 + k] = v[3]; }
    __syncthreads();
    for (int item = blockIdx.x; item < MTOK / 64; item += G) {
        for (int i = 0; i < 8; ++i) {
            const int row = item * 64 + 8 * wave + i;
            float xf[4][8]; bf16x8 xv[4];
#pragma unroll
            for (int jj = 0; jj < 4; ++jj) xv[jj] = *(const bf16x8*)(xn + TOFF(row, 512 * jj + 8 * lane));
            float s = lane < 32 ? rowss[(size_t)row * 32 + lane] : 0.f;
            asm volatile("" ::: "memory");
#pragma unroll
            for (int jj = 0; jj < 4; ++jj)
#pragma unroll
                for (int e = 0; e < 8; ++e) xf[jj][e] = bf2f((unsigned short)xv[jj][e]);
            s = wave_sum(s);
            const float rs = 1.0f / sqrtf(s * (1.0f / DM) + EPS);
            float mine = 0.f;
#pragma unroll 1
            for (int j = 0; j < 8; ++j) { float a = 0.f;
#pragma unroll
                for (int jj = 0; jj < 4; ++jj) { const f32x4 w0 = *(const LAS f32x4*)(WT + j * 2048 + 512 * jj + 8 * lane), w1 = *(const LAS f32x4*)(WT + j * 2048 + 512 * jj + 8 * lane + 4);
                    a += (xf[jj][0] * w0[0] + xf[jj][1] * w0[1]) + (xf[jj][2] * w0[2] + xf[jj][3] * w0[3]) + (xf[jj][4] * w1[0] + xf[jj][5] * w1[1]) + (xf[jj][6] * w1[2] + xf[jj][7] * w1[3]); }
                const float t = wave_sum(a) * rs; if (lane == j) mine = t; }
            if (lane < 8) ff[(size_t)row * 8 + lane] = mine;
        }
    }
    __syncthreads();
}
template <int DV>
__device__ __forceinline__ void phase_scan(const float* sloc, const float* dsc, bf16* sstart, int G, int tid) {
    constexpr int GPB = 128 * DV / 4, TOTAL = (DV == 256 ? 32 : 64) * GPB;
    for (int item = blockIdx.x * 512 + tid; item < TOTAL; item += G * 512) {
        const int p4 = item % GPB, bh = item / GPB;
        const int g = p4 & 3, ln = (p4 >> 2) & 63, dt = (p4 >> 8) & 3;
        const int d0 = 32 * dt + 8 * g + 4 * (ln >> 5);
        f32x4 s = {0.f, 0.f, 0.f, 0.f}; f32x4 ddv[7]; f32x4 lv[7];
#pragma unroll
        for (int sc = 0; sc < 7; ++sc) { const int ui = bh * 8 + sc; ddv[sc] = *(const f32x4*)(dsc + ui * 128 + d0); lv[sc] = *(const f32x4*)(sloc + (size_t)ui * 128 * DV + 4 * (size_t)p4); }
        asm volatile("" ::: "memory");
#pragma unroll
        for (int sc = 0; sc < 7; ++sc) { const int ui = bh * 8 + sc;
            s = s * ddv[sc] + lv[sc]; u32x2 p; p.x = cvtpk(s[0], s[1]); p.y = cvtpk(s[2], s[3]); *(u32x2*)(sstart + (size_t)(ui + 1) * 128 * DV + 4 * (size_t)p4) = p; }
    }
}

__device__ __forceinline__ unsigned offb(unsigned row, unsigned ch) { return 256u * row + 16u * (ch ^ (((row & 3u) << 2) | ((row >> 2) & 3u))); }
__device__ __forceinline__ unsigned tr_addr(unsigned lane, unsigned c, unsigned ks, unsigned t) {
    const unsigned h = lane >> 5, blk = (lane >> 4) & 1, q = (lane & 15) >> 2, p = lane & 3;
    return offb(16 * ks + 8 * h + 4 * t + q, 4 * c + 2 * blk + (p >> 1)) + 8 * (p & 1);
}
typedef short v4i16_t __attribute__((ext_vector_type(4)));
__device__ __forceinline__ s16x4 ds_tr(LAS const unsigned char* p) { return __builtin_bit_cast(s16x4, __builtin_amdgcn_ds_read_tr16_b64_v4i16((LAS v4i16_t*)p)); }
__device__ __forceinline__ bf16x8 ld_tr_frag(LAS const unsigned char* tile, unsigned lane, unsigned c, unsigned ks) {
    const s16x4 lo = ds_tr(tile + tr_addr(lane, c, ks, 0)), hi = ds_tr(tile + tr_addr(lane, c, ks, 1));
    return __builtin_shufflevector(lo, hi, 0, 1, 2, 3, 4, 5, 6, 7);
}
__device__ __forceinline__ bf16x8 ld_row_frag(LAS const unsigned char* tile, unsigned row, unsigned ch) { return *(const LAS bf16x8*)(tile + offb(row, ch)); }
template <int S> __device__ __forceinline__ bf16x8 pack_step(const f32x16& x) {
    u32x4 w = {cvtpk(x[8 * S], x[8 * S + 1]), cvtpk(x[8 * S + 2], x[8 * S + 3]), cvtpk(x[8 * S + 4], x[8 * S + 5]), cvtpk(x[8 * S + 6], x[8 * S + 7])};
    return __builtin_bit_cast(bf16x8, w);
}
#define LD_FENCE() asm volatile("" ::: "memory")
#define MFMA32(a, b, c) __builtin_amdgcn_mfma_f32_32x32x16_bf16((a), (b), (c), 0, 0, 0)

struct LinArgs {
    const bf16* u; int pitch; int qoff, koff, voff, goff;
    const float* bcum;
    const float* lbraw;
    const float* gain;
    float* sloc; float* dsc; const bf16* sstart; bf16* mix; int mixoff;
};
template <int DV, int NWH, bool HGRN, bool PB>
__device__ __forceinline__ void lin_unit(LAS unsigned char* lds, const int tid, const LinArgs& A, const int b, const int hbase, const int sc) {
    constexpr int NTH = 64 * NWH, NTQ = NTH / 128, TPT = 64 / NTQ, NHEADS = HGRN ? 8 : 4;
    constexpr int VS_OFF = 32768, AS_OFF = VS_OFF + DV * 128, DS_OFF = AS_OFF + 9216, RED_OFF = DS_OFF + 512, BT_OFF = RED_OFF + 2048, HEAD_LDS = BT_OFF + 4096;
    static_assert(HEAD_LDS * (8 / NWH) <= MISC_OFF, "LDS");
    const int wv = __builtin_amdgcn_readfirstlane(tid >> 6), wl = wv % NWH, hs = wv / NWH, head = hbase + hs;
    LAS unsigned char* hl = lds + hs * HEAD_LDS;
    LAS unsigned char* Qs = hl; LAS unsigned char* Ks = hl + 16384; LAS unsigned char* Vs = hl + VS_OFF; LAS unsigned char* As = hl + AS_OFF;
    LAS float* Ds = (LAS float*)(hl + DS_OFF); LAS float* red = (LAS float*)(hl + RED_OFF); LAS float* btot = (LAS float*)(hl + BT_OFF);
    const int ui = (b * NHEADS + head) * 8 + sc;
    f32x16 Sacc[4];
#pragma unroll
    for (int dt = 0; dt < 4; ++dt)
#pragma unroll
        for (int i = 0; i < 16; ++i) Sacc[dt][i] = 0.f;
    if (PB && sc > 0) {
        const bf16* sp = A.sstart + ((((size_t)ui * (DV / 32) + wl) * 4) * 64 + (tid & 63)) * 16;
        u32x4 rw[4][2];
#pragma unroll
        for (int dt = 0; dt < 4; ++dt) { rw[dt][0] = *(const u32x4*)(sp + dt * 1024); rw[dt][1] = *(const u32x4*)(sp + dt * 1024 + 8); }
        LD_FENCE();
#pragma unroll
        for (int dt = 0; dt < 4; ++dt)
#pragma unroll
            for (int h2 = 0; h2 < 2; ++h2)
#pragma unroll
                for (int q = 0; q < 4; ++q) { const unsigned w = rw[dt][h2][q]; Sacc[dt][8 * h2 + 2 * q] = __uint_as_float(w << 16); Sacc[dt][8 * h2 + 2 * q + 1] = __uint_as_float(w & 0xffff0000u); }
    }
    float dsum = 0.f, lb = 0.f, oml = 1.f; float dsum8[8] = {0.f, 0.f, 0.f, 0.f, 0.f, 0.f, 0.f, 0.f};
    float lb4[4] = {0.f, 0.f, 0.f, 0.f}, oml4[4] = {1.f, 1.f, 1.f, 1.f};
    if (HGRN) {
#pragma unroll
        for (int e = 0; e < 4; ++e) { const int d0_ = 4 * ((tid - hs * NTH) & 31) + e; lb4[e] = sigmoidf(A.lbraw[1024 + head * 128 + d0_] - A.lbraw[head * 128 + d0_]); oml4[e] = 1.f - lb4[e]; } }
    for (int c = 0; c < 4; ++c) {
        const int tok0 = b * SEQ + sc * 256 + c * 64;
        int tid_c = tid; asm volatile("" : "+v"(tid_c));
        const int th = tid_c - hs * NTH, lane = tid_c & 63, r = lane & 31, hb = lane >> 5;
        const int d = th & 127, tq = th >> 7;
        const unsigned wofs = 2u * (d & 7);
        float blast;
        if (!HGRN) {
            constexpr int NP = 1024 / NTH;
            u32x4 rk[NP], rq[NP]; f32x4 b0[NP], b1[NP];
#pragma unroll
            for (int j = 0; j < NP; ++j) { const int item = th + j * NTH, t = item >> 4, c8 = item & 15;
                rk[j] = *(const u32x4*)(A.u + UOFF(tok0 + t, A.koff + head * 128 + 8 * c8, A.pitch)); if (PB) rq[j] = *(const u32x4*)(A.u + UOFF(tok0 + t, A.qoff + head * 128 + 8 * c8, A.pitch));
                const f32x4* bp = (const f32x4*)(A.bcum + (size_t)(tok0 + t) * 512 + head * 128 + 8 * c8); b0[j] = bp[0]; b1[j] = bp[1]; }
            LD_FENCE();
#pragma unroll
            for (int j = 0; j < NP; ++j) { const int item = th + j * NTH, t = item >> 4, c8 = item & 15;
                float bb[8] = {b0[j][0], b0[j][1], b0[j][2], b0[j][3], b1[j][0], b1[j][1], b1[j][2], b1[j][3]};
                float kf[8], qf[8];
#pragma unroll
                for (int e = 0; e < 4; ++e) { kf[2 * e] = __uint_as_float(rk[j][e] << 16); kf[2 * e + 1] = __uint_as_float(rk[j][e] & 0xffff0000u); if (PB) { qf[2 * e] = __uint_as_float(rq[j][e] << 16); qf[2 * e + 1] = __uint_as_float(rq[j][e] & 0xffff0000u); } }
                u32x4 ko, qo;
#pragma unroll
                for (int e = 0; e < 4; ++e) { ko[e] = cvtpk(kf[2 * e] * __expf(-bb[2 * e]), kf[2 * e + 1] * __expf(-bb[2 * e + 1]));
                    if (PB) qo[e] = cvtpk(qf[2 * e] * QSCALE * __expf(bb[2 * e]), qf[2 * e + 1] * QSCALE * __expf(bb[2 * e + 1])); }
                *(LAS u32x4*)(Ks + offb(t, c8)) = ko; if (PB) *(LAS u32x4*)(Qs + offb(t, c8)) = qo;
                if (t == 63) {
#pragma unroll
                    for (int e = 0; e < 8; ++e) { Ds[8 * c8 + e] = __expf(bb[e]); dsum8[e] += bb[e]; } } }
            blast = 0.f;
        } else {
            constexpr int TP = 8; const int dbase = 4 * (th & 31), tq8 = th >> 5;
            float sgv[TP][4]; u32x2 hraw[TP], qraw[TP];
#pragma unroll
            for (int i = 0; i < TP; ++i) { const int tk = tok0 + tq8 * TP + i; hraw[i] = *(const u32x2*)(A.u + UOFF(tk, A.koff + head * 128 + dbase, A.pitch)); if (PB) qraw[i] = *(const u32x2*)(A.u + UOFF(tk, A.qoff + head * 128 + dbase, A.pitch)); }
            LD_FENCE();
            f32x4 run = {0.f, 0.f, 0.f, 0.f};
#pragma unroll
            for (int i = 0; i < TP; ++i) { const float hv[4] = {__uint_as_float(hraw[i].x << 16), __uint_as_float(hraw[i].x & 0xffff0000u), __uint_as_float(hraw[i].y << 16), __uint_as_float(hraw[i].y & 0xffff0000u)};
#pragma unroll
                for (int e = 0; e < 4; ++e) { const float sg = __builtin_amdgcn_rcpf(1.0f + __expf(-hv[e])); sgv[i][e] = sg; run[e] += __logf(lb4[e] + oml4[e] * sg); } }
            *(LAS f32x4*)(btot + tq8 * 128 + dbase) = run;
            __syncthreads();
            f32x4 off = {0.f, 0.f, 0.f, 0.f}, tot = off;
#pragma unroll
            for (int q = 0; q < 8; ++q) { const f32x4 v = *(const LAS f32x4*)(btot + q * 128 + dbase); tot += v; if (q < tq8) off += v; }
            f32x4 bb = off;
#pragma unroll
            for (int i = 0; i < TP; ++i) { const int t = tq8 * TP + i; float kk[4], qq[4];
                const float hq[4] = {__uint_as_float(qraw[i].x << 16), __uint_as_float(qraw[i].x & 0xffff0000u), __uint_as_float(qraw[i].y << 16), __uint_as_float(qraw[i].y & 0xffff0000u)};
#pragma unroll
                for (int e = 0; e < 4; ++e) { const float sg = sgv[i][e]; bb[e] += __logf(lb4[e] + oml4[e] * sg); kk[e] = oml4[e] * (1.0f - sg) * __expf(-bb[e]);
                    if (PB) qq[e] = hq[e] * __builtin_amdgcn_rcpf(1.0f + __expf(-hq[e])) * __expf(bb[e]); }
                u32x2 kp; kp.x = cvtpk(kk[0], kk[1]); kp.y = cvtpk(kk[2], kk[3]); *(LAS u32x2*)(Ks + offb(t, dbase >> 3) + 2 * (dbase & 7)) = kp;
                if (PB) { u32x2 qp; qp.x = cvtpk(qq[0], qq[1]); qp.y = cvtpk(qq[2], qq[3]); *(LAS u32x2*)(Qs + offb(t, dbase >> 3) + 2 * (dbase & 7)) = qp; } }
            if (tq8 == 0) {
#pragma unroll
                for (int e = 0; e < 4; ++e) { Ds[dbase + e] = __expf(tot[e]); dsum8[e] += tot[e]; } }
            blast = 0.f;
        }
        { u32x4 vv[4];
#pragma unroll
          for (int j = 0; j < 4; ++j) { const int item = th + j * NTH, t = item / (DV / 8), c8 = item % (DV / 8); vv[j] = *(const u32x4*)(A.u + UOFF(tok0 + t, A.voff + head * DV + 8 * c8, A.pitch)); }
          LD_FENCE();
#pragma unroll
          for (int j = 0; j < 4; ++j) { const int item = th + j * NTH, t = item / (DV / 8), c8 = item % (DV / 8); *(LAS u32x4*)(Vs + (c8 >> 4) * 16384 + offb(t, c8 & 15)) = vv[j]; } }
        __syncthreads();
        f32x16 o0, o1;
        u32x2 ggv[4][2]; f32x4 gnv[4];
        if (PB) {
#pragma unroll
            for (int g = 0; g < 4; ++g) { const int e0 = 32 * wl + 8 * g + 4 * hb; gnv[g] = *(const f32x4*)(A.gain + e0);
#pragma unroll
                for (int tt = 0; tt < 2; ++tt) ggv[g][tt] = *(const u32x2*)(A.u + UOFF(tok0 + 32 * tt + r, A.goff + head * DV + e0, A.pitch)); }
            LD_FENCE();
        }
        if (PB) {
            if (wl < 4) {
                const int tt = wl >> 1, st = wl & 1;
                f32x16 sa;
#pragma unroll
                for (int i = 0; i < 16; ++i) sa[i] = 0.f;
                if (st <= tt) {
#pragma unroll
                    for (int ks = 0; ks < 8; ++ks) { const bf16x8 af = ld_row_frag(Ks, 32 * st + r, 2 * ks + hb), bq = ld_row_frag(Qs, 32 * tt + r, 2 * ks + hb); sa = MFMA32(af, bq, sa); }
                    if (st == tt) {
#pragma unroll
                        for (int i = 0; i < 16; ++i) if (crow(i, hb) > r) sa[i] = 0.f; }
                }
#pragma unroll
                for (int g = 0; g < 4; ++g) { u32x2 p; p.x = cvtpk(sa[4 * g], sa[4 * g + 1]); p.y = cvtpk(sa[4 * g + 2], sa[4 * g + 3]);
                    *(LAS u32x2*)(As + (32 * tt + r) * 144 + (32 * st + 8 * g + 4 * hb) * 2) = p; }
            }
            __syncthreads();
        }
        bf16x8 vf[4];
#pragma unroll
        for (int ks = 0; ks < 4; ++ks) vf[ks] = ld_tr_frag(Vs + (wl >> 2) * 16384, lane, wl & 3, ks);
        if (PB) {
#pragma unroll
            for (int i = 0; i < 16; ++i) { o0[i] = 0.f; o1[i] = 0.f; }
#pragma unroll
            for (int ks = 0; ks < 4; ++ks) {
                const bf16x8 a1 = *(const LAS bf16x8*)(As + (32 + r) * 144 + 32 * ks + 16 * hb); o1 = MFMA32(vf[ks], a1, o1);
                if (ks < 2) { const bf16x8 a0 = *(const LAS bf16x8*)(As + r * 144 + 32 * ks + 16 * hb); o0 = MFMA32(vf[ks], a0, o0); } }
#pragma unroll
            for (int dt = 0; dt < 4; ++dt) {
                const bf16x8 sf0 = pack_step<0>(Sacc[dt]), sf1 = pack_step<1>(Sacc[dt]);
#pragma unroll
                for (int s2 = 0; s2 < 2; ++s2) {
                    const u32x2 qa0 = *(const LAS u32x2*)(Qs + offb(r, 4 * dt + 2 * s2) + 8 * hb), qb0 = *(const LAS u32x2*)(Qs + offb(r, 4 * dt + 2 * s2 + 1) + 8 * hb);
                    const u32x2 qa1 = *(const LAS u32x2*)(Qs + offb(32 + r, 4 * dt + 2 * s2) + 8 * hb), qb1 = *(const LAS u32x2*)(Qs + offb(32 + r, 4 * dt + 2 * s2 + 1) + 8 * hb);
                    const u32x4 q0 = {qa0.x, qa0.y, qb0.x, qb0.y}, q1 = {qa1.x, qa1.y, qb1.x, qb1.y};
                    o0 = MFMA32(s2 ? sf1 : sf0, __builtin_bit_cast(bf16x8, q0), o0); o1 = MFMA32(s2 ? sf1 : sf0, __builtin_bit_cast(bf16x8, q1), o1); } }
        }
#pragma unroll
        for (int ks = 0; ks < 4; ++ks)
#pragma unroll
            for (int dt = 0; dt < 4; ++dt) { const bf16x8 kf = ld_tr_frag(Ks, lane, dt, ks); Sacc[dt] = MFMA32(kf, vf[ks], Sacc[dt]); }
#pragma unroll
        for (int dt = 0; dt < 4; ++dt)
#pragma unroll
            for (int g = 0; g < 4; ++g) { const f32x4 dv = *(const LAS f32x4*)(Ds + 32 * dt + 8 * g + 4 * hb);
#pragma unroll
                for (int e = 0; e < 4; ++e) Sacc[dt][4 * g + e] *= dv[e]; }
        if (PB) {
            float s0 = 0.f, s1 = 0.f;
#pragma unroll
            for (int i = 0; i < 16; ++i) { s0 += o0[i] * o0[i]; s1 += o1[i] * o1[i]; }
            s0 += __shfl_xor(s0, 32); s1 += __shfl_xor(s1, 32);
            if (hb == 0) { red[wl * 64 + r] = s0; red[wl * 64 + 32 + r] = s1; }
            __syncthreads();
            float t0 = 0.f, t1 = 0.f;
#pragma unroll
            for (int w = 0; w < NWH; ++w) { t0 += red[w * 64 + r]; t1 += red[w * 64 + 32 + r]; }
            const float rs0 = 1.0f / sqrtf(t0 * (1.0f / DV) + EPS), rs1 = 1.0f / sqrtf(t1 * (1.0f / DV) + EPS);
#pragma unroll
            for (int g = 0; g < 4; ++g) { const int e0 = 32 * wl + 8 * g + 4 * hb; const f32x4 gn = gnv[g];
#pragma unroll
                for (int tt = 0; tt < 2; ++tt) { const size_t tok = (size_t)(tok0 + 32 * tt + r); const u32x2 gg = ggv[g][tt];
                    const float g0 = __uint_as_float(gg.x << 16), g1 = __uint_as_float(gg.x & 0xffff0000u), g2 = __uint_as_float(gg.y << 16), g3 = __uint_as_float(gg.y & 0xffff0000u);
                    const float rs = tt ? rs1 : rs0;
                    const float v0 = (tt ? o1[4 * g] : o0[4 * g]) * rs * gn[0] * (g0 * __builtin_amdgcn_rcpf(1.0f + __expf(-g0))), v1 = (tt ? o1[4 * g + 1] : o0[4 * g + 1]) * rs * gn[1] * (g1 * __builtin_amdgcn_rcpf(1.0f + __expf(-g1)));
                    const float v2 = (tt ? o1[4 * g + 2] : o0[4 * g + 2]) * rs * gn[2] * (g2 * __builtin_amdgcn_rcpf(1.0f + __expf(-g2))), v3 = (tt ? o1[4 * g + 3] : o0[4 * g + 3]) * rs * gn[3] * (g3 * __builtin_amdgcn_rcpf(1.0f + __expf(-g3)));
                    u32x2 p; p.x = cvtpk(v0, v1); p.y = cvtpk(v2, v3); *(u32x2*)(A.mix + tok * 2048 + A.mixoff + head * DV + e0) = p; } }
        }
        __syncthreads();
    }
    if (!PB) {
        const int th = tid - hs * NTH, d = th & 127, tq = th >> 7;
        float* sp = A.sloc + ((((size_t)ui * (DV / 32) + wl) * 4) * 64 + (tid & 63)) * 16;
#pragma unroll
        for (int dt = 0; dt < 4; ++dt)
#pragma unroll
            for (int g = 0; g < 4; ++g) *(f32x4*)(sp + dt * 1024 + 4 * g) = (f32x4){Sacc[dt][4 * g], Sacc[dt][4 * g + 1], Sacc[dt][4 * g + 2], Sacc[dt][4 * g + 3]};
        if (HGRN) { if ((th >> 5) == 0) {
#pragma unroll
            for (int e = 0; e < 4; ++e) A.dsc[ui * 128 + 4 * (th & 31) + e] = __expf(dsum8[e]); } }
        else if (th >= NTH - 16) {
#pragma unroll
            for (int e = 0; e < 8; ++e) A.dsc[ui * 128 + 8 * (th - (NTH - 16)) + e] = __expf(dsum8[e]); }
    }
}

namespace att {
constexpr int D = 128;
constexpr float SCALE = 0.08838834764831845f, INV_SCALE = 11.313708498984761f;
constexpr float THR = 8.f;
constexpr int NW = 8, QBLK = 32, KVBLK = 64, QB = NW * QBLK;
constexpr int SHM_V = KVBLK * D * 2, SHM_K = KVBLK * D * 2;
constexpr int LDS_CORE = 2 * SHM_V + 2 * SHM_K + NW * 64 * 4;
constexpr int OFF_BIAS = LDS_CORE, OFF_SEL = OFF_BIAS + 8192, OFF_KM = OFF_SEL + 1024, OFF_SCAN = OFF_KM + 3584, LDS_ATT = OFF_SCAN + 64;
static_assert(LDS_ATT <= MISC_OFF, "attention LDS");
#define KSWZ(row, colB) ((row) * 256 + ((colB) ^ (((row) & 7) << 4)))
#define SBAR() __builtin_amdgcn_sched_barrier(0)
__device__ __forceinline__ int v_st(int k, int c) { const int kk = (k & ~0xC) | ((k & 4) << 1) | ((k & 8) >> 1); return ((kk >> 3) * 4 + (c >> 5)) * 512 + ((kk & 7) * 32 + (c & 31)) * 2; }
__device__ __forceinline__ int v_rd_base(int lane) { return ((lane & 3) << 3) | (((lane >> 2) & 3) << 6) | (((lane >> 4) & 1) << 5) | (((lane >> 5) & 1) << 8); }
constexpr int v_rd_off(int d0, int ks, int half) { return d0 * 512 + ks * 4096 + half * 2048; }
__device__ __forceinline__ unsigned cvtpk_a(float lo, float hi) { unsigned r; asm volatile("v_cvt_pk_bf16_f32 %0, %1, %2" : "=v"(r) : "v"(lo), "v"(hi)); return r; }
__device__ __forceinline__ bf16x8 load8(const bf16* p) { return *reinterpret_cast<const bf16x8*>(p); }
__device__ __forceinline__ void mask_tile(f32x16& p0, f32x16& p1, int dq) {
    const float NEG = -__builtin_inff();
#pragma unroll
    for (int r = 0; r < 16; ++r) {
        const int c = (r & 3) + 8 * (r >> 2);
        if (dq - c < 0) p0[r] = NEG;
        if (dq - c - 32 < 0) p1[r] = NEG;
    }
}
__device__ __forceinline__ void partialSM(f32x16& p0, f32x16& p1, float& m_reg, float& mn, float& alpha, const bool keep) {
    float pmax = p0[0]; for (int r = 1; r < 16; ++r) pmax = fmaxf(pmax, p0[r]); for (int r = 0; r < 16; ++r) pmax = fmaxf(pmax, p1[r]);
    { auto rr = __builtin_amdgcn_permlane32_swap(__float_as_uint(pmax), __float_as_uint(pmax), false, false);
      pmax = fmaxf(__uint_as_float(rr[0]), __uint_as_float(rr[1])); }
    pmax = keep ? pmax : -__builtin_inff();
    constexpr float C2 = 1.4426950408889634f * SCALE;
    if (__builtin_expect(__all((pmax - m_reg) * SCALE <= THR), 1)) { mn = m_reg; alpha = 1.f; }
    else { mn = fmaxf(m_reg, pmax); alpha = __builtin_amdgcn_exp2f((m_reg - mn) * C2); m_reg = mn; }
    const float mnL = keep ? -mn * C2 : -__builtin_inff();
    for (int r = 0; r < 16; ++r) p0[r] = fmaf(p0[r], C2, mnL); for (int r = 0; r < 16; ++r) p1[r] = fmaf(p1[r], C2, mnL);
    for (int r = 0; r < 16; ++r) p0[r] = __builtin_amdgcn_exp2f(p0[r]);
}
__device__ __forceinline__ void finishSM(f32x16& p0, f32x16& p1, float alpha, float& l_reg, bf16x8& pa0, bf16x8& pa1, bf16x8& pa2, bf16x8& pa3) {
    for (int r = 0; r < 16; ++r) p1[r] = __builtin_amdgcn_exp2f(p1[r]);
    float ps = 0; for (int r = 0; r < 16; ++r) ps += p0[r]; for (int r = 0; r < 16; ++r) ps += p1[r];
    { auto rr = __builtin_amdgcn_permlane32_swap(__float_as_uint(ps), __float_as_uint(ps), false, false);
      ps = __uint_as_float(rr[0]) + __uint_as_float(rr[1]); }
    l_reg = l_reg * alpha + ps;
#define PK4(P, B_, OUT) do { unsigned a0 = cvtpk_a(P[B_+0], P[B_+1]), a1 = cvtpk_a(P[B_+2], P[B_+3]);                          \
        unsigned b0 = cvtpk_a(P[B_+4], P[B_+5]), b1 = cvtpk_a(P[B_+6], P[B_+7]);                                             \
        auto r0 = __builtin_amdgcn_permlane32_swap(a0, b0, false, false); auto r1 = __builtin_amdgcn_permlane32_swap(a1, b1, false, false); \
        u32x4 w = {r0[0], r1[0], r0[1], r1[1]}; OUT = *reinterpret_cast<bf16x8*>(&w); } while (0)
    PK4(p0, 0, pa0); PK4(p0, 8, pa1); PK4(p1, 0, pa2); PK4(p1, 8, pa3);
#undef PK4
}
template <int KB>
__device__ __forceinline__ void qkt(f32x16& p0, f32x16& p1, const char* K_lds, int r32, int hi, const bf16x8* qr, const float* bp) {
#pragma unroll
    for (int g = 0; g < 4; ++g) { const f32x4 b0 = *(const f32x4*)(bp + 8 * g), b1 = *(const f32x4*)(bp + 32 + 8 * g);
#pragma unroll
        for (int e = 0; e < 4; ++e) { p0[4 * g + e] = b0[e]; p1[4 * g + e] = b1[e]; } }
    const char* kb[4];
#pragma unroll
    for (int dd = 0; dd < 4; ++dd) kb[dd] = K_lds + KB * SHM_K + KSWZ(r32, (dd * 16 + hi * 8) * 2);
#pragma unroll
    for (int d0 = 0; d0 < 8; ++d0) { const char* a = kb[d0 & 3] + (d0 >> 2) * 128;
        bf16x8 b0 = *reinterpret_cast<const bf16x8*>(a);
        bf16x8 b1 = *reinterpret_cast<const bf16x8*>(a + 32 * 256);
        p0 = __builtin_amdgcn_mfma_f32_32x32x16_bf16(b0, qr[d0], p0, 0, 0, 0);
        p1 = __builtin_amdgcn_mfma_f32_32x32x16_bf16(b1, qr[d0], p1, 0, 0, 0); }
}
template <int VB>
__device__ __forceinline__ void pv_tile(f32x16* o, int vb0, bf16x8 pa0, bf16x8 pa1, bf16x8 pa2, bf16x8 pa3) {
#define TRRD(dst, off) asm volatile("ds_read_b64_tr_b16 %0, %1 offset:%2" : "=&v"(dst) : "v"(vb0), "i"(off) : "memory")
#define PV_D0(d0) do { s16x4 l0, l1, l2, l3, h0, h1, h2, h3; constexpr int b_ = VB * SHM_V + v_rd_off(d0, 0, 0);   \
        TRRD(l0, b_); TRRD(h0, b_ + 2048); TRRD(l1, b_ + 4096); TRRD(h1, b_ + 6144); TRRD(l2, b_ + 8192); TRRD(h2, b_ + 10240); TRRD(l3, b_ + 12288); TRRD(h3, b_ + 14336); \
        asm volatile("s_waitcnt lgkmcnt(0)" ::: "memory"); SBAR();   \
        o[d0] = __builtin_amdgcn_mfma_f32_32x32x16_bf16(pa0, (bf16x8){l0[0], l0[1], l0[2], l0[3], h0[0], h0[1], h0[2], h0[3]}, o[d0], 0, 0, 0);   \
        o[d0] = __builtin_amdgcn_mfma_f32_32x32x16_bf16(pa1, (bf16x8){l1[0], l1[1], l1[2], l1[3], h1[0], h1[1], h1[2], h1[3]}, o[d0], 0, 0, 0);   \
        o[d0] = __builtin_amdgcn_mfma_f32_32x32x16_bf16(pa2, (bf16x8){l2[0], l2[1], l2[2], l2[3], h2[0], h2[1], h2[2], h2[3]}, o[d0], 0, 0, 0);   \
        o[d0] = __builtin_amdgcn_mfma_f32_32x32x16_bf16(pa3, (bf16x8){l3[0], l3[1], l3[2], l3[3], h3[0], h3[1], h3[2], h3[3]}, o[d0], 0, 0, 0); } while (0)
    PV_D0(0); PV_D0(1); PV_D0(2); PV_D0(3);
#undef PV_D0
#undef TRRD
}
struct Blk { const bf16* u; int tokb, qcol, kcol, vcol; bf16* O; int P0; };
struct Seam { bf16x8 qr[8]; bf16x8 st_v0, st_v1, st_k0, st_k1; };
#define ROW(colbase, k0, rr) (Ub + UOFF(tokb_ + (k0) + (rr), (colbase) + sc, pitch))
#define VMW() asm volatile("s_waitcnt vmcnt(0)" ::: "memory")
#define VMWN(n) asm volatile("s_waitcnt vmcnt(%0)" :: "i"(n) : "memory")
#define SLOAD_H(Kp, Vp, k0) do { S.st_v0 = load8(ROW(Vp, k0, sr)); S.st_v1 = load8(ROW(Vp, k0, 32 + sr));              \
                         S.st_k0 = load8(ROW(Kp, k0, sr)); S.st_k1 = load8(ROW(Kp, k0, 32 + sr)); } while (0)
#define SWRITE_HK(bf) do { *(bf16x8*)(K_lds + (bf) * SHM_K + kws) = S.st_k0; *(bf16x8*)(K_lds + (bf) * SHM_K + kws + 32 * 256) = S.st_k1; } while (0)
#define SWRITE_HV(bf) do { *(bf16x8*)(V_lds + (bf) * SHM_V + vst0) = S.st_v0; *(bf16x8*)(V_lds + (bf) * SHM_V + vst1) = S.st_v1; } while (0)
#define SWRITE_H(bf) do { SWRITE_HV(bf); SWRITE_HK(bf); } while (0)
__device__ __forceinline__ void prime(const Blk& cur, char* lds, Seam& S, const int pitch) {
    const int tid = otid(), wid = __builtin_amdgcn_readfirstlane(tid >> 6), lane = tid & 63, r32 = lane & 31, hi = lane >> 5;
    const int sr = tid >> 4, sc = (tid & 15) * 8, kws = KSWZ(sr, sc * 2); char* K_lds = lds + 2 * SHM_V;
    const bf16* Ub = cur.u; const int tokb_ = cur.tokb;
    for (int d0 = 0; d0 < 8; ++d0) S.qr[d0] = load8(cur.u + UOFF(cur.tokb + cur.P0 + wid * QBLK + r32, cur.qcol + d0 * 16 + hi * 8, pitch));
    SLOAD_H(cur.kcol, cur.vcol, 0); VMW(); SWRITE_HK(0);
    __syncthreads();
}
__device__ __forceinline__ void block(const Blk& cur, const Blk& nxt, char* lds, Seam& S, const int pitch, const int opitch, const unsigned selbits, const float* biasL) {
    const int tid = otid(), wid = __builtin_amdgcn_readfirstlane(tid >> 6), lane = tid & 63, r32 = lane & 31, hi = lane >> 5;
    const int NT = cur.P0 / KVBLK + QB / KVBLK;
    const int qbn = cur.P0 >> 8;
    const int qlo = cur.P0 + wid * QBLK, qm = qlo + r32 - 4 * hi;
    char* V_lds = lds; char* K_lds = lds + 2 * SHM_V;
    float* ws = (float*)(lds + 2 * SHM_V + 2 * SHM_K) + wid * 64; float* li_l = ws, * al_l = ws + 32;
    float m_reg = -1e30f, l_reg = 0; f32x16 o[4] = {};
    const int sr = tid >> 4, sc = (tid & 15) * 8, vst0 = v_st(sr, sc), vst1 = v_st(32 + sr, sc), kws = KSWZ(sr, sc * 2);
    const int vb0 = (int)(uintptr_t)V_lds + v_rd_base(lane);
    const int Kh = cur.kcol, Vh = cur.vcol; const bf16* Ub = cur.u; const int tokb_ = cur.tokb;
#define RESC(a) do { if (__any((a) < 1.f)) { if (hi == 0) al_l[r32] = (a); asm volatile("s_waitcnt lgkmcnt(0)" ::: "memory");              \
                     for (int d_ = 0; d_ < 4; ++d_) for (int r = 0; r < 16; ++r) o[d_][r] *= al_l[crow(r, hi)]; } } while (0)
#define KBASE(t) ((t) * KVBLK)
#define MASKT(P0_, P1_, t) do { const int kb_ = KBASE(t); if ((kb_ >> 8) >= qbn && kb_ + KVBLK - 1 > qlo) mask_tile(P0_, P1_, qm - kb_); } while (0)
#define KEEPT(t) ((((t) * KVBLK) >> 8) >= qbn || ((selbits >> (((t) * KVBLK) >> 8)) & 1u))
#define BIASP(t) (biasL + KBASE(t) + 4 * hi)
    constexpr int NQL = 8;
#define SEAM_K0() do { VMWN(NQL); SWRITE_HK(0); SBAR(); } while (0)
    f32x16 pA0, pA1, pB0, pB1; float mnA, mnB, alA, alB; bf16x8 pa0, pa1, pa2, pa3;
    SWRITE_HV(0); SBAR();
    SLOAD_H(Kh, Vh, KBASE(1));
    SBAR(); qkt<0>(pA0, pA1, K_lds, r32, hi, S.qr, BIASP(0));
    MASKT(pA0, pA1, 0); partialSM(pA0, pA1, m_reg, mnA, alA, KEEPT(0));
    VMW(); SWRITE_H(1);
    __syncthreads();
#define HALF_STEP(PX0, PX1, mnX, alX, PY0, PY1, alY, t, KB, VB, SB) do {                                                      \
        SBAR(); qkt<KB>(PX0, PX1, K_lds, r32, hi, S.qr, BIASP(t));                                                           \
        finishSM(PY0, PY1, alY, l_reg, pa0, pa1, pa2, pa3); SBAR();                                                           \
        if ((t) + 1 < NT) { SLOAD_H(Kh, Vh, KBASE((t) + 1)); SBAR(); }                                                        \
        pv_tile<VB>(o, vb0, pa0, pa1, pa2, pa3); MASKT(PX0, PX1, (t)); partialSM(PX0, PX1, m_reg, mnX, alX, KEEPT(t));        \
        __syncthreads();                                                                                                      \
        if ((t) + 1 < NT) { VMW(); SWRITE_H(SB); }                                                                            \
        RESC(alX); __syncthreads(); } while (0)
    for (int t = 1; t + 1 < NT; t += 2) {
        HALF_STEP(pB0, pB1, mnB, alB, pA0, pA1, alA, t, 1, 0, 0);
        HALF_STEP(pA0, pA1, mnA, alA, pB0, pB1, alB, t + 1, 0, 1, 1);
    }
    SBAR(); qkt<1>(pB0, pB1, K_lds, r32, hi, S.qr, BIASP(NT - 1)); SBAR();
    SLOAD_H(nxt.kcol, nxt.vcol, 0); SBAR();
#pragma unroll
    for (int d0 = 0; d0 < 8; ++d0) S.qr[d0] = load8(nxt.u + UOFF(nxt.tokb + nxt.P0 + wid * QBLK + r32, nxt.qcol + d0 * 16 + hi * 8, pitch));
    SBAR();
    finishSM(pA0, pA1, alA, l_reg, pa0, pa1, pa2, pa3); SBAR();
    pv_tile<0>(o, vb0, pa0, pa1, pa2, pa3);
    MASKT(pB0, pB1, NT - 1); partialSM(pB0, pB1, m_reg, mnB, alB, true); __syncthreads(); RESC(alB);
    finishSM(pB0, pB1, alB, l_reg, pa0, pa1, pa2, pa3); SBAR(); pv_tile<1>(o, vb0, pa0, pa1, pa2, pa3);
    SBAR(); SEAM_K0();
    if (hi == 0) li_l[r32] = l_reg; asm volatile("s_waitcnt lgkmcnt(0)" ::: "memory");
    float rli[16];
#pragma unroll
    for (int r = 0; r < 16; ++r) rli[r] = __builtin_amdgcn_rcpf(li_l[crow(r, hi)]);
    bf16* Ow = cur.O + (size_t)(wid * QBLK) * opitch;
#pragma unroll
    for (int r = 0; r < 16; ++r) { const int orow = crow(r, hi);
#pragma unroll
        for (int d0 = 0; d0 < 4; ++d0) { const float v = o[d0][r] * rli[r];
            const float vn = __shfl_xor(v, 1);
            if ((r32 & 1) == 0) *(unsigned*)(Ow + (size_t)orow * opitch + d0 * 32 + r32) = cvtpk_a(v, vn); } }
    __syncthreads();
#undef RESC
#undef KBASE
#undef MASKT
#undef KEEPT
#undef BIASP
#undef SEAM_K0
#undef HALF_STEP
}
#undef ROW
#undef VMW
#undef VMWN
#undef SLOAD_H
#undef SWRITE_HK
#undef SWRITE_HV
#undef SWRITE_H

__device__ __forceinline__ void setup(char* lds, const int mode, const Blk& cur, const int pitch, const int b, const int h, const float* kmean, const float* ff, const float* fbias) {
    const int tid = otid(), lane = tid & 63, wave = tid >> 6;
    float* biasL = (float*)(lds + OFF_BIAS); unsigned* selm = (unsigned*)(lds + OFF_SEL); float* kms = (float*)(lds + OFF_KM); float* scanw = (float*)(lds + OFF_SCAN);
    const int qb = cur.P0 >> 8;
    if (mode == 0) {
        const float slope = exp2f(-(float)(h + 1)) * INV_SCALE;
        for (int i = tid; i < qb * 128; i += 512) kms[i] = kmean[(size_t)((b * 8 + h) * 8) * 128 + i];
        for (int s = tid; s < cur.P0 + 256; s += 512) biasL[s] = slope * (float)(s - cur.P0);
        __syncthreads();
        const int row = tid >> 1, dh = tid & 1;
        float acc[7] = {0.f, 0.f, 0.f, 0.f, 0.f, 0.f, 0.f};
        bf16x8 qv8[8];
#pragma unroll
        for (int c = 0; c < 8; ++c) qv8[c] = load8(cur.u + UOFF(cur.tokb + cur.P0 + row, cur.qcol + 64 * dh + 8 * c, pitch));
        asm volatile("" ::: "memory");
#pragma unroll
        for (int c = 0; c < 8; ++c) { const bf16x8 qv = qv8[c];
#pragma unroll
            for (int e = 0; e < 8; ++e) { const float qf = bf2f((unsigned short)qv[e]);
#pragma unroll
                for (int n = 0; n < 7; ++n) if (n < qb) acc[n] += qf * kms[n * 128 + 64 * dh + 8 * c + e]; } }
        unsigned bits;
#pragma unroll
        for (int n = 0; n < 7; ++n) acc[n] += __shfl_xor(acc[n], 1);
        if (qb <= 3) bits = (1u << qb) - 1u;
        else { bits = 0u;
#pragma unroll
            for (int pick = 0; pick < 3; ++pick) { float best = -__builtin_inff(); int bi = 0;
#pragma unroll
                for (int n = 0; n < 7; ++n) if (n < qb && !((bits >> n) & 1u) && acc[n] > best) { best = acc[n]; bi = n; }
                bits |= 1u << bi; } }
        if (dh == 0) selm[row] = bits;
        __syncthreads();
    } else {
        const float fb = fbias[h];
        float v[4]; float run = 0.f;
#pragma unroll
        for (int i = 0; i < 4; ++i) v[i] = ff[(size_t)(b * SEQ + 4 * tid + i) * 8 + h];
        asm volatile("" ::: "memory");
#pragma unroll
        for (int i = 0; i < 4; ++i) { run += log_sigmoid(v[i] + fb); v[i] = run; }
        float incl = run;
#pragma unroll
        for (int o = 1; o < 64; o <<= 1) { const float t = __shfl_up(incl, o); if (lane >= o) incl += t; }
        if (lane == 63) scanw[wave] = incl;
        __syncthreads();
        float off = incl - run;
        for (int w = 0; w < wave; ++w) off += scanw[w];
#pragma unroll
        for (int i = 0; i < 4; ++i) { v[i] += off; biasL[4 * tid + i] = v[i]; }
        __syncthreads();
        const float cref = biasL[cur.P0];
        __syncthreads();
#pragma unroll
        for (int i = 0; i < 4; ++i) biasL[4 * tid + i] = (cref - v[i]) * INV_SCALE;
        if (tid < 256) selm[tid] = 0xffu;
        __syncthreads();
    }
}
__device__ __forceinline__ void pair_item(char* lds, const int item, const int mode, const bf16* u, const int pitch, const int qoff, const int koff, const int voff,
                                          bf16* mix, const int mixoff, const float* kmean, const float* ff, const float* fbias) {
    const int bh = item >> 2, x = item & 3, b = bh >> 3, h = bh & 7;
    bf16* obase = mix + (size_t)(b * SEQ) * 2048 + mixoff + h * 128;
    const float* biasL = (const float*)(lds + OFF_BIAS); const unsigned* selm = (const unsigned*)(lds + OFF_SEL);
    Blk cur;
    cur.P0 = x * 256; cur.u = u; cur.tokb = b * SEQ; cur.qcol = qoff + h * 128; cur.kcol = koff + h * 128; cur.vcol = voff + h * 128; cur.O = obase + (size_t)cur.P0 * 2048;
    Seam S;
    for (int pass = 0; pass < 2; ++pass) {
        setup(lds, mode, cur, pitch, b, h, kmean, ff, fbias);
        if (pass == 0) prime(cur, lds, S, pitch);
        Blk nxt = cur;
        if (pass == 0) { nxt.P0 = (7 - x) * 256; nxt.O = obase + (size_t)nxt.P0 * 2048; }
        const int t_ = otid();
        const unsigned sel = selm[(t_ >> 6) * 32 + (t_ & 31)];
        block(cur, nxt, lds, S, pitch, 2048, sel, biasL);
        cur = nxt;
    }
}
}

template <int DV, bool HGRN>
__device__ __forceinline__ void ref_lin(LAS unsigned char* lds, const int tid, const int G, const bf16* u, const int pitch, const int qoff, const int koff, const int voff, const int goff,
                                        const float* glr, const float* w2, const float* gb, const float* lbraw, const float* gain, bf16* mix, const int mixoff) {
    constexpr int NDP = 512 / DV, DPP = 128 / NDP, NHEADS = HGRN ? 8 : 4, TPG = 16 / NDP, NWG = DV / 64;
    LAS float* qs = (LAS float*)lds; LAS float* ks = qs + 16 * 128; LAS float* dcs = ks + 16 * 128; LAS float* ored = dcs + 16 * 128; LAS float* wred = ored + NDP * 16 * DV;
    const int e = tid % DV, dp = tid / DV, lane = tid & 63, wave = tid >> 6;
    for (int unit = blockIdx.x; unit < NB * NHEADS; unit += G) {
        const int b = unit / NHEADS, head = unit % NHEADS;
        float S[DPP];
#pragma unroll
        for (int i = 0; i < DPP; ++i) S[i] = 0.f;
        for (int t0 = 0; t0 < SEQ; t0 += 16) {
            for (int idx = tid; idx < 16 * 128; idx += 512) { const int tt = idx >> 7, d = idx & 127; const size_t tok = (size_t)(b * SEQ + t0 + tt);
                float q, k, dc;
                if (!HGRN) { float z = gb[head * 128 + d]; for (int r = 0; r < 16; ++r) z += glr[tok * 16 + r] * w2[r * 512 + head * 128 + d];
                    dc = expf(log_sigmoid(z) * (1.0f / 16.0f)); q = bf2f(u[UOFF((int)tok, qoff + head * 128 + d, pitch)]) * QSCALE; k = bf2f(u[UOFF((int)tok, koff + head * 128 + d, pitch)]); }
                else { const float lb = sigmoidf(lbraw[1024 + head * 128 + d] - lbraw[head * 128 + d]); const float f = lb + (1.f - lb) * sigmoidf(bf2f(u[UOFF((int)tok, koff + head * 128 + d, pitch)]));
                    dc = f; k = 1.f - f; const float hq = bf2f(u[UOFF((int)tok, qoff + head * 128 + d, pitch)]); q = hq * sigmoidf(hq); }
                qs[idx] = q; ks[idx] = k; dcs[idx] = dc; }
            __syncthreads();
            for (int tt = 0; tt < 16; ++tt) { const size_t tok = (size_t)(b * SEQ + t0 + tt); const float v = bf2f(u[UOFF((int)tok, voff + head * DV + e, pitch)]); float op = 0.f;
#pragma unroll
                for (int i = 0; i < DPP; ++i) { const int d = dp * DPP + i; S[i] = dcs[tt * 128 + d] * S[i] + ks[tt * 128 + d] * v; op += S[i] * qs[tt * 128 + d]; }
                ored[(dp * 16 + tt) * DV + e] = op; }
            __syncthreads();
            float ov[TPG];
#pragma unroll
            for (int j = 0; j < TPG; ++j) { const int tt = dp * TPG + j; float o = 0.f;
#pragma unroll
                for (int p = 0; p < NDP; ++p) o += ored[(p * 16 + tt) * DV + e];
                ov[j] = o; const float sq = wave_sum(o * o); if (lane == 0) wred[wave * TPG + j] = sq; }
            __syncthreads();
#pragma unroll
            for (int j = 0; j < TPG; ++j) { const int tt = dp * TPG + j; float tot = 0.f;
#pragma unroll
                for (int w = 0; w < NWG; ++w) tot += wred[(dp * NWG + w) * TPG + j];
                const float rs = 1.0f / sqrtf(tot * (1.0f / DV) + EPS); const size_t tok = (size_t)(b * SEQ + t0 + tt);
                const float g = bf2f(u[UOFF((int)tok, goff + head * DV + e, pitch)]);
                mix[tok * 2048 + mixoff + head * DV + e] = f2bf(ov[j] * rs * gain[e] * (g * sigmoidf(g))); }
            __syncthreads();
        }
    }
}
__device__ __forceinline__ void ref_cfox(const float* ff, const float* fbias, float* cfox, const int G, const int tid) {
    const int gid = blockIdx.x * 512 + tid;
    if (gid < 64) { const int b = gid >> 3, h = gid & 7; float run = 0.f;
        for (int s = 0; s < SEQ; ++s) { run += log_sigmoid(ff[(size_t)(b * SEQ + s) * 8 + h] + fbias[h]); cfox[(size_t)gid * SEQ + s] = run; } }
}
__device__ __forceinline__ void ref_att(LAS unsigned char* lds, const int tid, const int G, const int mode, const bf16* u, const int pitch, const int qoff, const int koff, const int voff,
                                        bf16* mix, const int mixoff, const float* kmean, const float* cfox) {
    const int lane = tid & 63, wave = tid >> 6;
    LAS float* qf = (LAS float*)lds + wave * 128;
    for (int rowid = blockIdx.x * NWAVES + wave; rowid < NB * 8 * SEQ; rowid += G * NWAVES) {
        const int b = rowid >> 14, h = (rowid >> 11) & 7, t = rowid & 2047, j = t >> 8;
        const unsigned qq = *(const unsigned*)(u + UOFF(b * SEQ + t, qoff + h * 128 + 2 * lane, pitch));
        const float q0 = __uint_as_float(qq << 16), q1 = __uint_as_float(qq & 0xffff0000u);
        qf[2 * lane] = q0; qf[2 * lane + 1] = q1;
        unsigned bits = 0xffu;
        if (mode == 0) {
            float gate[7];
#pragma unroll
            for (int n = 0; n < 7; ++n) { const float* km = kmean + (size_t)((b * 8 + h) * 8 + n) * 128; gate[n] = wave_sum(q0 * km[2 * lane] + q1 * km[2 * lane + 1]); }
            if (j <= 3) bits = (1u << j) - 1u;
            else { bits = 0u;
#pragma unroll
                for (int pick = 0; pick < 3; ++pick) { float best = -__builtin_inff(); int bi = 0;
#pragma unroll
                    for (int n = 0; n < 7; ++n) if (n < j && !((bits >> n) & 1u) && gate[n] > best) { best = gate[n]; bi = n; }
                    bits |= 1u << bi; } }
        }
        const float slope = exp2f(-(float)(h + 1));
        const float ct = mode ? cfox[(size_t)(b * 8 + h) * SEQ + t] : 0.f;
        float m = -1e30f, l = 0.f, o0 = 0.f, o1 = 0.f;
        for (int kb = 0; kb <= t; kb += 64) {
            const int s = kb + lane; const int sc = s <= t ? s : t;
            bool valid = s <= t;
            if (mode == 0 && valid) { const int n = s >> 8; valid = (n == j) || ((bits >> n) & 1u); }
            float dot = 0.f;
            for (int c = 0; c < 16; ++c) { const bf16x8 kv = *(const bf16x8*)(u + UOFF(b * SEQ + sc, koff + h * 128 + 8 * c, pitch));
#pragma unroll
                for (int e = 0; e < 8; ++e) dot += qf[8 * c + e] * bf2f((unsigned short)kv[e]); }
            const float bias = mode ? (ct - cfox[(size_t)(b * 8 + h) * SEQ + sc]) : -slope * (float)(t - sc);
            const float logit = valid ? dot * QSCALE + bias : -__builtin_inff();
            const float mx = wave_max(logit), mnew = fmaxf(m, mx), alpha = expf(m - mnew);
            const float p = valid ? expf(logit - mnew) : 0.f;
            l = l * alpha + wave_sum(p); o0 *= alpha; o1 *= alpha; m = mnew;
            const int nk = (t - kb + 1) < 64 ? (t - kb + 1) : 64;
            for (int jj = 0; jj < nk; ++jj) { const float pj = __shfl(p, jj); const unsigned vv = *(const unsigned*)(u + UOFF(b * SEQ + kb + jj, voff + h * 128 + 2 * lane, pitch));
                o0 += pj * __uint_as_float(vv << 16); o1 += pj * __uint_as_float(vv & 0xffff0000u); }
        }
        const float inv = 1.0f / l;
        *(unsigned*)(mix + (size_t)(b * SEQ + t) * 2048 + mixoff + h * 128 + 2 * lane) = cvtpk(o0 * inv, o1 * inv);
    }
}

#ifndef ONE_LAUNCH
#define ONE_LAUNCH 1
#endif
#ifndef REF_LIN0
#define REF_LIN0 0
#endif
#ifndef REF_LIN1
#define REF_LIN1 0
#endif
#ifndef REF_ATT0
#define REF_ATT0 0
#endif
#ifndef REF_ATT1
#define REF_ATT1 0
#endif
#ifndef PROBES
#define PROBES 0
#endif
#if PROBES
#define KV(x) (K->variant & (x))
#else
#define KV(x) 0
#endif
#ifndef PG_SP2
#define PG_SP2 true
#endif
#ifndef PG_ALIGN
#define PG_ALIGN true
#endif
#ifndef STAGGER_STEPS
#define STAGGER_STEPS 0
#endif
#define STAGGER() do { if (STAGGER_STEPS > 0) { const int n_ = (int)((blockIdx.x >> 3) & 15u); for (int i_ = 0; i_ < n_; ++i_) __builtin_amdgcn_s_sleep(STAGGER_STEPS); } } while (0)
constexpr int N_PHASES = 20;
__global__ void __launch_bounds__(NWAVES * 64, 2) fwd(Args a_unused) {
    extern __shared__ __attribute__((aligned(16))) unsigned char lds_raw[];
    LAS unsigned char* lds = (LAS unsigned char*)lds_raw;
    volatile LAS unsigned* MISC = (volatile LAS unsigned*)(lds + MISC_OFF);
    const int G = gridDim.x;
    if (threadIdx.x < 64) MISC[threadIdx.x] = 0u;
    __syncthreads();
    int lo, hi;
    XcdBarrier bar;
    { KArgsP K = kargs(); lo = K->ph_lo; hi = K->ph_hi; unsigned char* ws = K->ws;
      bar.bar = (unsigned*)(ws + WS_CTL) + CW_BAR; bar.x = 0; bar.st = nullptr;
      if (hi - lo > 1) bar = xcd_barrier_post((unsigned*)(ws + WS_CTL) + CW_BAR, MISC + 8); }
#define PH(k) (lo <= (k) && (k) < hi)
#ifndef SEAM_REPS
#define SEAM_REPS 1
#endif
#define SEAM(k) do { if (PH(k) && PH((k) + 1)) { for (int r_ = 0; r_ < SEAM_REPS; ++r_) xcd_barrier(bar); } } while (0)
#define WSP(T, off) ((T*)(ws + (off)))

    if (PH(0)) { KArgsP K = kargs(); const int tid = otid(), lane = tid & 63, wave = __builtin_amdgcn_readfirstlane(tid >> 6); (void)lane; (void)wave; if (!KV(32)) phase_transposes(lds, K, G, wave, lane); __syncthreads(); if (!KV(64)) phase_norm0(lds, K, G, tid, wave, lane); __syncthreads(); }
    SEAM(0);
    for (int layer = 0; layer < 2; ++layer) {
        const int pb = 1 + 9 * layer;
        if (PH(pb + 0)) {
            KArgsP K = kargs(); const int tid = otid(), lane = tid & 63, wave = __builtin_amdgcn_readfirstlane(tid >> 6); (void)lane; (void)wave; unsigned char* ws = K->ws; const int NU = layer ? NU1 : NU0;
            const bf16* h16 = (const bf16*)((unsigned char*)K->out + OUT_H16);
            if (layer == 1) phase_ff(lds, K->in[11], K->in[10], h16, WSP(float, WS_ROWSS2), WSP(float, WS_FF), G, tid, wave, lane);
            pg8::Gemm g{h16, WSP(bf16, layer ? WS_WIN1 : WS_WIN0), MTOK, NU, DM, KV(4), 1}; pg8::StaticOrder S; S.init(MTOK, NU, G, (int)blockIdx.x);
            int pm0 = -1; { pg8::Unit u0; if (S.next(0, u0)) pm0 = u0.pm; }
            LAS float* rtab = (LAS float*)(lds + 131072);
            if (pm0 >= 0 && tid < 256) { const f32x4* pp = (const f32x4*)(WSP(float, layer ? WS_ROWSS2 : WS_ROWSS) + (size_t)(pm0 * 256 + tid) * 32); float sq = 0.f;
#pragma unroll
                for (int q = 0; q < 8; ++q) { const f32x4 t = pp[q]; sq += (t[0] + t[1]) + (t[2] + t[3]); }
                rtab[tid] = __builtin_amdgcn_rsqf(sq * (1.0f / 2048.0f) + EPS); }
            __syncthreads();
            pg8::EpiScale<0, UTILED != 0> E{WSP(bf16, WS_U), NU, WSP(float, layer ? WS_ROWSS2 : WS_ROWSS), 0, rtab, pm0};
            STAGGER();
            pg8::gemm_phase<pg8::EpiScale<0, UTILED != 0>, pg8::StaticOrder, PG_ALIGN, PG_SP2>(lds, g, S, E);
        }
        SEAM(pb + 0);
        if (PH(pb + 1)) {
            KArgsP K = kargs(); const int tid = otid(), lane = tid & 63, wave = __builtin_amdgcn_readfirstlane(tid >> 6); (void)lane; (void)wave; unsigned char* ws = K->ws;
            if (layer == 0) {
                phase_kmean(lds, WSP(bf16, WS_U), WSP(float, WS_KMEAN), G, tid);
#if !REF_LIN0
                LinArgs L{WSP(bf16, WS_U), NU0, C0_GQ, C0_GK, C0_GV, C0_GG, WSP(float, WS_BCUM), nullptr, K->in[5], WSP(float, WS_P), WSP(float, WS_DSC), WSP(bf16, WS_S), WSP(bf16, WS_P), 0};
                for (int unit = blockIdx.x; unit < 256; unit += G) { const int sc = unit & 7; if (sc < 7) lin_unit<256, 8, false, false>(lds, tid, L, unit >> 5, (unit >> 3) & 3, sc); }
#endif
            } else {
#if !REF_LIN1
                LinArgs L{WSP(bf16, WS_U), NU1, C1_HQ, C1_HF, C1_HI, C1_HG, nullptr, K->in[18], K->in[13], WSP(float, WS_P), WSP(float, WS_DSC), WSP(bf16, WS_S), WSP(bf16, WS_P), 1024};
                for (int unit = blockIdx.x; unit < 256; unit += G) { const int sc = unit & 7; if (sc < 7) lin_unit<128, 4, true, false>(lds, tid, L, unit >> 5, 2 * ((unit >> 3) & 3), sc); }
#endif
            }
        }
        SEAM(pb + 1);
        if (PH(pb + 2)) {
            KArgsP K = kargs(); const int tid = otid(), lane = tid & 63, wave = __builtin_amdgcn_readfirstlane(tid >> 6); (void)lane; (void)wave; unsigned char* ws = K->ws; (void)ws;
#ifdef PROBE_BURN
            if (KV(16)) {
                const bf16x8 a0 = *(const bf16x8*)(WSP(bf16, WS_U) + (size_t)tid * 64), b0 = *(const bf16x8*)(WSP(bf16, WS_U) + (size_t)tid * 64 + 8);
                const bf16x8 a1 = *(const bf16x8*)(WSP(bf16, WS_U) + (size_t)tid * 64 + 16), b1 = *(const bf16x8*)(WSP(bf16, WS_U) + (size_t)tid * 64 + 24);
                f32x4 acc[16];
#pragma unroll
                for (int i = 0; i < 16; ++i) acc[i] = (f32x4){0.f, 0.f, 0.f, 0.f};
                for (int it = 0; it < 32768 / 16; ++it) {
#pragma unroll
                    for (int i = 0; i < 16; ++i) acc[i] = __builtin_amdgcn_mfma_f32_16x16x32_bf16((i & 1) ? a1 : a0, (i & 2) ? b1 : b0, acc[i], 0, 0, 0);
                }
                float sum = 0.f;
#pragma unroll
                for (int i = 0; i < 16; ++i) sum += acc[i][0] + acc[i][1] + acc[i][2] + acc[i][3];
                if (sum == 1.2345f) WSP(float, WS_CFOX)[tid] = sum;
            } else
#endif
            if (layer == 0) {
#if !REF_LIN0
                phase_scan<256>(WSP(float, WS_P), WSP(float, WS_DSC), WSP(bf16, WS_S), G, tid);
#endif
            } else {
#if !REF_LIN1
                phase_scan<128>(WSP(float, WS_P), WSP(float, WS_DSC), WSP(bf16, WS_S), G, tid);
#endif
#if REF_ATT1
                ref_cfox(WSP(float, WS_FF), K->in[12], WSP(float, WS_CFOX), G, tid);
#endif
            }
        }
        SEAM(pb + 2);
        if (PH(pb + 3)) {
            KArgsP K = kargs(); const int tid = otid(), lane = tid & 63, wave = __builtin_amdgcn_readfirstlane(tid >> 6); (void)lane; (void)wave; unsigned char* ws = K->ws;
            const int variant = KV(0xff);
            if (variant & 1) {} else
            if (layer == 0) {
#if REF_LIN0
                ref_lin<256, false>(lds, tid, G, WSP(bf16, WS_U), NU0, C0_GQ, C0_GK, C0_GV, C0_GG, WSP(float, WS_GLR), K->in[3], K->in[4], nullptr, K->in[5], WSP(bf16, WS_P), 0);
#else
                { LinArgs L{WSP(bf16, WS_U), NU0, C0_GQ, C0_GK, C0_GV, C0_GG, WSP(float, WS_BCUM), nullptr, K->in[5], WSP(float, WS_P), WSP(float, WS_DSC), WSP(bf16, WS_S), WSP(bf16, WS_P), 0};
                  for (int unit = blockIdx.x; unit < 256; unit += G) lin_unit<256, 8, false, true>(lds, tid, L, unit >> 5, (unit >> 3) & 3, unit & 7); }
#endif
#if REF_ATT0
                ref_att(lds, tid, G, 0, WSP(bf16, WS_U), NU0, C0_MQ, C0_MK, C0_MV, WSP(bf16, WS_P), 1024, WSP(float, WS_KMEAN), nullptr);
#endif
            } else {
#if REF_LIN1
                ref_lin<128, true>(lds, tid, G, WSP(bf16, WS_U), NU1, C1_HQ, C1_HF, C1_HI, C1_HG, nullptr, nullptr, nullptr, K->in[18], K->in[13], WSP(bf16, WS_P), 1024);
#else
                { LinArgs L{WSP(bf16, WS_U), NU1, C1_HQ, C1_HF, C1_HI, C1_HG, nullptr, K->in[18], K->in[13], WSP(float, WS_P), WSP(float, WS_DSC), WSP(bf16, WS_S), WSP(bf16, WS_P), 1024};
                  for (int unit = blockIdx.x; unit < 256; unit += G) lin_unit<128, 4, true, true>(lds, tid, L, unit >> 5, 2 * ((unit >> 3) & 3), unit & 7); }
#endif
#if REF_ATT1
                ref_att(lds, tid, G, 1, WSP(bf16, WS_U), NU1, C1_FQ, C1_FK, C1_FV, WSP(bf16, WS_P), 0, nullptr, WSP(float, WS_CFOX));
#endif
            }
            if (!(variant & 2) && ((layer == 0 && !REF_ATT0) || (layer == 1 && !REF_ATT1))) {
                const int pitch = layer ? NU1 : NU0, qoff = layer ? C1_FQ : C0_MQ, koff = layer ? C1_FK : C0_MK, voff = layer ? C1_FV : C0_MV, mixoff = layer ? 0 : 1024;
                for (int item = blockIdx.x; item < 256; item += G) att::pair_item((char*)lds_raw, item, layer, WSP(bf16, WS_U), pitch, qoff, koff, voff, WSP(bf16, WS_P), mixoff, WSP(float, WS_KMEAN), WSP(float, WS_FF), K->in[12]);
            }
        }
        SEAM(pb + 3);
        if (PH(pb + 4)) {
            KArgsP K = kargs(); const int tid = otid(), lane = tid & 63, wave = __builtin_amdgcn_readfirstlane(tid >> 6); (void)lane; (void)wave; unsigned char* ws = K->ws;
            pg8::Gemm g{WSP(bf16, WS_P), WSP(bf16, layer ? WS_WOUT1 : WS_WOUT0), MTOK, DM, DM, 0, 0}; pg8::StaticOrder S; S.init(MTOK, DM, G, (int)blockIdx.x);
            bf16* h16 = (bf16*)((unsigned char*)K->out + OUT_H16);
            if (layer == 0) { pg8::EpiResid<true, false> E{K->in[0], h16, WSP(float, WS_ROWSS), 0, nullptr}; pg8::gemm_phase<pg8::EpiResid<true, false>, pg8::StaticOrder, PG_ALIGN, PG_SP2>(lds, g, S, E); }
            else { pg8::EpiResid<false, false> E{h16, h16, WSP(float, WS_ROWSS), 0, nullptr}; pg8::gemm_phase<pg8::EpiResid<false, false>, pg8::StaticOrder, PG_ALIGN, PG_SP2>(lds, g, S, E); }
        }
        SEAM(pb + 4);
        for (int half = 0; half < MLP_SPLIT; ++half) {
            if (PH(pb + 5 + 2 * half)) {
                KArgsP K = kargs(); const int tid = otid(), lane = tid & 63, wave = __builtin_amdgcn_readfirstlane(tid >> 6); (void)lane; (void)wave; unsigned char* ws = K->ws;
                pg8::Gemm g{(const bf16*)((unsigned char*)K->out + OUT_H16) + (size_t)half * MHALF * DM, WSP(bf16, layer ? WS_WUP1 : WS_WUP0), MHALF, DFF, DM, KV(4), 1}; pg8::StaticOrder S; S.init(MHALF, DFF, G, (int)blockIdx.x);
                pg8::EpiSqRelu E{WSP(bf16, WS_HID), DFF};
                STAGGER();
#ifdef PROBE_EPINULL
                if (KV(8)) { pg8::EpiSqReluNS E0{WSP(bf16, WS_HID), DFF}; pg8::gemm_phase<pg8::EpiSqReluNS, pg8::StaticOrder, PG_ALIGN, PG_SP2>(lds, g, S, E0); } else
#endif
                pg8::gemm_phase<pg8::EpiSqRelu, pg8::StaticOrder, PG_ALIGN, PG_SP2>(lds, g, S, E);
            }
            SEAM(pb + 5 + 2 * half);
            if (PH(pb + 6 + 2 * half)) {
                KArgsP K = kargs(); const int tid = otid(), lane = tid & 63, wave = __builtin_amdgcn_readfirstlane(tid >> 6); (void)lane; (void)wave; unsigned char* ws = K->ws;
                pg8::Gemm g{WSP(bf16, WS_HID), WSP(bf16, layer ? WS_WDN1 : WS_WDN0), MHALF, DM, DFF, 0, 1}; pg8::StaticOrder S; S.init(MHALF, DM, G, (int)blockIdx.x);
                bf16* h16 = (bf16*)((unsigned char*)K->out + OUT_H16);
                pg8::EpiResid<false, true> E{h16, layer ? WSP(bf16, WS_HFIN) : h16, WSP(float, WS_ROWSS2), half * MHALF, WSP(float, WS_ROWSS)};
                pg8::gemm_phase<pg8::EpiResid<false, true>, pg8::StaticOrder, PG_ALIGN, PG_SP2>(lds, g, S, E);
            }
            SEAM(pb + 6 + 2 * half);
        }
    }
    if (PH(19)) { KArgsP K = kargs(); const int tid = otid(), lane = tid & 63, wave = __builtin_amdgcn_readfirstlane(tid >> 6); (void)lane; (void)wave; unsigned char* ws = K->ws; phase_final_norm(WSP(bf16, WS_HFIN), K->out, K->in[19], WSP(float, WS_ROWSS2), G, wave, lane); }
#undef PH
#undef SEAM
#undef WSP
}

extern "C" void kernel_launch(void* const* d_in, const int* in_sizes, int n_in, void* d_out, int out_size, void* d_ws, size_t ws_size, hipStream_t stream) {
    static int grid = 0;
    if (grid == 0) {
        if (n_in != 20 || in_sizes[0] != MTOK * DM || out_size != MTOK * DM || ws_size < WS_END) {
            fprintf(stderr, "kernel_launch: unexpected problem (n_in %d, in0 %d, out %d, ws %zu; need ws >= %zu); nothing launched\n", n_in, n_in > 0 ? in_sizes[0] : -1, out_size, ws_size, (size_t)WS_END); grid = -1; return; }
        int dev = 0, cus = 0, per_cu = 0;
        if (hipGetDevice(&dev) != hipSuccess || hipDeviceGetAttribute(&cus, hipDeviceAttributeMultiprocessorCount, dev) != hipSuccess) { fprintf(stderr, "kernel_launch: device query failed\n"); grid = -1; return; }
        if (hipFuncSetAttribute((const void*)fwd, hipFuncAttributeMaxDynamicSharedMemorySize, LDS_BYTES) != hipSuccess) { fprintf(stderr, "kernel_launch: hipFuncSetAttribute failed\n"); grid = -1; return; }
        if (hipOccupancyMaxActiveBlocksPerMultiprocessor(&per_cu, (const void*)fwd, NWAVES * 64, LDS_BYTES) != hipSuccess || per_cu < 1)
            fprintf(stderr, "kernel_launch: note: occupancy query reports %d workgroups per CU\n", per_cu);
        (void)hipGetLastError();
        grid = cus;
    }
    if (grid < 0) return;
    if (hipMemsetAsync((char*)d_ws + WS_CTL, 0, CTL_ZERO_BYTES, stream) != hipSuccess) { fprintf(stderr, "kernel_launch: memset failed\n"); return; }
    Args a{};
    for (int i = 0; i < 20; ++i) a.in[i] = (const float*)d_in[i];
    a.out = (float*)d_out; a.ws = (unsigned char*)d_ws;
#if ONE_LAUNCH
    a.ph_lo = 0; a.ph_hi = N_PHASES;
    hipLaunchKernelGGL(fwd, dim3(grid), dim3(NWAVES * 64), LDS_BYTES, stream, a);
#else
#ifndef REPEAT_MASK
#define REPEAT_MASK 0u
#endif
#ifndef REPEAT_VARIANT
#define REPEAT_VARIANT 0
#endif
    for (int p = 0; p < N_PHASES; ++p) { a.ph_lo = p; a.ph_hi = p + 1;
        if ((REPEAT_MASK >> p) & 1u) { a.variant = REPEAT_VARIANT; hipLaunchKernelGGL(fwd, dim3(grid), dim3(NWAVES * 64), LDS_BYTES, stream, a); a.variant = 0; }
        hipLaunchKernelGGL(fwd, dim3(grid), dim3(NWAVES * 64), LDS_BYTES, stream, a); }
#endif
    const hipError_t le = hipPeekAtLastError();
    if (le != hipSuccess) fprintf(stderr, "kernel_launch: launch failed: %s\n", hipGetErrorName(le));
}
```

```cpp
#include <hip/hip_runtime.h>
#include <cstdio>
#include <cstdint>
#include <cmath>
__device__ __forceinline__ int otid() { int t = threadIdx.x; asm volatile("" : "+v"(t)); return t; }
#define ONE_LAUNCH 1
namespace pg8 {
#define PG8_LAS __attribute__((address_space(3)))
typedef unsigned short bf16_t;
typedef short bf16x8 __attribute__((ext_vector_type(8)));
typedef float f32x4 __attribute__((ext_vector_type(4)));
typedef unsigned u32x4 __attribute__((ext_vector_type(4)));
constexpr int BM = 256, BK = 64, HALF = 128, HTB = HALF * BK * 2  , STAGE_BYTES = 8 * HTB, NXCD = 8, WGM = 8;

__host__ __device__ __forceinline__ int lds_byte(int r, int c) { const int st = (r >> 4) * 2 + (c >> 5), rr = r & 15, cc = c & 31, ob = rr * 64 + cc * 2; return st * 1024 + (ob ^ (((ob >> 9) & 1) << 5)); }
__host__ __device__ __forceinline__ void stage_rc(int b, int& R, int& C) { const int st = b / 1024, sb = b % 1024, swz = sb ^ (((sb >> 9) & 1) << 5); R = (st >> 1) * 16 + swz / 64; C = (st & 1) * 32 + (swz % 64) / 2; }
__host__ __device__ __forceinline__ int perm32(int rho) { const int n = rho >> 4, i = rho & 15; return 8 * (i >> 2) + 4 * n + (i & 3); }

struct Unit { int pm, pn; };
struct Gemm { const bf16_t* A; const bf16_t* Bt; int M, N, K; int sp; int atile; int btile; };

struct StaticOrder {
    int nM, nN, nwg, G, c;
    __host__ __device__ void init(int M, int N, int G_, int c_) { nM = M / BM; nN = N / BM; nwg = nM * nN; G = G_; c = c_; }
    __host__ __device__ __forceinline__ bool next(int i, Unit& u) const {
        const long L = (long)i * G + c; if (L >= nwg) return false;
        int wgid = (int)L; { const int q = nwg / NXCD, r = nwg % NXCD, xcd = wgid % NXCD, off = wgid / NXCD; wgid = (xcd < r ? xcd * (q + 1) : r * (q + 1) + (xcd - r) * q) + off; }
        const int nig = WGM * nN, gid = wgid / nig, fm = gid * WGM, gsz = (nM - fm) < WGM ? (nM - fm) : WGM;
        u.pm = fm + ((wgid % nig) % gsz); u.pn = (wgid % nig) / gsz; return true;
    }
    __device__ __forceinline__ void a_ready(const Unit&) const {}
    __device__ __forceinline__ void done(const Unit&) const {}
};
__device__ __forceinline__ unsigned cvt_pk_bf16(float lo, float hi) { unsigned r; asm volatile("v_cvt_pk_bf16_f32 %0, %1, %2" : "=v"(r) : "v"(lo), "v"(hi)); return r; }
#ifndef PG_EPIWAIT
#define PG_EPIWAIT 0
#endif
#define EPI_FENCE() asm volatile("" ::: "memory")
__host__ __device__ __forceinline__ unsigned atile_off(int R, int C) { return (unsigned)(((((R >> 6) * 2 + (C >> 5)) * 4 + ((R >> 4) & 3)) * 1024) + (((R & 15) * 4 + ((C >> 3) & 3)) * 16) + (C & 7) * 2); }
constexpr float RMS_EPS = 1e-6f;
template <int ACT, bool TILED> struct EpiScale {
    static constexpr bool PERM = true, AFTER_DRAIN = false; static constexpr int NVM = 16;
    bf16_t* O; int ldc; const float* rowss; int row_base;
    const PG8_LAS float* tab; int tab_pm;
    __device__ __forceinline__ void operator()(const f32x4 (&acc)[2][2][4][2], const Unit& u, int wr, int wc, int fr, int fq) const {
        const int lrow0 = u.pm * BM + wr * 64 + fr; const int col0 = u.pn * BM + wc * 32 + 8 * fq;
        float rsv[2][4];
        if (u.pm == tab_pm) {
#pragma unroll
            for (int ai = 0; ai < 2; ++ai)
#pragma unroll
                for (int m = 0; m < 4; ++m) rsv[ai][m] = tab[wr * 64 + fr + ai * HALF + m * 16];
        } else {
#pragma unroll
            for (int ai = 0; ai < 2; ++ai)
#pragma unroll
                for (int m = 0; m < 4; ++m) { const f32x4* pp = (const f32x4*)(rowss + (size_t)(row_base + lrow0 + ai * HALF + m * 16) * 32 + 8 * fq); const f32x4 t0 = pp[0], t1 = pp[1];
                    float s = ((t0[0] + t0[1]) + (t0[2] + t0[3])) + ((t1[0] + t1[1]) + (t1[2] + t1[3]));
                    s += __shfl_xor(s, 16); s += __shfl_xor(s, 32); rsv[ai][m] = __builtin_amdgcn_rsqf(s * (1.0f / 2048.0f) + RMS_EPS); EPI_FENCE(); }
        }
#pragma unroll
        for (int ai = 0; ai < 2; ++ai)
#pragma unroll
            for (int m = 0; m < 4; ++m) { const int lrow = lrow0 + ai * HALF + m * 16;
                const float rs = rsv[ai][m];
                bf16_t* rowp = O + (size_t)lrow * ldc + col0;
#pragma unroll
                for (int bj = 0; bj < 2; ++bj) { f32x4 v0 = acc[ai][bj][m][0] * rs, v1 = acc[ai][bj][m][1] * rs;
                    if (ACT == 1) {
#pragma unroll
                        for (int e = 0; e < 4; ++e) { const float a = fmaxf(v0[e], 0.f), b = fmaxf(v1[e], 0.f); v0[e] = a * a; v1[e] = b * b; } }
                    u32x4 w; w.x = cvt_pk_bf16(v0[0], v0[1]); w.y = cvt_pk_bf16(v0[2], v0[3]); w.z = cvt_pk_bf16(v1[0], v1[1]); w.w = cvt_pk_bf16(v1[2], v1[3]);
                    if (TILED) *(u32x4*)((unsigned char*)O + ((size_t)(u.pm * 2 + ai) * (ldc >> 6) + (u.pn * 4 + bj * 2 + (wc >> 1))) * 16384 + ((wr * 2 + (wc & 1)) * 4 + m) * 1024 + (fr * 4 + fq) * 16) = w;
                    else *(u32x4*)(rowp + bj * HALF) = w; } }
    }
};
struct EpiSqRelu {
    static constexpr bool PERM = true, AFTER_DRAIN = false; static constexpr int NVM = 16;
    bf16_t* O; int ldc;
    __device__ __forceinline__ void operator()(const f32x4 (&acc)[2][2][4][2], const Unit& u, int wr, int wc, int fr, int fq) const {
        const int ktn = ldc >> 6;
#pragma unroll
        for (int ai = 0; ai < 2; ++ai)
#pragma unroll
            for (int bj = 0; bj < 2; ++bj) { unsigned char* tile = (unsigned char*)O + ((size_t)(u.pm * 2 + ai) * ktn + (u.pn * 4 + bj * 2 + (wc >> 1))) * 16384 + ((wr * 2 + (wc & 1)) * 4) * 1024 + (fr * 4 + fq) * 16;
#pragma unroll
                for (int m = 0; m < 4; ++m) { f32x4 v0 = acc[ai][bj][m][0], v1 = acc[ai][bj][m][1];
#pragma unroll
                    for (int e = 0; e < 4; ++e) { float a, b; asm("v_max_f32_e32 %0, 0, %1" : "=v"(a) : "v"(v0[e])); asm("v_max_f32_e32 %0, 0, %1" : "=v"(b) : "v"(v1[e])); v0[e] = a * a; v1[e] = b * b; }
                    u32x4 w; w.x = cvt_pk_bf16(v0[0], v0[1]); w.y = cvt_pk_bf16(v0[2], v0[3]); w.z = cvt_pk_bf16(v1[0], v1[1]); w.w = cvt_pk_bf16(v1[2], v1[3]);
                    *(u32x4*)(tile + m * 1024) = w; } }
    }
};
struct EpiSqReluNS {
    static constexpr bool PERM = true, AFTER_DRAIN = false; static constexpr int NVM = 0;
    bf16_t* O; int ldc;
    __device__ __forceinline__ void operator()(const f32x4 (&acc)[2][2][4][2], const Unit& u, int wr, int wc, int fr, int fq) const {
        const int lrow0 = u.pm * BM + wr * 64 + fr; const int col0 = u.pn * BM + wc * 32 + 8 * fq;
#pragma unroll
        for (int ai = 0; ai < 2; ++ai)
#pragma unroll
            for (int m = 0; m < 4; ++m) { bf16_t* rowp = O + (size_t)(lrow0 + ai * HALF + m * 16) * ldc + col0;
#pragma unroll
                for (int bj = 0; bj < 2; ++bj) { f32x4 v0 = acc[ai][bj][m][0], v1 = acc[ai][bj][m][1];
#pragma unroll
                    for (int e = 0; e < 4; ++e) { float a, b; asm("v_max_f32_e32 %0, 0, %1" : "=v"(a) : "v"(v0[e])); asm("v_max_f32_e32 %0, 0, %1" : "=v"(b) : "v"(v1[e])); v0[e] = a * a; v1[e] = b * b; }
                    u32x4 w; w.x = cvt_pk_bf16(v0[0], v0[1]); w.y = cvt_pk_bf16(v0[2], v0[3]); w.z = cvt_pk_bf16(v1[0], v1[1]); w.w = cvt_pk_bf16(v1[2], v1[3]);
                    *(u32x4*)(O + (((size_t)(u.pm * 32 + u.pn) * 8 + (wr * 4 + wc)) * 16 + (ai * 8 + m * 2 + bj)) * 512 + (fq * 16 + fr) * 8) = w;     } }
    }
};
template <bool F32IN, bool RS2> struct EpiResid {
    static constexpr bool PERM = true, AFTER_DRAIN = false; static constexpr int NVM = 16;
    const void* hin; bf16_t* hout; float* rowss; int row_base; const float* rowss_in;
    __device__ __forceinline__ void operator()(const f32x4 (&acc)[2][2][4][2], const Unit& u, int wr, int wc, int fr, int fq) const {
        const int row0 = row_base + u.pm * BM + wr * 64 + fr; const int col0 = u.pn * BM + wc * 32 + 8 * fq;
        const size_t tb0 = ((size_t)((row_base >> 7) + u.pm * 2) * 32 + (u.pn * 4 + (wc >> 1))) * 16384 + ((wr * 2 + (wc & 1)) * 4) * 1024 + (fr * 4 + fq) * 16;
#define EPI_TOFF(ai_, m_, bj_) (tb0 + ((size_t)(ai_) * 32 + (bj_) * 2) * 16384 + (m_) * 1024)
        float rs2[2][4];
        if (RS2) { f32x4 pr[2][4][2];
#pragma unroll
            for (int ai = 0; ai < 2; ++ai)
#pragma unroll
                for (int m = 0; m < 4; ++m) { const f32x4* pp = (const f32x4*)(rowss_in + (size_t)(row0 + ai * HALF + m * 16) * 32 + 8 * fq); pr[ai][m][0] = pp[0]; pr[ai][m][1] = pp[1]; }
            EPI_FENCE();
#pragma unroll
            for (int ai = 0; ai < 2; ++ai)
#pragma unroll
                for (int m = 0; m < 4; ++m) { const f32x4 t0 = pr[ai][m][0], t1 = pr[ai][m][1]; float sq = ((t0[0] + t0[1]) + (t0[2] + t0[3])) + ((t1[0] + t1[1]) + (t1[2] + t1[3]));
                    sq += __shfl_xor(sq, 16); sq += __shfl_xor(sq, 32); rs2[ai][m] = __builtin_amdgcn_rcpf(sq * (1.0f / 2048.0f) + RMS_EPS); }
        }
        f32x4 hb[2][2][2][2];
#define EPI_LOAD(buf, k) do { _Pragma("unroll") for (int q_ = 0; q_ < 2; ++q_) { const int ai_ = (k) >> 1, m_ = 2 * ((k) & 1) + q_;                                                                          \
            _Pragma("unroll") for (int bj = 0; bj < 2; ++bj) {                                                                                                                                                  \
                if (F32IN) { const float* p_ = (const float*)hin + (size_t)(row0 + ai_ * HALF + m_ * 16) * 2048 + col0 + bj * HALF; hb[buf][q_][bj][0] = *(const f32x4*)p_; hb[buf][q_][bj][1] = *(const f32x4*)(p_ + 4); } \
                else { const u32x4 t_ = *(const u32x4*)((const unsigned char*)hin + EPI_TOFF(ai_, m_, bj));                                                                                                   \
                       hb[buf][q_][bj][0] = (f32x4){__uint_as_float(t_.x << 16), __uint_as_float(t_.x & 0xffff0000u), __uint_as_float(t_.y << 16), __uint_as_float(t_.y & 0xffff0000u)};                         \
                       hb[buf][q_][bj][1] = (f32x4){__uint_as_float(t_.z << 16), __uint_as_float(t_.z & 0xffff0000u), __uint_as_float(t_.w << 16), __uint_as_float(t_.w & 0xffff0000u)}; } } } } while (0)
        EPI_LOAD(0, 0); EPI_FENCE();
#pragma unroll
        for (int k = 0; k < 4; ++k) {
            if (k < 3) { if (k & 1) EPI_LOAD(0, k + 1); else EPI_LOAD(1, k + 1); }
            EPI_FENCE();
#pragma unroll
            for (int q = 0; q < 2; ++q) { const int ai = k >> 1, m = 2 * (k & 1) + q; const int row = row0 + ai * HALF + m * 16; float ss = 0.f;
#pragma unroll
                for (int bj = 0; bj < 2; ++bj) {
                    const f32x4 v0 = (RS2 ? acc[ai][bj][m][0] * rs2[ai][m] : acc[ai][bj][m][0]) + hb[k & 1][q][bj][0], v1 = (RS2 ? acc[ai][bj][m][1] * rs2[ai][m] : acc[ai][bj][m][1]) + hb[k & 1][q][bj][1];
                    u32x4 p; p.x = cvt_pk_bf16(v0[0], v0[1]); p.y = cvt_pk_bf16(v0[2], v0[3]); p.z = cvt_pk_bf16(v1[0], v1[1]); p.w = cvt_pk_bf16(v1[2], v1[3]);
                    *(u32x4*)((unsigned char*)hout + EPI_TOFF(ai, m, bj)) = p;
                    const float r0 = __uint_as_float(p.x << 16), r1 = __uint_as_float(p.x & 0xffff0000u), r2 = __uint_as_float(p.y << 16), r3 = __uint_as_float(p.y & 0xffff0000u);
                    const float r4 = __uint_as_float(p.z << 16), r5 = __uint_as_float(p.z & 0xffff0000u), r6 = __uint_as_float(p.w << 16), r7 = __uint_as_float(p.w & 0xffff0000u);
                    ss += ((r0 * r0 + r1 * r1) + (r2 * r2 + r3 * r3)) + ((r4 * r4 + r5 * r5) + (r6 * r6 + r7 * r7)); }
                ss += __shfl_xor(ss, 16); ss += __shfl_xor(ss, 32);
                if (fq == 0) rowss[(size_t)row * 32 + u.pn * 4 + wc] = ss; }
            EPI_FENCE();
        }
#undef EPI_LOAD
#undef EPI_TOFF
    }
};
struct EpiNull {
    static constexpr bool PERM = true, AFTER_DRAIN = false; static constexpr int NVM = 0;
    __device__ __forceinline__ void operator()(const f32x4 (&acc)[2][2][4][2], const Unit&, int, int, int, int) const {
#pragma unroll
        for (int ai = 0; ai < 2; ++ai)
#pragma unroll
            for (int bj = 0; bj < 2; ++bj)
#pragma unroll
                for (int m = 0; m < 4; ++m)
#pragma unroll
                    for (int n = 0; n < 2; ++n) asm volatile("" :: "v"(acc[ai][bj][m][n]));
    }
};
template <class Epi, class Sched, bool ALIGN_EPI = false, bool SP2 = false>
__device__ __forceinline__ void gemm_phase(PG8_LAS unsigned char* lds, const Gemm g, const Sched& S, const Epi& E) {
    const int tid = otid(), wid = __builtin_amdgcn_readfirstlane(tid >> 6), lane = tid & 63, wr = wid >> 2, wc = wid & 3, fr = lane & 15, fq = lane >> 4;
    const int K = g.K, nt = K / BK;
    unsigned voffA[2], voffB[2];
#pragma unroll
    for (int i = 0; i < 2; ++i) { int R, C; stage_rc(tid * 16 + i * 8192, R, C); const int Rb = Epi::PERM ? ((R & ~31) + perm32(R & 31)) : R;
        voffA[i] = g.atile ? atile_off(R, C) : (unsigned)(R * K + C) * 2u; voffB[i] = g.btile ? atile_off(Rb, C) : (unsigned)(Rb * K + C) * 2u; }
    const size_t kstepB = g.btile ? (size_t)16384 : (size_t)(BK * 2), kstepA = g.atile ? (size_t)16384 : (size_t)(BK * 2);
    const size_t hstepB = (size_t)HALF * K * 2, hstepA = hstepB;
    const size_t tstepB = 2 * hstepB, tstepA = 2 * hstepA;
    const unsigned ldsw = (unsigned)wid * 1024u;
    const int aoff = lds_byte(wr * 64 + fr, fq * 8), boff = lds_byte(wc * 32 + fr, fq * 8);
#define PG8_SA(b, h) (((b) * 2 + (h)) * HTB)
#define PG8_SB(b, h) ((4 + (b) * 2 + (h)) * HTB)
#define PG8_STAGE(bufoff, gbase, voff) do { _Pragma("unroll") for (int _i = 0; _i < 2; ++_i) \
        __builtin_amdgcn_global_load_lds((const unsigned*)((const char*)(gbase) + (voff)[_i]), (PG8_LAS unsigned*)(lds + (bufoff) + ldsw + _i * 8192), 16, 0, 0); } while (0)
#define PG8_LDA(dst, b, h) do { _Pragma("unroll") for (int m = 0; m < 4; ++m) _Pragma("unroll") for (int k = 0; k < 2; ++k) dst[m][k] = *(const PG8_LAS bf16x8*)(lds + PG8_SA(b, h) + aoff + m * 2048 + k * 1024); } while (0)
#define PG8_LDB(dst, b, h) do { _Pragma("unroll") for (int n = 0; n < 2; ++n) _Pragma("unroll") for (int k = 0; k < 2; ++k) dst[n][k] = *(const PG8_LAS bf16x8*)(lds + PG8_SB(b, h) + boff + n * 2048 + k * 1024); } while (0)
#define PG8_MMA(ai, bj, At, Bt) do { __builtin_amdgcn_s_setprio(1); _Pragma("unroll") for (int m = 0; m < 4; ++m) _Pragma("unroll") for (int n = 0; n < 2; ++n) _Pragma("unroll") for (int k = 0; k < 2; ++k) \
        acc[ai][bj][m][n] = __builtin_amdgcn_mfma_f32_16x16x32_bf16(Bt[n][k], At[m][k], acc[ai][bj][m][n], 0, 0, 0); __builtin_amdgcn_s_setprio(0); } while (0)
#define PG8_WAIT_V(n) asm volatile("s_waitcnt vmcnt(" #n ")" ::: "memory")
#define PG8_WAIT_VE do { if (PG_EPIWAIT && Epi::NVM >= 16) asm volatile("s_cmp_eq_u32 %0, 0\n\ts_cbranch_scc1 .LPG8A%=\n\ts_waitcnt vmcnt(24)\n\ts_branch .LPG8B%=\n.LPG8A%=:\n\ts_waitcnt vmcnt(8)\n.LPG8B%=:" :: "s"(epi_first) : "memory", "scc"); else PG8_WAIT_V(8); } while (0)
#define PG8_WAIT_L(n) asm volatile("s_waitcnt lgkmcnt(" #n ")" ::: "memory")
#define PG8_BAR __builtin_amdgcn_s_barrier()
#define PG8_SCHED __builtin_amdgcn_sched_barrier(0)
    Unit cur, nxt; int ui = 0;
    if (!S.next(0, cur)) return;
    f32x4 acc[2][2][4][2];
#pragma unroll
    for (int a = 0; a < 2; ++a)
#pragma unroll
        for (int b = 0; b < 2; ++b)
#pragma unroll
            for (int m = 0; m < 4; ++m)
#pragma unroll
                for (int n = 0; n < 2; ++n) acc[a][b][m][n] = (f32x4){0.f, 0.f, 0.f, 0.f};
    bf16x8 At[4][2], B0[2][2], B1[2][2];
    const char* cA = (const char*)g.A + (size_t)(g.sp ? 0 : cur.pm) * tstepA; const char* cB = (const char*)g.Bt + (size_t)(g.sp ? 0 : cur.pn) * tstepB;
    S.a_ready(cur);
    if constexpr (SP2) {
        PG8_STAGE(PG8_SB(0, 0), cB, voffB); PG8_STAGE(PG8_SB(0, 1), cB + hstepB, voffB); PG8_STAGE(PG8_SA(0, 0), cA, voffA); PG8_STAGE(PG8_SA(0, 1), cA + hstepA, voffA);
        if (wr == 1) PG8_BAR;
        PG8_WAIT_V(2); PG8_BAR;
        PG8_STAGE(PG8_SB(1, 0), cB + kstepB, voffB); PG8_STAGE(PG8_SA(1, 0), cA + kstepA, voffA); PG8_STAGE(PG8_SB(1, 1), cB + hstepB + kstepB, voffB);
        PG8_WAIT_V(6); PG8_BAR;
    } else {
        PG8_STAGE(PG8_SB(0, 0), cB, voffB); PG8_STAGE(PG8_SA(0, 0), cA, voffA); PG8_STAGE(PG8_SB(0, 1), cB + hstepB, voffB); PG8_STAGE(PG8_SA(0, 1), cA + hstepA, voffA);
        if (wr == 1) PG8_BAR;
        PG8_WAIT_V(4); PG8_BAR;
        PG8_STAGE(PG8_SB(1, 0), cB + kstepB, voffB); PG8_STAGE(PG8_SA(1, 0), cA + kstepA, voffA); PG8_STAGE(PG8_SB(1, 1), cB + hstepB + kstepB, voffB);
        PG8_WAIT_V(6); PG8_BAR;
    }
    for (;;) {
        const bool has_next = S.next(ui + 1, nxt);
        const char* nA = has_next ? (const char*)g.A + (size_t)(g.sp ? 0 : nxt.pm) * tstepA : cA; const char* nB = has_next ? (const char*)g.Bt + (size_t)(g.sp ? 0 : nxt.pn) * tstepB : cB;
        for (int t = 0; t < nt; t += 2) {
            const bool last = (t == nt - 2);
            const int epi_first = __builtin_amdgcn_readfirstlane((t == 0 && ui > 0) ? 1 : 0);
            const char* a1 = cA + (size_t)(t + 1) * kstepA;
            const char* a2 = last ? nA : cA + (size_t)(t + 2) * kstepA; const char* b2 = last ? nB : cB + (size_t)(t + 2) * kstepB;
            const char* a3 = a2 + kstepA; const char* b3 = b2 + kstepB;
            if (last && has_next) S.a_ready(nxt);
            if constexpr (SP2) {
            PG8_LDB(B0, 0, 0); PG8_LDB(B1, 0, 1); PG8_SCHED; PG8_LDA(At, 0, 0); PG8_STAGE(PG8_SA(1, 1), a1 + hstepA, voffA);
            PG8_WAIT_VE; PG8_WAIT_L(0); PG8_BAR; PG8_MMA(0, 0, At, B0); PG8_MMA(0, 1, At, B1); PG8_BAR; PG8_SCHED;
            PG8_LDA(At, 0, 1); PG8_STAGE(PG8_SB(0, 0), b2, voffB); PG8_STAGE(PG8_SB(0, 1), b2 + hstepB, voffB); PG8_STAGE(PG8_SA(0, 0), a2, voffA);
            PG8_WAIT_VE; PG8_WAIT_L(0); PG8_BAR; PG8_MMA(1, 0, At, B0); PG8_MMA(1, 1, At, B1); PG8_BAR; PG8_SCHED;
            PG8_LDB(B0, 1, 0); PG8_LDB(B1, 1, 1); PG8_SCHED; PG8_LDA(At, 1, 0); PG8_STAGE(PG8_SA(0, 1), a2 + hstepA, voffA);
            PG8_WAIT_V(8); PG8_WAIT_L(0); PG8_BAR; PG8_MMA(0, 0, At, B0); PG8_MMA(0, 1, At, B1); PG8_BAR; PG8_SCHED;
            PG8_LDA(At, 1, 1); PG8_STAGE(PG8_SB(1, 0), b3, voffB); PG8_STAGE(PG8_SB(1, 1), b3 + hstepB, voffB); PG8_STAGE(PG8_SA(1, 0), a3, voffA);
            PG8_WAIT_V(8); PG8_WAIT_L(0); PG8_BAR; PG8_MMA(1, 0, At, B0); PG8_MMA(1, 1, At, B1); PG8_BAR; PG8_SCHED;
            } else {
            PG8_LDB(B0, 0, 0); PG8_SCHED; PG8_LDA(At, 0, 0); PG8_STAGE(PG8_SA(1, 1), a1 + hstepA, voffA);
            PG8_WAIT_L(8); PG8_BAR; PG8_WAIT_L(0); PG8_MMA(0, 0, At, B0); PG8_BAR; PG8_SCHED;
            PG8_LDB(B1, 0, 1); PG8_STAGE(PG8_SB(0, 0), b2, voffB);
            PG8_BAR; PG8_WAIT_L(0); PG8_MMA(0, 1, At, B1); PG8_BAR;
            PG8_LDA(At, 0, 1); PG8_STAGE(PG8_SA(0, 0), a2, voffA);
            PG8_BAR; PG8_WAIT_L(0); PG8_MMA(1, 0, At, B0); PG8_BAR; PG8_SCHED;
            PG8_STAGE(PG8_SB(0, 1), b2 + hstepB, voffB);
            PG8_WAIT_V(6); PG8_BAR; PG8_MMA(1, 1, At, B1); PG8_BAR;
            PG8_LDB(B0, 1, 0); PG8_SCHED; PG8_LDA(At, 1, 0); PG8_STAGE(PG8_SA(0, 1), a2 + hstepA, voffA);
            PG8_WAIT_L(8); PG8_BAR; PG8_WAIT_L(0); PG8_MMA(0, 0, At, B0); PG8_BAR; PG8_SCHED;
            PG8_LDB(B1, 1, 1); PG8_STAGE(PG8_SB(1, 0), b3, voffB);
            PG8_BAR; PG8_WAIT_L(0); PG8_MMA(0, 1, At, B1); PG8_BAR;
            PG8_LDA(At, 1, 1); PG8_STAGE(PG8_SA(1, 0), a3, voffA);
            PG8_BAR; PG8_WAIT_L(0); PG8_MMA(1, 0, At, B0); PG8_BAR; PG8_SCHED;
            PG8_STAGE(PG8_SB(1, 1), b3 + hstepB, voffB);
            PG8_WAIT_V(6); PG8_BAR; PG8_MMA(1, 1, At, B1); PG8_BAR;
            }
        }
        if constexpr (ALIGN_EPI) { if (wr == 0) PG8_BAR; }
        if constexpr (!Epi::AFTER_DRAIN) { E(acc, cur, wr, wc, fr, fq); S.done(cur); }
        if (!has_next) break;
#pragma unroll
        for (int a = 0; a < 2; ++a)
#pragma unroll
            for (int b = 0; b < 2; ++b)
#pragma unroll
                for (int m = 0; m < 4; ++m)
#pragma unroll
                    for (int n = 0; n < 2; ++n) acc[a][b][m][n] = (f32x4){0.f, 0.f, 0.f, 0.f};
        cur = nxt; cA = nA; cB = nB; ++ui;
        if constexpr (ALIGN_EPI) { if (wr == 1) PG8_BAR; }
    }
    PG8_WAIT_V(0);
    if constexpr (!ALIGN_EPI) { if (wr == 0) PG8_BAR; }
    PG8_BAR;
    if constexpr (Epi::AFTER_DRAIN) { E.fused(acc, cur, wr, wc, fr, fq, lds, wid, lane); S.done(cur); }
#undef PG8_SA
#undef PG8_SB
#undef PG8_STAGE
#undef PG8_LDA
#undef PG8_LDB
#undef PG8_MMA
#undef PG8_WAIT_V
#undef PG8_WAIT_L
#undef PG8_BAR
#undef PG8_SCHED
}
}

#ifndef MLP_SPLIT
#define MLP_SPLIT 2
#endif
constexpr int NB = 8, SEQ = 2048, DM = 2048, MTOK = NB * SEQ, DFF = 8192, MHALF = MTOK / MLP_SPLIT;
constexpr int NU0 = 6144, NU1 = 7168;
constexpr int LD_IN0 = 6160, LD_IN1 = 7176;
constexpr int C0_GQ = 0, C0_GK = 512, C0_GV = 1024, C0_GG = 2048, C0_MQ = 3072, C0_MK = 4096, C0_MV = 5120;
constexpr int C1_FQ = 0, C1_FK = 1024, C1_FV = 2048, C1_HQ = 3072, C1_HF = 4096, C1_HI = 5120, C1_HG = 6144;
constexpr float EPS = 1e-6f;
constexpr float QSCALE = 0.08838834764831845f;
constexpr size_t MiB = 1u << 20;
constexpr size_t WS_CTL = 0, CTL_ZERO_BYTES = 65536;
constexpr size_t WS_ROWSS = 1 * MiB;
constexpr size_t WS_GLR = 3 * MiB;
constexpr size_t WS_FF = 4 * MiB;
constexpr size_t WS_KMEAN = 4 * MiB + 512 * 1024;
constexpr size_t WS_DSC = 4 * MiB + 768 * 1024;
constexpr size_t WS_CFOX = 5 * MiB;
constexpr size_t WS_WIN0 = 6 * MiB, WS_WOUT0 = 30 * MiB, WS_WUP0 = 38 * MiB, WS_WDN0 = 70 * MiB;
constexpr size_t WS_WIN1 = 102 * MiB, WS_WOUT1 = 130 * MiB, WS_WUP1 = 138 * MiB, WS_WDN1 = 170 * MiB;
constexpr size_t WS_U = 202 * MiB;
constexpr size_t WS_BCUM = WS_U + 192 * MiB;
constexpr size_t WS_HFIN = WS_WIN0, WS_HID = WS_U;
constexpr size_t OUT_H16 = 64 * MiB;
#ifndef LIN_PREFETCH
#define LIN_PREFETCH 5
#endif
#ifndef LIN_PARK
#define LIN_PARK 1
#endif
#ifndef PARK_MASK
#define PARK_MASK 7
#endif
#ifndef LIN_PADB
#define LIN_PADB 1
#endif
#ifndef LIN_GATE_EARLY
#define LIN_GATE_EARLY 2
#endif
#ifndef LIN_SU_EARLY
#define LIN_SU_EARLY 2
#endif
#ifndef LIN_QLATE
#define LIN_QLATE 1
#endif
#ifndef HID_DB
#define HID_DB 1
#endif
constexpr size_t HID_STRIDE = (HID_DB && MLP_SPLIT == 2) ? 128 * MiB : 0;
constexpr size_t WS_P = 426 * MiB;
constexpr size_t WS_S = 490 * MiB;
constexpr size_t WS_ROWSS2 = 506 * MiB;
constexpr size_t WS_END = 508 * MiB;
constexpr int CW_BAR = 4096;
constexpr int LDS_BYTES = 147456, MISC_OFF = LDS_BYTES - 256;
constexpr int NWAVES = 8;

#define GAS __attribute__((address_space(1)))
#define LAS __attribute__((address_space(3)))
typedef unsigned short bf16;
typedef unsigned u32x4 __attribute__((ext_vector_type(4)));
typedef unsigned u32x2 __attribute__((ext_vector_type(2)));
typedef float f32x4 __attribute__((ext_vector_type(4)));
typedef float f32x2 __attribute__((ext_vector_type(2)));
typedef float f32x16 __attribute__((ext_vector_type(16)));
typedef short bf16x8 __attribute__((ext_vector_type(8)));
typedef short s16x4 __attribute__((ext_vector_type(4)));
typedef __bf16 bf16x2_t __attribute__((ext_vector_type(2)));
#define LDS_WAIT() asm volatile("s_waitcnt lgkmcnt(0)" ::: "memory")
__device__ __forceinline__ float bf2f(unsigned short b) { return __uint_as_float((unsigned)b << 16); }
__device__ __forceinline__ unsigned cvtpk(float lo, float hi) { f32x2 v = {lo, hi}; bf16x2_t b = __builtin_convertvector(v, bf16x2_t); return __builtin_bit_cast(unsigned, b); }
__device__ __forceinline__ unsigned short f2bf(float f) { return (unsigned short)(cvtpk(f, 0.f) & 0xffffu); }
__device__ __forceinline__ float wave_sum(float v) {
#pragma unroll
    for (int o = 1; o < 64; o <<= 1) v += __shfl_xor(v, o);
    return v;
}
__device__ __forceinline__ float wave_max(float v) {
#pragma unroll
    for (int o = 1; o < 64; o <<= 1) v = fmaxf(v, __shfl_xor(v, o));
    return v;
}
__device__ __forceinline__ float log_sigmoid(float z) { return fminf(z, 0.f) - log1pf(expf(-fabsf(z))); }
__device__ __forceinline__ float sigmoidf(float z) { return 1.0f / (1.0f + expf(-z)); }
__device__ __forceinline__ int crow(int r, int hi) { return (r & 3) + 8 * (r >> 2) + 4 * hi; }
#ifndef UTILED
#define UTILED 1
#endif
__device__ __forceinline__ size_t UOFF(int tok, int col, int pitch) {
#if UTILED
    return ((size_t)((tok >> 7) * (pitch >> 6) + (col >> 6)) << 13) + (pg8::atile_off(tok & 127, col & 63) >> 1);
#else
    return (size_t)tok * pitch + col;
#endif
}
__device__ __forceinline__ size_t TOFF(int row, int col) { return ((size_t)((row >> 7) * 32 + (col >> 6)) << 13) + (pg8::atile_off(row & 127, col & 63) >> 1); }
struct Args { const float* in[20]; float* out; unsigned char* ws; int ph_lo, ph_hi, variant, pad; };
typedef const __attribute__((address_space(4))) Args* KArgsP;
__device__ __forceinline__ KArgsP kargs() { KArgsP p = (KArgsP)__builtin_amdgcn_kernarg_segment_ptr(); asm volatile("" : "+s"(p)); return p; }
#define XB_TMO      128
#define XB_XCNT(j)  (256  + 64 * (j))
#define XB_XSUB(j)  (1280 + 64 * (j))
#define XB_XGEN(j)  (2304 + 64 * (j))
#define XB_TOP      3328
#define XB_TOPGEN   3392
#define XCD_BAR_WORDS 3456
#define XB_SPIN_CAP (1u << 18)

__device__ __forceinline__ unsigned xb_ld(unsigned* p)              { return __hip_atomic_load(p, __ATOMIC_RELAXED, __HIP_MEMORY_SCOPE_AGENT); }
__device__ __forceinline__ unsigned xb_add(unsigned* p, unsigned v) { return __hip_atomic_fetch_add(p, v, __ATOMIC_RELAXED, __HIP_MEMORY_SCOPE_AGENT); }
__device__ __forceinline__ unsigned xb_xcc_id() { return (unsigned)__builtin_amdgcn_s_getreg((3 << 11) | 20) & 0xFu; }
#define XB_SPIN(cond, bar) do { unsigned _sp = 0; while (cond) { __builtin_amdgcn_s_sleep(1); \
    if ((++_sp & 255u) == 0u) { if (xb_ld(&(bar)[XB_TMO])) break; if (_sp > XB_SPIN_CAP) { atomicAdd(&(bar)[XB_TMO], 1u); break; } } } } while (0)

struct XcdBarrier {
    unsigned* bar; unsigned x;
    volatile LAS unsigned* st;
};

__device__ __forceinline__ XcdBarrier xcd_barrier_post(unsigned* bar, volatile LAS unsigned* st) {
    XcdBarrier b; b.bar = bar; b.x = xb_xcc_id(); b.st = st;
    if (threadIdx.x == 0) (void)xb_add(&bar[XB_XCNT(b.x)], 1u);
    return b;
}
__device__ __forceinline__ void xcd_barrier_complete(unsigned* bar, unsigned x, unsigned& nloc, unsigned& nx) {
    const unsigned G = gridDim.x * gridDim.y * gridDim.z;
    unsigned sum, cnt, mine, sp = 0u;
    for (;;) {
        sum = 0u; cnt = 0u; mine = 0u;
#pragma unroll
        for (unsigned j = 0; j < 16; ++j) { const unsigned c = xb_ld(&bar[XB_XCNT(j)]); sum += c; cnt += (c > 0u) ? 1u : 0u; mine = (j == x) ? c : mine; }
        if (sum == G) break;
        __builtin_amdgcn_s_sleep(1);
        if ((++sp & 255u) == 0u) { if (xb_ld(&bar[XB_TMO])) break; if (sp > XB_SPIN_CAP) { atomicAdd(&bar[XB_TMO], 1u); break; } }
    }
    nloc = mine > 0u ? mine : 1u; nx = cnt > 0u ? cnt : 1u;
}

__device__ __forceinline__ void xcd_barrier(const XcdBarrier& b) {
    asm volatile("s_waitcnt vmcnt(0)" ::: "memory");
    __syncthreads();
    if (threadIdx.x == 0) {
        unsigned* bar = b.bar;
        __builtin_amdgcn_s_waitcnt(0);
        unsigned nloc = b.st[0], nx = b.st[1];
        if (nloc == 0u) { xcd_barrier_complete(bar, b.x, nloc, nx); b.st[0] = nloc; b.st[1] = nx; }
        const unsigned old = xb_add(&bar[XB_XSUB(b.x)], 1u);
        const unsigned gen = old / nloc;
        if (old + 1u == (gen + 1u) * nloc) {
            __builtin_amdgcn_fence(__ATOMIC_RELEASE, "agent");
            asm volatile("s_waitcnt vmcnt(0)" ::: "memory");
            const unsigned og = xb_add(&bar[XB_TOP], 1u);
            const unsigned tg = og / nx;
            if (og + 1u == (tg + 1u) * nx) xb_add(&bar[XB_TOPGEN], 1u);
            else XB_SPIN(xb_ld(&bar[XB_TOPGEN]) == tg, bar);
            __builtin_amdgcn_fence(__ATOMIC_ACQUIRE, "agent");
            xb_add(&bar[XB_XGEN(b.x)], 1u);
            asm volatile("s_waitcnt vmcnt(0)" ::: "memory");
        } else {
            XB_SPIN(xb_ld(&bar[XB_XGEN(b.x)]) == gen, bar);
            __builtin_amdgcn_fence(__ATOMIC_ACQUIRE, "agent");
            asm volatile("s_waitcnt vmcnt(0)" ::: "memory");
        }
    }
    __syncthreads();
}

#ifndef PROLOGUE_NT
#define PROLOGUE_NT 0
#endif
#if PROLOGUE_NT
#define NT_LOAD4(p) __builtin_nontemporal_load(p)
#else
#define NT_LOAD4(p) (*(p))
#endif

#ifndef WTILED
#define WTILED 1
#endif
#if WTILED
#define WTILED_BASE(n0_, k0_, K_) ((((size_t)((n0_) >> 7) * ((K_) >> 6) + ((k0_) >> 6)) << 13) + (pg8::atile_off((n0_) & 127, 0) >> 1))
#define WTILED_OFF(n_, c_, K_) ((pg8::atile_off(((n_) & 31), (c_)) >> 1))
#else
#define WTILED_BASE(n0_, k0_, K_) ((size_t)(n0_) * (K_) + (k0_))
#define WTILED_OFF(n_, c_, K_) ((size_t)(n_) * (K_) + (c_))
#endif
struct TrItem { const float* src; const float* gain; bf16* dst; int ld, K; };
__device__ __forceinline__ TrItem tr_decode(KArgsP K, int r) {
    unsigned char* ws = K->ws; TrItem t;
#define TJ(idx, gidx, ld_, co_, nc_, K_, off_, ro_) { const int items_ = ((K_) / 64) * ((nc_) / 32); if (r < items_) { const int nblk = (nc_) / 32, kb = r / nblk, nb = r % nblk, k0 = 64 * kb, n0 = 32 * nb; \
        t.src = K->in[idx] + (size_t)k0 * (ld_) + (co_) + n0; t.gain = (gidx) >= 0 ? K->in[(gidx) >= 0 ? (gidx) : 0] + k0 : nullptr; t.dst = (bf16*)(ws + (off_)) + WTILED_BASE((ro_) + n0, k0, K_); t.ld = (ld_); t.K = (K_); return t; } r -= items_; }
    TJ(2, 1, LD_IN0, 0, 3072, 2048, WS_WIN0, 0)
    TJ(2, 1, LD_IN0, 3088, 3072, 2048, WS_WIN0, 3072)
    TJ(6, -1, 2048, 0, 2048, 2048, WS_WOUT0, 0)
    TJ(8, 7, 8192, 0, 8192, 2048, WS_WUP0, 0)
    TJ(9, -1, 2048, 0, 2048, 8192, WS_WDN0, 0)
    TJ(11, 10, LD_IN1, 0, 3072, 2048, WS_WIN1, 0)
    TJ(11, 10, LD_IN1, 3080, 4096, 2048, WS_WIN1, 3072)
    TJ(14, -1, 2048, 0, 2048, 2048, WS_WOUT1, 0)
    TJ(16, 15, 8192, 0, 8192, 2048, WS_WUP1, 0)
    TJ(17, -1, 2048, 0, 2048, 8192, WS_WDN1, 0)
#undef TJ
    t.src = nullptr; t.gain = nullptr; t.dst = nullptr; t.ld = 0; t.K = 0; return t;
}
#define TR_LOAD(t, tv) do { _Pragma("unroll") for (int i = 0; i < 8; ++i) tv[i] = NT_LOAD4((const f32x4*)((t).src + (size_t)(8 * i + (lane >> 3)) * (t).ld + 4 * (lane & 7))); } while (0)
__device__ __forceinline__ void tr_process(const TrItem& t, const f32x4 (&tv)[8], LAS float* scr, int lane) {
#pragma unroll
    for (int i = 0; i < 8; ++i) { LAS float* d_ = scr + (8 * i + (lane >> 3)) * 33 + 4 * (lane & 7); d_[0] = tv[i][0]; d_[1] = tv[i][1]; d_[2] = tv[i][2]; d_[3] = tv[i][3]; }
    const int c = lane & 7;
    f32x4 g0 = {1.f, 1.f, 1.f, 1.f}, g1 = g0;
    if (t.gain) { g0 = *(const f32x4*)(t.gain + 8 * c); g1 = *(const f32x4*)(t.gain + 8 * c + 4); }
    LDS_WAIT(); asm volatile("" ::: "memory");
#pragma unroll
    for (int j = 0; j < 4; ++j) { const int n = (lane >> 3) + 8 * j; const LAS float* s = scr + (8 * c) * 33 + n;
        u32x4 o; o.x = cvtpk(s[0 * 33] * g0[0], s[1 * 33] * g0[1]); o.y = cvtpk(s[2 * 33] * g0[2], s[3 * 33] * g0[3]); o.z = cvtpk(s[4 * 33] * g1[0], s[5 * 33] * g1[1]); o.w = cvtpk(s[6 * 33] * g1[2], s[7 * 33] * g1[3]);
        *(GAS u32x4*)(t.dst + WTILED_OFF(n, 8 * c, t.K)) = o; }
    LDS_WAIT(); asm volatile("" ::: "memory");
}
#ifndef TR_STATIC
#define TR_STATIC 17
#endif
__device__ __forceinline__ void phase_transposes(LAS unsigned char* lds, KArgsP K, int G, int wave, int lane) {
    LAS float* scr = (LAS float*)(lds + wave * 16384);
    const int gw = blockIdx.x * NWAVES + wave, NGW = G * NWAVES;
    constexpr int TOTAL = 2 * (32 * 96) + 32 * 64 + 32 * 256 + 128 * 64 + 32 * 96 + 32 * 128 + 32 * 64 + 32 * 256 + 128 * 64;
    const int NSTAT = (TR_STATIC > 0 && TR_STATIC * NGW < TOTAL) ? TR_STATIC * NGW : TOTAL;
    f32x4 ta[8], tb[8];
    int it = gw;
    if (it < NSTAT) {
        TrItem j0 = tr_decode(K, it), j1; TR_LOAD(j0, ta);
        for (;;) {
            const int it1 = it + NGW; const bool h1 = it1 < NSTAT;
            if (h1) { j1 = tr_decode(K, it1); TR_LOAD(j1, tb); }
            asm volatile("" ::: "memory");
            tr_process(j0, ta, scr, lane);
            if (!h1) break;
            const int it2 = it1 + NGW; const bool h2 = it2 < NSTAT;
            if (h2) { j0 = tr_decode(K, it2); TR_LOAD(j0, ta); }
            asm volatile("" ::: "memory");
            tr_process(j1, tb, scr, lane);
            if (!h2) break;
            it = it2;
        }
    }
    if (NSTAT < TOTAL) {
        unsigned* ctr = (unsigned*)(K->ws + WS_CTL) + 12288;
        volatile LAS unsigned* qslot = (volatile LAS unsigned*)(lds + MISC_OFF) + 24;
        const int nch = (TOTAL - NSTAT + 15) / 16;
        const bool lead = wave == 0 && lane == 0;
        if (lead) qslot[0] = __hip_atomic_fetch_add(ctr, 1u, __ATOMIC_RELAXED, __HIP_MEMORY_SCOPE_AGENT);
        __syncthreads();
        int q = (int)qslot[0];
        while (q < nch) {
            unsigned qn = 0u; if (lead) qn = __hip_atomic_fetch_add(ctr, 1u, __ATOMIC_RELAXED, __HIP_MEMORY_SCOPE_AGENT);
            const int ia = NSTAT + 16 * q + 2 * wave, ib = ia + 1;
            const bool ha = ia < TOTAL, hb = ib < TOTAL;
            TrItem ja, jb;
            if (ha) { ja = tr_decode(K, ia); TR_LOAD(ja, ta); }
            if (hb) { jb = tr_decode(K, ib); TR_LOAD(jb, tb); }
            asm volatile("" ::: "memory");
            if (ha) tr_process(ja, ta, scr, lane);
            if (hb) tr_process(jb, tb, scr, lane);
            __syncthreads();
            if (lead) qslot[0] = qn;
            __syncthreads();
            q = (int)qslot[0];
        }
    }
}
__device__ __forceinline__ void phase_norm0(LAS unsigned char* lds, KArgsP K, int G, int tid, int wave, int lane) {
    unsigned char* ws = K->ws; const float* x = K->in[0]; const float* g0 = K->in[1]; const float* win = K->in[2]; const float* w2 = K->in[3]; const float* gb = K->in[4];
    bf16* xn = (bf16*)((unsigned char*)K->out + OUT_H16); float* rowss = (float*)(ws + WS_ROWSS); float* glr = (float*)(ws + WS_GLR); float* bcum = (float*)(ws + WS_BCUM);
    LAS float* WT = (LAS float*)lds;
    LAS float* glr_s = (LAS float*)(lds + 131072);
    if ((int)blockIdx.x >= MTOK / 64) return;
    for (int idx = tid; idx < 2048 * 4; idx += 512) { const int k = idx >> 2, j4 = idx & 3; const f32x4 v = *(const f32x4*)(win + (size_t)k * LD_IN0 + 3072 + 4 * j4) * g0[k];
        WT[(4 * j4 + 0) * 2048 + k] = v[0]; WT[(4 * j4 + 1) * 2048 + k] = v[1]; WT[(4 * j4 + 2) * 2048 + k] = v[2]; WT[(4 * j4 + 3) * 2048 + k] = v[3]; }
    float w2c[16];
#pragma unroll
    for (int r = 0; r < 16; ++r) w2c[r] = w2[r * 512 + tid];
    const float bc = gb[tid];
    __syncthreads();
    for (int item = blockIdx.x; item < MTOK / 64; item += G) {
        const int r0 = item * 64;
        for (int i = 0; i < 8; i += 2) {
            const int row = r0 + 8 * wave + i;
            f32x4 va[8], vb[8]; float ssa = 0.f, ssb = 0.f;
#pragma unroll
            for (int jj = 0; jj < 8; ++jj) { va[jj] = NT_LOAD4((const f32x4*)(x + (size_t)row * DM) + 64 * jj + lane); vb[jj] = NT_LOAD4((const f32x4*)(x + (size_t)(row + 1) * DM) + 64 * jj + lane); }
            asm volatile("" ::: "memory");
#pragma unroll
            for (int jj = 0; jj < 8; ++jj) { ssa += (va[jj][0] * va[jj][0] + va[jj][1] * va[jj][1]) + (va[jj][2] * va[jj][2] + va[jj][3] * va[jj][3]); ssb += (vb[jj][0] * vb[jj][0] + vb[jj][1] * vb[jj][1]) + (vb[jj][2] * vb[jj][2] + vb[jj][3] * vb[jj][3]); }
#pragma unroll
            for (int jj = 0; jj < 8; ++jj) { u32x2 pa, pb; pa.x = cvtpk(va[jj][0], va[jj][1]); pa.y = cvtpk(va[jj][2], va[jj][3]); pb.x = cvtpk(vb[jj][0], vb[jj][1]); pb.y = cvtpk(vb[jj][2], vb[jj][3]);
                *(u32x2*)(xn + TOFF(row, 256 * jj + 4 * lane)) = pa; *(u32x2*)(xn + TOFF(row + 1, 256 * jj + 4 * lane)) = pb; }
            float acca[16], accb[16];
#pragma unroll 2
            for (int j = 0; j < 16; ++j) { float a = 0.f, b = 0.f;
#pragma unroll
                for (int jj = 0; jj < 8; ++jj) { const f32x4 w = *(const LAS f32x4*)(WT + j * 2048 + 256 * jj + 4 * lane);
                    a += (va[jj][0] * w[0] + va[jj][1] * w[1]) + (va[jj][2] * w[2] + va[jj][3] * w[3]); b += (vb[jj][0] * w[0] + vb[jj][1] * w[1]) + (vb[jj][2] * w[2] + vb[jj][3] * w[3]); }
                acca[j] = a; accb[j] = b; }
#pragma unroll
            for (int st = 0; st < 4; ++st) { const int half = 8 >> st; const unsigned um = 0u - (((unsigned)lane >> st) & 1u);
#pragma unroll
                for (int q = 0; q < 8; ++q) if (q < half) {
                    const unsigned alo = __float_as_uint(acca[q]), ahi = __float_as_uint(acca[q + half]), blo = __float_as_uint(accb[q]), bhi = __float_as_uint(accb[q + half]);
                    const float sa = __uint_as_float((alo & um) | (ahi & ~um)), sb = __uint_as_float((blo & um) | (bhi & ~um));
                    const float ka = __uint_as_float((ahi & um) | (alo & ~um)), kb = __uint_as_float((bhi & um) | (blo & ~um));
                    acca[q] = ka + __shfl_xor(sa, 1 << st); accb[q] = kb + __shfl_xor(sb, 1 << st); } }
            float ta = acca[0], tb = accb[0];
            ta += __shfl_xor(ta, 16); ta += __shfl_xor(ta, 32); tb += __shfl_xor(tb, 16); tb += __shfl_xor(tb, 32);
            ssa = wave_sum(ssa); ssb = wave_sum(ssb);
            const float rsa = 1.0f / sqrtf(ssa * (1.0f / DM) + EPS), rsb = 1.0f / sqrtf(ssb * (1.0f / DM) + EPS);
            const int col = ((lane & 1) << 3) | ((lane & 2) << 1) | ((lane & 4) >> 1) | ((lane & 8) >> 3);
            if (lane < 16) { glr_s[(8 * wave + i) * 16 + col] = ta * rsa; glr[(size_t)row * 16 + col] = ta * rsa; glr_s[(8 * wave + i + 1) * 16 + col] = tb * rsb; glr[(size_t)(row + 1) * 16 + col] = tb * rsb; }
            if (lane < 32) { rowss[(size_t)row * 32 + lane] = (lane == 0) ? ssa : 0.f; rowss[(size_t)(row + 1) * 32 + lane] = (lane == 0) ? ssb : 0.f; }
        }
        __syncthreads();
        float run = 0.f;
        for (int t = 0; t < 64; ++t) { float z = bc;
#pragma unroll
            for (int q = 0; q < 4; ++q) { const f32x4 gq = *(const LAS f32x4*)(glr_s + t * 16 + 4 * q); z += (gq[0] * w2c[4 * q] + gq[1] * w2c[4 * q + 1]) + (gq[2] * w2c[4 * q + 2] + gq[3] * w2c[4 * q + 3]); }
            run += (fminf(z, 0.f) - __logf(1.0f + __expf(-fabsf(z)))) * (1.0f / 16.0f); bcum[(size_t)(r0 + t) * 512 + tid] = run; }
        __syncthreads();
    }
}
__device__ __forceinline__ void phase_final_norm(const bf16* h16, float* out, const float* g, const float* rowss, int G, int wave, int lane, float pscale = 1.f) {
    f32x4 gv[8];
#pragma unroll
    for (int jj = 0; jj < 8; ++jj) gv[jj] = ((const f32x4*)g)[64 * jj + lane];
    for (int row = blockIdx.x * NWAVES + wave; row < MTOK; row += G * NWAVES) {
        float s = lane < 32 ? rowss[(size_t)row * 32 + lane] : 0.f;
        u32x2 hv[8];
#pragma unroll
        for (int jj = 0; jj < 8; ++jj) hv[jj] = *(const u32x2*)(h16 + TOFF(row, 256 * jj + 4 * lane));
        asm volatile("" ::: "memory");
        s = wave_sum(s);
        const float rs = pscale / sqrtf(s * (1.0f / DM) + EPS);
        f32x4* orow = (f32x4*)(out + (size_t)row * DM);
#pragma unroll
        for (int jj = 0; jj < 8; ++jj) { const f32x4 v = {__uint_as_float(hv[jj].x << 16), __uint_as_float(hv[jj].x & 0xffff0000u), __uint_as_float(hv[jj].y << 16), __uint_as_float(hv[jj].y & 0xffff0000u)};
            orow[64 * jj + lane] = v * rs * gv[jj]; }
    }
}
__device__ __forceinline__ void phase_kmean(LAS unsigned char* lds, const bf16* u, float* kmean, int G, int tid) {
    LAS float* red = (LAS float*)lds;
    const int c8 = tid & 15, tg = tid >> 4;
    for (int item = blockIdx.x; item < 512; item += G) {
        const int n = item & 7, bh = item >> 3, b = bh >> 3, h = bh & 7;
        float a[8] = {0, 0, 0, 0, 0, 0, 0, 0}; bf16x8 kv[8];
#pragma unroll
        for (int i = 0; i < 8; ++i) { const int tok = b * SEQ + n * 256 + tg * 8 + i; kv[i] = *(const bf16x8*)(u + UOFF(tok, C0_MK + h * 128 + 8 * c8, NU0)); }
        asm volatile("" ::: "memory");
#pragma unroll
        for (int i = 0; i < 8; ++i)
#pragma unroll
            for (int e = 0; e < 8; ++e) a[e] += bf2f((unsigned short)kv[i][e]);
#pragma unroll
        for (int e = 0; e < 8; ++e) red[tg * 128 + 8 * c8 + e] = a[e];
        __syncthreads();
        if (tid < 128) { float s = 0.f; for (int g = 0; g < 32; ++g) s += red[g * 128 + tid]; kmean[(size_t)item * 128 + tid] = s * (1.0f / 256.0f); }
        __syncthreads();
    }
}
__device__ __forceinline__ void phase_ff(LAS unsigned char* lds, const float* win1, const float* gain, const bf16* xn, const float* rowss, float* ff, int G, int tid, int wave, int lane) {
    LAS float* WT = (LAS float*)lds;
    if ((int)blockIdx.x >= MTOK / 64) return;
    for (int idx = tid; idx < 2048 * 2; idx += 512) { const int k = idx >> 1, j4 = idx & 1; const f32x4 v = *(const f32x4*)(win1 + (size_t)k * LD_IN1 + 3072 + 4 * j4) * gain[k];
        WT[(4 * j4 + 0) * 2048 + k] = v[0]; WT[(4 * j4 + 1) * 2048 + k] = v[1]; WT[(4 * j4 + 2) * 2048 + k] = v[2]; WT[(4 * j4 + 3) * 2048 + k] = v[3]; }
    __syncthreads();
    for (int item = blockIdx.x; item < MTOK / 64; item += G) {
        for (int i = 0; i < 8; ++i) {
            const int row = item * 64 + 8 * wave + i;
            float xf[4][8]; bf16x8 xv[4];
#pragma unroll
            for (int jj = 0; jj < 4; ++jj) xv[jj] = *(const bf16x8*)(xn + TOFF(row, 512 * jj + 8 * lane));
            float s = lane < 32 ? rowss[(size_t)row * 32 + lane] : 0.f;
            asm volatile("" ::: "memory");
#pragma unroll
            for (int jj = 0; jj < 4; ++jj)
#pragma unroll
                for (int e = 0; e < 8; ++e) xf[jj][e] = bf2f((unsigned short)xv[jj][e]);
            s = wave_sum(s);
            const float rs = 1.0f / sqrtf(s * (1.0f / DM) + EPS);
            float mine = 0.f;
#pragma unroll 1
            for (int j = 0; j < 8; ++j) { float a = 0.f;
#pragma unroll
                for (int jj = 0; jj < 4; ++jj) { const f32x4 w0 = *(const LAS f32x4*)(WT + j * 2048 + 512 * jj + 8 * lane), w1 = *(const LAS f32x4*)(WT + j * 2048 + 512 * jj + 8 * lane + 4);
                    a += (xf[jj][0] * w0[0] + xf[jj][1] * w0[1]) + (xf[jj][2] * w0[2] + xf[jj][3] * w0[3]) + (xf[jj][4] * w1[0] + xf[jj][5] * w1[1]) + (xf[jj][6] * w1[2] + xf[jj][7] * w1[3]); }
                const float t = wave_sum(a) * rs; if (lane == j) mine = t; }
            if (lane < 8) ff[(size_t)row * 8 + lane] = mine;
        }
    }
    __syncthreads();
}
template <int DV>
__device__ __forceinline__ void phase_scan(const float* sloc, const float* dsc, bf16* sstart, int G, int tid) {
    constexpr int GPB = 128 * DV / 4, TOTAL = (DV == 256 ? 32 : 64) * GPB;
    for (int item = blockIdx.x * 512 + tid; item < TOTAL; item += G * 512) {
        const int p4 = item % GPB, bh = item / GPB;
        const int g = p4 & 3, ln = (p4 >> 2) & 63, dt = (p4 >> 8) & 3;
        const int d0 = 32 * dt + 8 * g + 4 * (ln >> 5);
        f32x4 s = {0.f, 0.f, 0.f, 0.f}; f32x4 ddv[7]; f32x4 lv[7];
#pragma unroll
        for (int sc = 0; sc < 7; ++sc) { const int ui = bh * 8 + sc; ddv[sc] = *(const f32x4*)(dsc + ui * 128 + d0); lv[sc] = *(const f32x4*)(sloc + (size_t)ui * 128 * DV + 4 * (size_t)p4); }
        asm volatile("" ::: "memory");
#pragma unroll
        for (int sc = 0; sc < 7; ++sc) { const int ui = bh * 8 + sc;
            s = s * ddv[sc] + lv[sc]; u32x2 p; p.x = cvtpk(s[0], s[1]); p.y = cvtpk(s[2], s[3]); *(u32x2*)(sstart + (size_t)(ui + 1) * 128 * DV + 4 * (size_t)p4) = p; }
    }
}

__device__ __forceinline__ unsigned offb(unsigned row, unsigned ch) { return 256u * row + 16u * (ch ^ (((row & 3u) << 2) | ((row >> 2) & 3u))); }
__device__ __forceinline__ unsigned tr_addr(unsigned lane, unsigned c, unsigned ks, unsigned t) {
    const unsigned h = lane >> 5, blk = (lane >> 4) & 1, q = (lane & 15) >> 2, p = lane & 3;
    return offb(16 * ks + 8 * h + 4 * t + q, 4 * c + 2 * blk + (p >> 1)) + 8 * (p & 1);
}
typedef short v4i16_t __attribute__((ext_vector_type(4)));
__device__ __forceinline__ s16x4 ds_tr(LAS const unsigned char* p) { return __builtin_bit_cast(s16x4, __builtin_amdgcn_ds_read_tr16_b64_v4i16((LAS v4i16_t*)p)); }
__device__ __forceinline__ bf16x8 ld_tr_frag(LAS const unsigned char* tile, unsigned lane, unsigned c, unsigned ks) {
    const s16x4 lo = ds_tr(tile + tr_addr(lane, c, ks, 0)), hi = ds_tr(tile + tr_addr(lane, c, ks, 1));
    return __builtin_shufflevector(lo, hi, 0, 1, 2, 3, 4, 5, 6, 7);
}
__device__ __forceinline__ bf16x8 ld_row_frag(LAS const unsigned char* tile, unsigned row, unsigned ch) { return *(const LAS bf16x8*)(tile + offb(row, ch)); }
template <int S> __device__ __forceinline__ bf16x8 pack_step(const f32x16& x) {
    u32x4 w = {cvtpk(x[8 * S], x[8 * S + 1]), cvtpk(x[8 * S + 2], x[8 * S + 3]), cvtpk(x[8 * S + 4], x[8 * S + 5]), cvtpk(x[8 * S + 6], x[8 * S + 7])};
    return __builtin_bit_cast(bf16x8, w);
}
#define LD_FENCE() asm volatile("" ::: "memory")
#define MFMA32(a, b, c) __builtin_amdgcn_mfma_f32_32x32x16_bf16((a), (b), (c), 0, 0, 0)

struct LinArgs {
    const bf16* u; int pitch; int qoff, koff, voff, goff;
    const float* bcum;
    const float* lbraw;
    const float* gain;
    float* sloc; float* dsc; const bf16* sstart; bf16* mix; int mixoff;
};
#ifdef PROBE_LIN
#define LIN_T(k) do { if (PROBE_LIN_SEL) { if (threadIdx.x == 0) { const unsigned long long t_ = __builtin_amdgcn_s_memrealtime(); if ((k) == 0) tfirst_ = t_; if ((k) == PROBE_LIN + 1) ((volatile LAS unsigned*)(lds + MISC_OFF))[20] += (unsigned)(t_ - tprev_); if (PROBE_LIN == 9 && (k) == 4) ((volatile LAS unsigned*)(lds + MISC_OFF))[20] += (unsigned)(t_ - tfirst_); tprev_ = t_; } } } while (0)
#else
#define LIN_T(k) do {} while (0)
#endif
template <int DV, int NWH, bool HGRN, bool PB>
__device__ __forceinline__ void lin_unit(LAS unsigned char* lds, const int tid, const LinArgs& A, const int b, const int hbase, const int sc) {
    constexpr int NTH = 64 * NWH, NTQ = NTH / 128, TPT = 64 / NTQ, NHEADS = HGRN ? 8 : 4;
    constexpr int VS_OFF = 32768, AS_OFF = VS_OFF + DV * 128, DS_OFF = AS_OFF + 9216, RED_OFF = DS_OFF + 512, BT_OFF = RED_OFF + 2048, GT_OFF = BT_OFF + 4096, HEAD_LDS = GT_OFF + 4 * DV;
    static_assert(HEAD_LDS * (8 / NWH) <= MISC_OFF, "LDS");
    const int wv = __builtin_amdgcn_readfirstlane(tid >> 6), wl = wv % NWH, hs = wv / NWH, head = hbase + hs;
    LAS unsigned char* hl = lds + hs * HEAD_LDS;
    LAS unsigned char* Qs = hl; LAS unsigned char* Ks = hl + 16384; LAS unsigned char* Vs = hl + VS_OFF; LAS unsigned char* As = hl + AS_OFF;
    LAS float* Ds = (LAS float*)(hl + DS_OFF); LAS float* red = (LAS float*)(hl + RED_OFF); LAS float* btot = (LAS float*)(hl + BT_OFF); LAS float* gtab = (LAS float*)(hl + GT_OFF);
    const int ui = (b * NHEADS + head) * 8 + sc;
    f32x16 Sacc[4];
#pragma unroll
    for (int dt = 0; dt < 4; ++dt)
#pragma unroll
        for (int i = 0; i < 16; ++i) Sacc[dt][i] = 0.f;
    constexpr int NP = HGRN ? 1 : 1024 / NTH;
    u32x4 rk[NP], rq[NP], vv[4]; f32x4 b0[NP], b1[NP]; u32x2 hraw[8], qraw[8];
#define LIN_LOADS_K(tokb_) do { int tl_ = tid; asm volatile("" : "+v"(tl_)); const int th_ = tl_ - hs * NTH, tokb = (tokb_); \
        if (!HGRN) { _Pragma("unroll") for (int j = 0; j < NP; ++j) { const int item = th_ + j * NTH, t = item >> 4, c8 = item & 15; \
                rk[j] = *(const u32x4*)(A.u + UOFF(tokb + t, A.koff + head * 128 + 8 * c8, A.pitch)); \
                const f32x4* bp = (const f32x4*)(A.bcum + (size_t)(tokb + t) * 512 + head * 128 + 8 * c8); b0[j] = bp[0]; b1[j] = bp[1]; } } \
        else { const int dbase_ = 4 * (th_ & 31), tq8_ = th_ >> 5; _Pragma("unroll") for (int i = 0; i < 8; ++i) { const int tk = tokb + tq8_ * 8 + i; \
                hraw[i] = *(const u32x2*)(A.u + UOFF(tk, A.koff + head * 128 + dbase_, A.pitch)); } } \
        LD_FENCE(); } while (0)
#define LIN_LOADS_V(tokb_) do { int tl_ = tid; asm volatile("" : "+v"(tl_)); const int th_ = tl_ - hs * NTH, tokb = (tokb_); \
        _Pragma("unroll") for (int j = 0; j < 4; ++j) { const int item = th_ + j * NTH, t = item / (DV / 8), c8 = item % (DV / 8); vv[j] = *(const u32x4*)(A.u + UOFF(tokb + t, A.voff + head * DV + 8 * c8, A.pitch)); } \
        LD_FENCE(); } while (0)
#define LIN_LOADS_Q(tokb_) do { if (PB) { int tl_ = tid; asm volatile("" : "+v"(tl_)); const int th_ = tl_ - hs * NTH, tokb = (tokb_); \
        if (!HGRN) { _Pragma("unroll") for (int j = 0; j < NP; ++j) { const int item = th_ + j * NTH, t = item >> 4, c8 = item & 15; rq[j] = *(const u32x4*)(A.u + UOFF(tokb + t, A.qoff + head * 128 + 8 * c8, A.pitch)); } } \
        else { const int dbase_ = 4 * (th_ & 31), tq8_ = th_ >> 5; _Pragma("unroll") for (int i = 0; i < 8; ++i) { const int tk = tokb + tq8_ * 8 + i; qraw[i] = *(const u32x2*)(A.u + UOFF(tk, A.qoff + head * 128 + dbase_, A.pitch)); } } \
        LD_FENCE(); } } while (0)
#define LIN_LOADS(tokb_) do { LIN_LOADS_K(tokb_); LIN_LOADS_V(tokb_); LIN_LOADS_Q(tokb_); } while (0)
    constexpr bool PRE = ((LIN_PREFETCH >> ((PB ? 2 : 0) + (HGRN ? 1 : 0))) & 1) != 0;
    if (PRE && !(HGRN && PB)) LIN_LOADS(b * SEQ + sc * 256);
    constexpr bool PARK = LIN_PARK != 0 && HGRN && PB && !PRE && NWH == 4 && DV == 128;
#define LIN_DMA4(tokb_, Kd_, Qd_, Vd_, m_) do { int tp_ = tid; asm volatile("" : "+v"(tp_)); const int l_ = tp_ & 63, tokd = (tokb_); \
        _Pragma("unroll") for (int j = 0; j < 4; ++j) { const int row = 16 * wl + 4 * j + (l_ >> 4), ch = (l_ & 15) ^ ((((l_ >> 4) & 3) << 2) | j); const unsigned pofs = (unsigned)(wl * 4 + j) * 1024u; \
            if ((m_) & 1) __builtin_amdgcn_global_load_lds((const unsigned*)(A.u + UOFF(tokd + row, A.koff + head * 128 + 8 * ch, A.pitch)), (LAS unsigned*)((Kd_) + pofs), 16, 0, 0); \
            if ((m_) & 2) __builtin_amdgcn_global_load_lds((const unsigned*)(A.u + UOFF(tokd + row, A.qoff + head * 128 + 8 * ch, A.pitch)), (LAS unsigned*)((Qd_) + pofs), 16, 0, 0); \
            if ((m_) & 4) __builtin_amdgcn_global_load_lds((const unsigned*)(A.u + UOFF(tokd + row, A.voff + head * DV + 8 * ch, A.pitch)), (LAS unsigned*)((Vd_) + pofs), 16, 0, 0); } } while (0)
#define LIN_DMA(tokb_) LIN_DMA4(tokb_, Ks, Qs, Vs, PARK_MASK)
    constexpr bool PADB = LIN_PADB != 0 && HGRN && !PB && !PRE && NWH == 4 && DV == 128;
    static_assert(!PADB || (2 * HEAD_LDS + 1024 + 8192 <= MISC_OFF && AS_OFF + 16384 <= HEAD_LDS), "LDS (PADB)");
    if (PADB) { Ds = (LAS float*)(lds + 2 * HEAD_LDS + hs * 512); btot = (LAS float*)(lds + 2 * HEAD_LDS + 1024 + hs * 4096); LIN_DMA4(b * SEQ + sc * 256, Ks, Qs, Vs, 5); }
    if (PB) { const int th_g = tid - hs * NTH; if (th_g < DV) gtab[th_g] = A.gain[th_g]; }
    if (PARK) LIN_DMA(b * SEQ + sc * 256);
    if (PB && sc > 0) {
        const bf16* sp = A.sstart + ((((size_t)ui * (DV / 32) + wl) * 4) * 64 + (tid & 63)) * 16;
        u32x4 rw[4][2];
#pragma unroll
        for (int dt = 0; dt < 4; ++dt) { rw[dt][0] = *(const u32x4*)(sp + dt * 1024); rw[dt][1] = *(const u32x4*)(sp + dt * 1024 + 8); }
        LD_FENCE();
#pragma unroll
        for (int dt = 0; dt < 4; ++dt)
#pragma unroll
            for (int h2 = 0; h2 < 2; ++h2)
#pragma unroll
                for (int q = 0; q < 4; ++q) { const unsigned w = rw[dt][h2][q]; Sacc[dt][8 * h2 + 2 * q] = __uint_as_float(w << 16); Sacc[dt][8 * h2 + 2 * q + 1] = __uint_as_float(w & 0xffff0000u); }
    }
    if (PRE && HGRN && PB) LIN_LOADS(b * SEQ + sc * 256);
    float dsum = 0.f, lb = 0.f, oml = 1.f; float dsum8[8] = {0.f, 0.f, 0.f, 0.f, 0.f, 0.f, 0.f, 0.f};
    float lb4[4] = {0.f, 0.f, 0.f, 0.f}, oml4[4] = {1.f, 1.f, 1.f, 1.f};
    if (HGRN) {
#pragma unroll
        for (int e = 0; e < 4; ++e) { int tlb_ = tid; asm volatile("" : "+v"(tlb_)); const int d0_ = 4 * ((tlb_ - hs * NTH) & 31) + e; lb4[e] = sigmoidf(A.lbraw[1024 + head * 128 + d0_] - A.lbraw[head * 128 + d0_]); oml4[e] = 1.f - lb4[e]; } }
    if (PARK || PADB) { asm volatile("s_waitcnt vmcnt(0)" ::: "memory"); __syncthreads(); }
    for (int c = 0; c < 4; ++c) {
        const int tok0 = b * SEQ + sc * 256 + c * 64;
        int tid_c = tid; asm volatile("" : "+v"(tid_c));
#ifdef PROBE_LIN
        unsigned long long tprev_ = 0, tfirst_ = 0;
#endif
        LIN_T(0);
        const int th = tid_c - hs * NTH, lane = tid_c & 63, r = lane & 31, hb = lane >> 5;
        const int d = th & 127, tq = th >> 7;
        const unsigned wofs = 2u * (d & 7);
        if (PADB) { Ks = (c & 1) ? hl : hl + 16384; Vs = (c & 1) ? hl + AS_OFF : hl + VS_OFF;
            if (c < 3) LIN_DMA4(tok0 + 64, ((c & 1) ? hl + 16384 : hl), Qs, ((c & 1) ? hl + VS_OFF : hl + AS_OFF), 5); }
        if (!PRE && !PARK && !PADB) LIN_LOADS(tok0);
        if (PARK || PADB) { const int dbase_ = 4 * (th & 31), tq8_ = th >> 5;
#pragma unroll
            for (int i = 0; i < 8; ++i) { const int t = tq8_ * 8 + i; if (PARK_MASK & 1) hraw[i] = *(const LAS u32x2*)(Ks + offb(t, dbase_ >> 3) + 2 * (dbase_ & 7)); if (PB && (PARK_MASK & 2)) qraw[i] = *(const LAS u32x2*)(Qs + offb(t, dbase_ >> 3) + 2 * (dbase_ & 7)); }
            if ((PARK_MASK & 7) != 7) { if (!(PARK_MASK & 1)) LIN_LOADS_K(tok0); if (!(PARK_MASK & 4)) LIN_LOADS_V(tok0); if (!(PARK_MASK & 2)) LIN_LOADS_Q(tok0); } }
        if (!(PARK || PADB) || !(PARK_MASK & 4)) {
#pragma unroll
          for (int j = 0; j < 4; ++j) { const int item = th + j * NTH, t = item / (DV / 8), c8 = item % (DV / 8); *(LAS u32x4*)(Vs + (c8 >> 4) * 16384 + offb(t, c8 & 15)) = vv[j]; } }
        float blast;
        if (!HGRN) {
#pragma unroll
            for (int j = 0; j < NP; ++j) { const int item = th + j * NTH, t = item >> 4, c8 = item & 15;
                float bb[8] = {b0[j][0], b0[j][1], b0[j][2], b0[j][3], b1[j][0], b1[j][1], b1[j][2], b1[j][3]};
                float kf[8], qf[8];
#pragma unroll
                for (int e = 0; e < 4; ++e) { kf[2 * e] = __uint_as_float(rk[j][e] << 16); kf[2 * e + 1] = __uint_as_float(rk[j][e] & 0xffff0000u); if (PB) { qf[2 * e] = __uint_as_float(rq[j][e] << 16); qf[2 * e + 1] = __uint_as_float(rq[j][e] & 0xffff0000u); } }
                u32x4 ko, qo;
#pragma unroll
                for (int e = 0; e < 4; ++e) { ko[e] = cvtpk(kf[2 * e] * __expf(-bb[2 * e]), kf[2 * e + 1] * __expf(-bb[2 * e + 1]));
                    if (PB) qo[e] = cvtpk(qf[2 * e] * QSCALE * __expf(bb[2 * e]), qf[2 * e + 1] * QSCALE * __expf(bb[2 * e + 1])); }
                *(LAS u32x4*)(Ks + offb(t, c8)) = ko; if (PB) *(LAS u32x4*)(Qs + offb(t, c8)) = qo;
                if (t == 63) {
#pragma unroll
                    for (int e = 0; e < 8; ++e) { Ds[8 * c8 + e] = __expf(bb[e]); dsum8[e] += bb[e]; } } }
            blast = 0.f;
        } else {
            constexpr int TP = 8; const int dbase = 4 * (th & 31), tq8 = th >> 5;
            float kl[TP][4], ql[TP][4];
            f32x4 lip = {1.f, 1.f, 1.f, 1.f};
#pragma unroll
            for (int i = 0; i < TP; ++i) { const float hv[4] = {__uint_as_float(hraw[i].x << 16), __uint_as_float(hraw[i].x & 0xffff0000u), __uint_as_float(hraw[i].y << 16), __uint_as_float(hraw[i].y & 0xffff0000u)};
                const float hq[4] = {__uint_as_float(qraw[i].x << 16), __uint_as_float(qraw[i].x & 0xffff0000u), __uint_as_float(qraw[i].y << 16), __uint_as_float(qraw[i].y & 0xffff0000u)};
#pragma unroll
                for (int e = 0; e < 4; ++e) { const float eh = __expf(-hv[e]), g = __builtin_amdgcn_rcpf(1.0f + lb4[e] * eh); kl[i][e] = __builtin_fmaf(-lb4[e], eh, eh) * (g * lip[e]); lip[e] *= (1.0f + eh) * g;
                    if (PB) { const float eq = __expf(-hq[e]); ql[i][e] = hq[e] * __builtin_amdgcn_rcpf((1.0f + eq) * lip[e]); } } }
            *(LAS f32x4*)(btot + tq8 * 128 + dbase) = lip;
            __syncthreads();
            f32x4 offi = {1.f, 1.f, 1.f, 1.f}, toti = offi;
#pragma unroll
            for (int q = 0; q < 8; ++q) { const f32x4 v = *(const LAS f32x4*)(btot + q * 128 + dbase); toti *= v; if (q < tq8) offi *= v; }
            f32x4 poff = {1.f, 1.f, 1.f, 1.f};
            if (PB) {
#pragma unroll
                for (int e = 0; e < 4; ++e) poff[e] = __builtin_amdgcn_rcpf(offi[e]); }
#pragma unroll
            for (int i = 0; i < TP; ++i) { const int t = tq8 * TP + i;
                u32x2 kp; kp.x = cvtpk(kl[i][0] * offi[0], kl[i][1] * offi[1]); kp.y = cvtpk(kl[i][2] * offi[2], kl[i][3] * offi[3]); *(LAS u32x2*)(Ks + offb(t, dbase >> 3) + 2 * (dbase & 7)) = kp;
                if (PB) { u32x2 qp; qp.x = cvtpk(ql[i][0] * poff[0], ql[i][1] * poff[1]); qp.y = cvtpk(ql[i][2] * poff[2], ql[i][3] * poff[3]); *(LAS u32x2*)(Qs + offb(t, dbase >> 3) + 2 * (dbase & 7)) = qp; } }
            if (tq8 == 0) {
#pragma unroll
                for (int e = 0; e < 4; ++e) { Ds[dbase + e] = __builtin_amdgcn_rcpf(toti[e]); dsum8[e] -= __logf(toti[e]); } }
            blast = 0.f;
        }
        __syncthreads(); LIN_T(1);
        f32x16 o0, o1;
        u32x2 ggv[4][2]; float gsl[4][2][4];
        constexpr bool GE = PB && ((LIN_GATE_EARLY >> (HGRN ? 1 : 0)) & 1) != 0;
        constexpr bool SUE = PB && ((LIN_SU_EARLY >> (HGRN ? 1 : 0)) & 1) != 0;
        if (PB) {
#pragma unroll
            for (int g = 0; g < 4; ++g) { const int e0 = 32 * wl + 8 * g + 4 * hb;
#pragma unroll
                for (int tt = 0; tt < 2; ++tt) ggv[g][tt] = *(const u32x2*)(A.u + UOFF(tok0 + 32 * tt + r, A.goff + head * DV + e0, A.pitch)); }
            LD_FENCE();
        }
        if (PRE && !(LIN_QLATE && HGRN && PB) && c < 3) { LIN_LOADS_K(tok0 + 64); LIN_LOADS_V(tok0 + 64); LIN_LOADS_Q(tok0 + 64); }
        bf16x8 vf[4];
        if (PARK || SUE) {
#pragma unroll
            for (int ks = 0; ks < 4; ++ks) vf[ks] = ld_tr_frag(Vs + (wl >> 2) * 16384, lane, wl & 3, ks); }
        if (PB) {
            if (wl < 4) {
                const int tt = wl >> 1, st = wl & 1;
                f32x16 sa;
#pragma unroll
                for (int i = 0; i < 16; ++i) sa[i] = 0.f;
                if (st <= tt) {
#pragma unroll
                    for (int ks = 0; ks < 8; ++ks) { const bf16x8 af = ld_row_frag(Ks, 32 * st + r, 2 * ks + hb), bq = ld_row_frag(Qs, 32 * tt + r, 2 * ks + hb); sa = MFMA32(af, bq, sa); }
                    if (st == tt) {
#pragma unroll
                        for (int i = 0; i < 16; ++i) if (crow(i, hb) > r) sa[i] = 0.f; }
                }
#pragma unroll
                for (int g = 0; g < 4; ++g) { u32x2 p; p.x = cvtpk(sa[4 * g], sa[4 * g + 1]); p.y = cvtpk(sa[4 * g + 2], sa[4 * g + 3]);
                    *(LAS u32x2*)(As + (32 * tt + r) * 144 + (32 * st + 8 * g + 4 * hb) * 2) = p; }
            }
#pragma unroll
            for (int i = 0; i < 16; ++i) { o0[i] = 0.f; o1[i] = 0.f; }
#pragma unroll
            for (int dt = 0; dt < 4; ++dt) {
                const bf16x8 sf0 = pack_step<0>(Sacc[dt]), sf1 = pack_step<1>(Sacc[dt]);
#pragma unroll
                for (int s2 = 0; s2 < 2; ++s2) {
                    const u32x2 qa0 = *(const LAS u32x2*)(Qs + offb(r, 4 * dt + 2 * s2) + 8 * hb), qb0 = *(const LAS u32x2*)(Qs + offb(r, 4 * dt + 2 * s2 + 1) + 8 * hb);
                    const u32x2 qa1 = *(const LAS u32x2*)(Qs + offb(32 + r, 4 * dt + 2 * s2) + 8 * hb), qb1 = *(const LAS u32x2*)(Qs + offb(32 + r, 4 * dt + 2 * s2 + 1) + 8 * hb);
                    const u32x4 q0 = {qa0.x, qa0.y, qb0.x, qb0.y}, q1 = {qa1.x, qa1.y, qb1.x, qb1.y};
                    o0 = MFMA32(s2 ? sf1 : sf0, __builtin_bit_cast(bf16x8, q0), o0); o1 = MFMA32(s2 ? sf1 : sf0, __builtin_bit_cast(bf16x8, q1), o1); } }
            if (SUE) {
#pragma unroll
        for (int ks = 0; ks < 4; ++ks)
#pragma unroll
            for (int dt = 0; dt < 4; ++dt) { const bf16x8 kf = ld_tr_frag(Ks, lane, dt, ks); Sacc[dt] = MFMA32(kf, vf[ks], Sacc[dt]); }
#pragma unroll
        for (int dt = 0; dt < 4; ++dt)
#pragma unroll
            for (int g = 0; g < 4; ++g) { const f32x4 dv = *(const LAS f32x4*)(Ds + 32 * dt + 8 * g + 4 * hb);
#pragma unroll
                for (int e = 0; e < 4; ++e) Sacc[dt][4 * g + e] *= dv[e]; }
            }
            __syncthreads(); LIN_T(2);
            if (PARK) {
#pragma unroll
                for (int g = 0; g < 4; ++g) { asm volatile("" :: "v"(ggv[g][0])); asm volatile("" :: "v"(ggv[g][1])); } }
            if (PARK && c < 3) LIN_DMA4(tok0 + 64, Ks, Qs, Vs, PARK_MASK & (SUE ? 7 : 4));
        }
        if (!PARK && !SUE) {
#pragma unroll
            for (int ks = 0; ks < 4; ++ks) vf[ks] = ld_tr_frag(Vs + (wl >> 2) * 16384, lane, wl & 3, ks); }
        if (PB) {
#pragma unroll
            for (int ks = 0; ks < 4; ++ks) {
                const bf16x8 a1 = *(const LAS bf16x8*)(As + (32 + r) * 144 + 32 * ks + 16 * hb); o1 = MFMA32(vf[ks], a1, o1);
                if (ks < 2) { const bf16x8 a0 = *(const LAS bf16x8*)(As + r * 144 + 32 * ks + 16 * hb); o0 = MFMA32(vf[ks], a0, o0); } }
            if (GE) {
#pragma unroll
                for (int g = 0; g < 4; ++g) { const int e0 = 32 * wl + 8 * g + 4 * hb; const f32x4 gn = *(const LAS f32x4*)(gtab + e0);
#pragma unroll
                    for (int tt = 0; tt < 2; ++tt) { const u32x2 gg = ggv[g][tt];
                        const float gv[4] = {__uint_as_float(gg.x << 16), __uint_as_float(gg.x & 0xffff0000u), __uint_as_float(gg.y << 16), __uint_as_float(gg.y & 0xffff0000u)};
#pragma unroll
                        for (int e = 0; e < 4; ++e) gsl[g][tt][e] = gn[e] * (gv[e] * __builtin_amdgcn_rcpf(1.0f + __expf(-gv[e]))); } } }
        }
        if (!SUE) {
#pragma unroll
        for (int ks = 0; ks < 4; ++ks)
#pragma unroll
            for (int dt = 0; dt < 4; ++dt) { const bf16x8 kf = ld_tr_frag(Ks, lane, dt, ks); Sacc[dt] = MFMA32(kf, vf[ks], Sacc[dt]); }
#pragma unroll
        for (int dt = 0; dt < 4; ++dt)
#pragma unroll
            for (int g = 0; g < 4; ++g) { const f32x4 dv = *(const LAS f32x4*)(Ds + 32 * dt + 8 * g + 4 * hb);
#pragma unroll
                for (int e = 0; e < 4; ++e) Sacc[dt][4 * g + e] *= dv[e]; }
        }
        if (PRE && LIN_QLATE && HGRN && PB && c < 3) { LIN_LOADS_K(tok0 + 64); LIN_LOADS_V(tok0 + 64); LIN_LOADS_Q(tok0 + 64); }
        if (PB) {
            float s0 = 0.f, s1 = 0.f;
#pragma unroll
            for (int i = 0; i < 16; ++i) { s0 += o0[i] * o0[i]; s1 += o1[i] * o1[i]; }
            s0 += __shfl_xor(s0, 32); s1 += __shfl_xor(s1, 32);
            if (hb == 0) { red[wl * 64 + r] = s0; red[wl * 64 + 32 + r] = s1; }
            __syncthreads(); LIN_T(3);
            if (PARK && !SUE && c < 3) LIN_DMA4(tok0 + 64, Ks, Qs, Vs, PARK_MASK & 3);
#ifdef PARK_DEBUG_SYNC
            if (PARK) { asm volatile("s_waitcnt vmcnt(0)" ::: "memory"); __syncthreads(); }
#endif
            float t0 = 0.f, t1 = 0.f;
#pragma unroll
            for (int w = 0; w < NWH; ++w) { t0 += red[w * 64 + r]; t1 += red[w * 64 + 32 + r]; }
            const float rs0 = 1.0f / sqrtf(t0 * (1.0f / DV) + EPS), rs1 = 1.0f / sqrtf(t1 * (1.0f / DV) + EPS);
#pragma unroll
            for (int g = 0; g < 4; ++g) { const int e0 = 32 * wl + 8 * g + 4 * hb; const f32x4 gn = *(const LAS f32x4*)(gtab + e0);
#pragma unroll
                for (int tt = 0; tt < 2; ++tt) { const size_t tok = (size_t)(tok0 + 32 * tt + r); const u32x2 gg = ggv[g][tt];
                    const float g0 = __uint_as_float(gg.x << 16), g1 = __uint_as_float(gg.x & 0xffff0000u), g2 = __uint_as_float(gg.y << 16), g3 = __uint_as_float(gg.y & 0xffff0000u);
                    const float rs = tt ? rs1 : rs0;
                    float v0, v1, v2, v3;
                    if (GE) { v0 = (tt ? o1[4 * g] : o0[4 * g]) * rs * gsl[g][tt][0]; v1 = (tt ? o1[4 * g + 1] : o0[4 * g + 1]) * rs * gsl[g][tt][1]; v2 = (tt ? o1[4 * g + 2] : o0[4 * g + 2]) * rs * gsl[g][tt][2]; v3 = (tt ? o1[4 * g + 3] : o0[4 * g + 3]) * rs * gsl[g][tt][3]; }
                    else { v0 = (tt ? o1[4 * g] : o0[4 * g]) * rs * gn[0] * (g0 * __builtin_amdgcn_rcpf(1.0f + __expf(-g0))); v1 = (tt ? o1[4 * g + 1] : o0[4 * g + 1]) * rs * gn[1] * (g1 * __builtin_amdgcn_rcpf(1.0f + __expf(-g1)));
                        v2 = (tt ? o1[4 * g + 2] : o0[4 * g + 2]) * rs * gn[2] * (g2 * __builtin_amdgcn_rcpf(1.0f + __expf(-g2))); v3 = (tt ? o1[4 * g + 3] : o0[4 * g + 3]) * rs * gn[3] * (g3 * __builtin_amdgcn_rcpf(1.0f + __expf(-g3))); }
                    u32x2 p; p.x = cvtpk(v0, v1); p.y = cvtpk(v2, v3); *(u32x2*)(A.mix + tok * 2048 + A.mixoff + head * DV + e0) = p; } }
        }
        if (PARK || PADB) asm volatile("s_waitcnt vmcnt(0)" ::: "memory");
        __syncthreads(); LIN_T(4);
    }
    if (!PB) {
        int tid_e = tid; asm volatile("" : "+v"(tid_e));
        const int th = tid_e - hs * NTH, d = th & 127, tq = th >> 7;
        float* sp = A.sloc + ((((size_t)ui * (DV / 32) + wl) * 4) * 64 + (tid_e & 63)) * 16;
#pragma unroll
        for (int dt = 0; dt < 4; ++dt)
#pragma unroll
            for (int g = 0; g < 4; ++g) *(f32x4*)(sp + dt * 1024 + 4 * g) = (f32x4){Sacc[dt][4 * g], Sacc[dt][4 * g + 1], Sacc[dt][4 * g + 2], Sacc[dt][4 * g + 3]};
        if (HGRN) { if ((th >> 5) == 0) {
#pragma unroll
            for (int e = 0; e < 4; ++e) A.dsc[ui * 128 + 4 * (th & 31) + e] = __expf(dsum8[e]); } }
        else if (th >= NTH - 16) {
#pragma unroll
            for (int e = 0; e < 8; ++e) A.dsc[ui * 128 + 8 * (th - (NTH - 16)) + e] = __expf(dsum8[e]); }
    }
}

namespace att {
constexpr int D = 128;
constexpr float SCALE = 0.08838834764831845f, INV_SCALE = 11.313708498984761f;
constexpr float THR = 8.f;
constexpr int NW = 8, QBLK = 32, KVBLK = 64, QB = NW * QBLK;
constexpr int SHM_V = KVBLK * D * 2, SHM_K = KVBLK * D * 2;
constexpr int LDS_CORE = 2 * SHM_V + 2 * SHM_K + NW * 64 * 4;
constexpr int OFF_BIAS = LDS_CORE, OFF_SEL = OFF_BIAS + 8192, OFF_KM = OFF_SEL + 1024, OFF_SCAN = OFF_KM + 3584, LDS_ATT = OFF_SCAN + 64;
static_assert(LDS_ATT <= MISC_OFF, "attention LDS");
#define KSWZ(row, colB) ((row) * 256 + ((colB) ^ (((row) & 7) << 4)))
#define SBAR() __builtin_amdgcn_sched_barrier(0)
__device__ __forceinline__ int v_st(int k, int c) { const int kk = (k & ~0xC) | ((k & 4) << 1) | ((k & 8) >> 1); return ((kk >> 3) * 4 + (c >> 5)) * 512 + ((kk & 7) * 32 + (c & 31)) * 2; }
__device__ __forceinline__ int v_rd_base(int lane) { return ((lane & 3) << 3) | (((lane >> 2) & 3) << 6) | (((lane >> 4) & 1) << 5) | (((lane >> 5) & 1) << 8); }
constexpr int v_rd_off(int d0, int ks, int half) { return d0 * 512 + ks * 4096 + half * 2048; }
__device__ __forceinline__ unsigned cvtpk_a(float lo, float hi) { unsigned r; asm volatile("v_cvt_pk_bf16_f32 %0, %1, %2" : "=v"(r) : "v"(lo), "v"(hi)); return r; }
__device__ __forceinline__ bf16x8 load8(const bf16* p) { return *reinterpret_cast<const bf16x8*>(p); }
__device__ __forceinline__ void mask_tile(f32x16& p0, f32x16& p1, int dq) {
    const float NEG = -__builtin_inff();
#pragma unroll
    for (int r = 0; r < 16; ++r) {
        const int c = (r & 3) + 8 * (r >> 2);
        if (dq - c < 0) p0[r] = NEG;
        if (dq - c - 32 < 0) p1[r] = NEG;
    }
}
__device__ __forceinline__ void partialSM(f32x16& p0, f32x16& p1, float& m_reg, float& mn, float& alpha, const bool keep) {
    float pmax = p0[0]; for (int r = 1; r < 16; ++r) pmax = fmaxf(pmax, p0[r]); for (int r = 0; r < 16; ++r) pmax = fmaxf(pmax, p1[r]);
    { auto rr = __builtin_amdgcn_permlane32_swap(__float_as_uint(pmax), __float_as_uint(pmax), false, false);
      pmax = fmaxf(__uint_as_float(rr[0]), __uint_as_float(rr[1])); }
    pmax = keep ? pmax : -__builtin_inff();
    constexpr float C2 = 1.4426950408889634f * SCALE;
    if (__builtin_expect(__all((pmax - m_reg) * SCALE <= THR), 1)) { mn = m_reg; alpha = 1.f; }
    else { mn = fmaxf(m_reg, pmax); alpha = __builtin_amdgcn_exp2f((m_reg - mn) * C2); m_reg = mn; }
    const float mnL = keep ? -mn * C2 : -__builtin_inff();
    for (int r = 0; r < 16; ++r) p0[r] = fmaf(p0[r], C2, mnL); for (int r = 0; r < 16; ++r) p1[r] = fmaf(p1[r], C2, mnL);
    for (int r = 0; r < 16; ++r) p0[r] = __builtin_amdgcn_exp2f(p0[r]);
}
__device__ __forceinline__ void finishSM(f32x16& p0, f32x16& p1, float alpha, float& l_reg, bf16x8& pa0, bf16x8& pa1, bf16x8& pa2, bf16x8& pa3) {
    for (int r = 0; r < 16; ++r) p1[r] = __builtin_amdgcn_exp2f(p1[r]);
    float ps = 0; for (int r = 0; r < 16; ++r) ps += p0[r]; for (int r = 0; r < 16; ++r) ps += p1[r];
    { auto rr = __builtin_amdgcn_permlane32_swap(__float_as_uint(ps), __float_as_uint(ps), false, false);
      ps = __uint_as_float(rr[0]) + __uint_as_float(rr[1]); }
    l_reg = l_reg * alpha + ps;
#define PK4(P, B_, OUT) do { unsigned a0 = cvtpk_a(P[B_+0], P[B_+1]), a1 = cvtpk_a(P[B_+2], P[B_+3]);                          \
        unsigned b0 = cvtpk_a(P[B_+4], P[B_+5]), b1 = cvtpk_a(P[B_+6], P[B_+7]);                                             \
        auto r0 = __builtin_amdgcn_permlane32_swap(a0, b0, false, false); auto r1 = __builtin_amdgcn_permlane32_swap(a1, b1, false, false); \
        u32x4 w = {r0[0], r1[0], r0[1], r1[1]}; OUT = *reinterpret_cast<bf16x8*>(&w); } while (0)
    PK4(p0, 0, pa0); PK4(p0, 8, pa1); PK4(p1, 0, pa2); PK4(p1, 8, pa3);
#undef PK4
}
template <int KB>
__device__ __forceinline__ void qkt(f32x16& p0, f32x16& p1, const char* K_lds, int r32, int hi, const bf16x8* qr, const float* bp) {
#pragma unroll
    for (int g = 0; g < 4; ++g) { const f32x4 b0 = *(const f32x4*)(bp + 8 * g), b1 = *(const f32x4*)(bp + 32 + 8 * g);
#pragma unroll
        for (int e = 0; e < 4; ++e) { p0[4 * g + e] = b0[e]; p1[4 * g + e] = b1[e]; } }
    const char* kb[4];
#pragma unroll
    for (int dd = 0; dd < 4; ++dd) kb[dd] = K_lds + KB * SHM_K + KSWZ(r32, (dd * 16 + hi * 8) * 2);
#pragma unroll
    for (int d0 = 0; d0 < 8; ++d0) { const char* a = kb[d0 & 3] + (d0 >> 2) * 128;
        bf16x8 b0 = *reinterpret_cast<const bf16x8*>(a);
        bf16x8 b1 = *reinterpret_cast<const bf16x8*>(a + 32 * 256);
        p0 = __builtin_amdgcn_mfma_f32_32x32x16_bf16(b0, qr[d0], p0, 0, 0, 0);
        p1 = __builtin_amdgcn_mfma_f32_32x32x16_bf16(b1, qr[d0], p1, 0, 0, 0); }
}
template <int VB>
__device__ __forceinline__ void pv_tile(f32x16* o, int vb0, bf16x8 pa0, bf16x8 pa1, bf16x8 pa2, bf16x8 pa3) {
#define TRRD(dst, off) asm volatile("ds_read_b64_tr_b16 %0, %1 offset:%2" : "=&v"(dst) : "v"(vb0), "i"(off) : "memory")
#define PV_D0(d0) do { s16x4 l0, l1, l2, l3, h0, h1, h2, h3; constexpr int b_ = VB * SHM_V + v_rd_off(d0, 0, 0);   \
        TRRD(l0, b_); TRRD(h0, b_ + 2048); TRRD(l1, b_ + 4096); TRRD(h1, b_ + 6144); TRRD(l2, b_ + 8192); TRRD(h2, b_ + 10240); TRRD(l3, b_ + 12288); TRRD(h3, b_ + 14336); \
        asm volatile("s_waitcnt lgkmcnt(0)" ::: "memory"); SBAR();   \
        o[d0] = __builtin_amdgcn_mfma_f32_32x32x16_bf16(pa0, (bf16x8){l0[0], l0[1], l0[2], l0[3], h0[0], h0[1], h0[2], h0[3]}, o[d0], 0, 0, 0);   \
        o[d0] = __builtin_amdgcn_mfma_f32_32x32x16_bf16(pa1, (bf16x8){l1[0], l1[1], l1[2], l1[3], h1[0], h1[1], h1[2], h1[3]}, o[d0], 0, 0, 0);   \
        o[d0] = __builtin_amdgcn_mfma_f32_32x32x16_bf16(pa2, (bf16x8){l2[0], l2[1], l2[2], l2[3], h2[0], h2[1], h2[2], h2[3]}, o[d0], 0, 0, 0);   \
        o[d0] = __builtin_amdgcn_mfma_f32_32x32x16_bf16(pa3, (bf16x8){l3[0], l3[1], l3[2], l3[3], h3[0], h3[1], h3[2], h3[3]}, o[d0], 0, 0, 0); } while (0)
    PV_D0(0); PV_D0(1); PV_D0(2); PV_D0(3);
#undef PV_D0
#undef TRRD
}
struct Blk { const bf16* u; int tokb, qcol, kcol, vcol; bf16* O; int P0; };
struct Seam { bf16x8 qr[8]; bf16x8 st_v0, st_v1, st_k0, st_k1; };
#define ROW(colbase, k0, rr) (Ub + UOFF(tokb_ + (k0) + (rr), (colbase) + sc, pitch))
#define VMW() asm volatile("s_waitcnt vmcnt(0)" ::: "memory")
#define VMWN(n) asm volatile("s_waitcnt vmcnt(%0)" :: "i"(n) : "memory")
#define SLOAD_H(Kp, Vp, k0) do { S.st_v0 = load8(ROW(Vp, k0, sr)); S.st_v1 = load8(ROW(Vp, k0, 32 + sr));              \
                         S.st_k0 = load8(ROW(Kp, k0, sr)); S.st_k1 = load8(ROW(Kp, k0, 32 + sr)); } while (0)
#define SWRITE_HK(bf) do { *(bf16x8*)(K_lds + (bf) * SHM_K + kws) = S.st_k0; *(bf16x8*)(K_lds + (bf) * SHM_K + kws + 32 * 256) = S.st_k1; } while (0)
#define SWRITE_HV(bf) do { *(bf16x8*)(V_lds + (bf) * SHM_V + vst0) = S.st_v0; *(bf16x8*)(V_lds + (bf) * SHM_V + vst1) = S.st_v1; } while (0)
#define SWRITE_H(bf) do { SWRITE_HV(bf); SWRITE_HK(bf); } while (0)
__device__ __forceinline__ void prime(const Blk& cur, char* lds, Seam& S, const int pitch) {
    const int tid = otid(), wid = __builtin_amdgcn_readfirstlane(tid >> 6), lane = tid & 63, r32 = lane & 31, hi = lane >> 5;
    const int sr = tid >> 4, sc = (tid & 15) * 8, kws = KSWZ(sr, sc * 2); char* K_lds = lds + 2 * SHM_V;
    const bf16* Ub = cur.u; const int tokb_ = cur.tokb;
    for (int d0 = 0; d0 < 8; ++d0) S.qr[d0] = load8(cur.u + UOFF(cur.tokb + cur.P0 + wid * QBLK + r32, cur.qcol + d0 * 16 + hi * 8, pitch));
    SLOAD_H(cur.kcol, cur.vcol, 0); VMW(); SWRITE_HK(0);
    __syncthreads();
}
__device__ __forceinline__ void block(const Blk& cur, const Blk& nxt, char* lds, Seam& S, const int pitch, const int opitch, const unsigned selbits, const float* biasL) {
    const int tid = otid(), wid = __builtin_amdgcn_readfirstlane(tid >> 6), lane = tid & 63, r32 = lane & 31, hi = lane >> 5;
    const int NT = cur.P0 / KVBLK + QB / KVBLK;
    const int qbn = cur.P0 >> 8;
    const int qlo = cur.P0 + wid * QBLK, qm = qlo + r32 - 4 * hi;
    char* V_lds = lds; char* K_lds = lds + 2 * SHM_V;
    float* ws = (float*)(lds + 2 * SHM_V + 2 * SHM_K) + wid * 64; float* li_l = ws, * al_l = ws + 32;
    float m_reg = -1e30f, l_reg = 0; f32x16 o[4] = {};
    const int sr = tid >> 4, sc = (tid & 15) * 8, vst0 = v_st(sr, sc), vst1 = v_st(32 + sr, sc), kws = KSWZ(sr, sc * 2);
    const int vb0 = (int)(uintptr_t)V_lds + v_rd_base(lane);
    const int Kh = cur.kcol, Vh = cur.vcol; const bf16* Ub = cur.u; const int tokb_ = cur.tokb;
#define RESC(a) do { if (__any((a) < 1.f)) { if (hi == 0) al_l[r32] = (a); asm volatile("s_waitcnt lgkmcnt(0)" ::: "memory");              \
                     for (int d_ = 0; d_ < 4; ++d_) for (int r = 0; r < 16; ++r) o[d_][r] *= al_l[crow(r, hi)]; } } while (0)
#define KBASE(t) ((t) * KVBLK)
#define MASKT(P0_, P1_, t) do { const int kb_ = KBASE(t); if ((kb_ >> 8) >= qbn && kb_ + KVBLK - 1 > qlo) mask_tile(P0_, P1_, qm - kb_); } while (0)
#define KEEPT(t) ((((t) * KVBLK) >> 8) >= qbn || ((selbits >> (((t) * KVBLK) >> 8)) & 1u))
#define BIASP(t) (biasL + KBASE(t) + 4 * hi)
    constexpr int NQL = 8;
#define SEAM_K0() do { VMWN(NQL); SWRITE_HK(0); SBAR(); } while (0)
    f32x16 pA0, pA1, pB0, pB1; float mnA, mnB, alA, alB; bf16x8 pa0, pa1, pa2, pa3;
    SWRITE_HV(0); SBAR();
    SLOAD_H(Kh, Vh, KBASE(1));
    SBAR(); qkt<0>(pA0, pA1, K_lds, r32, hi, S.qr, BIASP(0));
    MASKT(pA0, pA1, 0); partialSM(pA0, pA1, m_reg, mnA, alA, KEEPT(0));
    VMW(); SWRITE_H(1);
    __syncthreads();
#define HALF_STEP(PX0, PX1, mnX, alX, PY0, PY1, alY, t, KB, VB, SB) do {                                                      \
        SBAR(); qkt<KB>(PX0, PX1, K_lds, r32, hi, S.qr, BIASP(t));                                                           \
        finishSM(PY0, PY1, alY, l_reg, pa0, pa1, pa2, pa3); SBAR();                                                           \
        if ((t) + 1 < NT) { SLOAD_H(Kh, Vh, KBASE((t) + 1)); SBAR(); }                                                        \
        pv_tile<VB>(o, vb0, pa0, pa1, pa2, pa3); MASKT(PX0, PX1, (t)); partialSM(PX0, PX1, m_reg, mnX, alX, KEEPT(t));        \
        __syncthreads();                                                                                                      \
        if ((t) + 1 < NT) { VMW(); SWRITE_H(SB); }                                                                            \
        RESC(alX); __syncthreads(); } while (0)
    for (int t = 1; t + 1 < NT; t += 2) {
        HALF_STEP(pB0, pB1, mnB, alB, pA0, pA1, alA, t, 1, 0, 0);
        HALF_STEP(pA0, pA1, mnA, alA, pB0, pB1, alB, t + 1, 0, 1, 1);
    }
    SBAR(); qkt<1>(pB0, pB1, K_lds, r32, hi, S.qr, BIASP(NT - 1)); SBAR();
    SLOAD_H(nxt.kcol, nxt.vcol, 0); SBAR();
#pragma unroll
    for (int d0 = 0; d0 < 8; ++d0) S.qr[d0] = load8(nxt.u + UOFF(nxt.tokb + nxt.P0 + wid * QBLK + r32, nxt.qcol + d0 * 16 + hi * 8, pitch));
    SBAR();
    finishSM(pA0, pA1, alA, l_reg, pa0, pa1, pa2, pa3); SBAR();
    pv_tile<0>(o, vb0, pa0, pa1, pa2, pa3);
    MASKT(pB0, pB1, NT - 1); partialSM(pB0, pB1, m_reg, mnB, alB, true); __syncthreads(); RESC(alB);
    finishSM(pB0, pB1, alB, l_reg, pa0, pa1, pa2, pa3); SBAR(); pv_tile<1>(o, vb0, pa0, pa1, pa2, pa3);
    SBAR(); SEAM_K0();
#ifdef PROBE_ATT
    unsigned long long te_ = 0; if (threadIdx.x == 0) te_ = __builtin_amdgcn_s_memrealtime();
#endif
    if (hi == 0) li_l[r32] = l_reg; asm volatile("s_waitcnt lgkmcnt(0)" ::: "memory");
    float rli[16];
#pragma unroll
    for (int r = 0; r < 16; ++r) rli[r] = __builtin_amdgcn_rcpf(li_l[crow(r, hi)]);
    bf16* Ow = cur.O + (size_t)(wid * QBLK) * opitch;
#pragma unroll
    for (int r = 0; r < 16; ++r) { const int orow = crow(r, hi);
#pragma unroll
        for (int d0 = 0; d0 < 4; ++d0) { const float v = o[d0][r] * rli[r];
            const float vn = __shfl_xor(v, 1);
            if ((r32 & 1) == 0) *(unsigned*)(Ow + (size_t)orow * opitch + d0 * 32 + r32) = cvtpk_a(v, vn); } }
    __syncthreads();
#ifdef PROBE_ATT
    if (PROBE_ATT == 2 && threadIdx.x == 0) ((volatile unsigned*)(lds + MISC_OFF))[20] += (unsigned)(__builtin_amdgcn_s_memrealtime() - te_);
#endif
#undef RESC
#undef KBASE
#undef MASKT
#undef KEEPT
#undef BIASP
#undef SEAM_K0
#undef HALF_STEP
}
#undef ROW
#undef VMW
#undef VMWN
#undef SLOAD_H
#undef SWRITE_HK
#undef SWRITE_HV
#undef SWRITE_H

__device__ __forceinline__ void setup(char* lds, const int mode, const Blk& cur, const int pitch, const int b, const int h, const float* kmean, const float* ff, const float* fbias, const int pass) {
    const int tid = otid(), lane = tid & 63, wave = tid >> 6;
    float* biasL = (float*)(lds + OFF_BIAS); unsigned* selm = (unsigned*)(lds + OFF_SEL); float* kms = (float*)(lds + OFF_KM); float* scanw = (float*)(lds + OFF_SCAN);
    const int qb = cur.P0 >> 8;
    if (mode == 0) {
        const float slope = exp2f(-(float)(h + 1)) * INV_SCALE;
        if (qb > 3) for (int i = tid; i < qb * 128; i += 512) kms[i] = kmean[(size_t)((b * 8 + h) * 8) * 128 + i];
        for (int s = tid; s < cur.P0 + 256; s += 512) biasL[s] = slope * (float)(s - cur.P0);
        __syncthreads();
        const int row = tid >> 1, dh = tid & 1;
        unsigned bits = (1u << qb) - 1u;
        if (qb > 3) {
            float acc[7] = {0.f, 0.f, 0.f, 0.f, 0.f, 0.f, 0.f};
            bf16x8 qv8[8];
#pragma unroll
            for (int c = 0; c < 8; ++c) qv8[c] = load8(cur.u + UOFF(cur.tokb + cur.P0 + row, cur.qcol + 64 * dh + 8 * c, pitch));
            asm volatile("" ::: "memory");
#pragma unroll
            for (int c = 0; c < 8; ++c) { const bf16x8 qv = qv8[c];
#pragma unroll
                for (int e = 0; e < 8; ++e) { const float qf = bf2f((unsigned short)qv[e]);
#pragma unroll
                    for (int n = 0; n < 7; ++n) acc[n] += qf * kms[n * 128 + 64 * dh + 8 * c + e]; } }
#pragma unroll
            for (int n = 0; n < 7; ++n) acc[n] += __shfl_xor(acc[n], 1);
            bits = 0u;
#pragma unroll
            for (int pick = 0; pick < 3; ++pick) { float best = -__builtin_inff(); int bi = 0;
#pragma unroll
                for (int n = 0; n < 7; ++n) if (n < qb && !((bits >> n) & 1u) && acc[n] > best) { best = acc[n]; bi = n; }
                bits |= 1u << bi; }
        }
        if (dh == 0) selm[row] = bits;
        __syncthreads();
    } else if (pass != 0) {
        const float bref = biasL[cur.P0];
        __syncthreads();
#pragma unroll
        for (int i = 0; i < 4; ++i) biasL[4 * tid + i] -= bref;
        __syncthreads();
    } else {
        const float fb = fbias[h];
        float v[4]; float run = 0.f;
#pragma unroll
        for (int i = 0; i < 4; ++i) v[i] = ff[(size_t)(b * SEQ + 4 * tid + i) * 8 + h];
        asm volatile("" ::: "memory");
#pragma unroll
        for (int i = 0; i < 4; ++i) { run += log_sigmoid(v[i] + fb); v[i] = run; }
        float incl = run;
#pragma unroll
        for (int o = 1; o < 64; o <<= 1) { const float t = __shfl_up(incl, o); if (lane >= o) incl += t; }
        if (lane == 63) scanw[wave] = incl;
        __syncthreads();
        float off = incl - run;
        for (int w = 0; w < wave; ++w) off += scanw[w];
#pragma unroll
        for (int i = 0; i < 4; ++i) { v[i] += off; biasL[4 * tid + i] = v[i]; }
        __syncthreads();
        const float cref = biasL[cur.P0];
        __syncthreads();
#pragma unroll
        for (int i = 0; i < 4; ++i) biasL[4 * tid + i] = (cref - v[i]) * INV_SCALE;
        if (tid < 256) selm[tid] = 0xffu;
        __syncthreads();
    }
}
__device__ __forceinline__ void pair_item(char* lds, const int item, const int mode, const bf16* u, const int pitch, const int qoff, const int koff, const int voff,
                                          bf16* mix, const int mixoff, const float* kmean, const float* ff, const float* fbias) {
    const int bh = item >> 2, x = item & 3, b = bh >> 3, h = bh & 7;
    bf16* obase = mix + (size_t)(b * SEQ) * 2048 + mixoff + h * 128;
    const float* biasL = (const float*)(lds + OFF_BIAS); const unsigned* selm = (const unsigned*)(lds + OFF_SEL);
    Blk cur;
    cur.P0 = x * 256; cur.u = u; cur.tokb = b * SEQ; cur.qcol = qoff + h * 128; cur.kcol = koff + h * 128; cur.vcol = voff + h * 128; cur.O = obase + (size_t)cur.P0 * 2048;
    Seam S;
    for (int pass = 0; pass < 2; ++pass) {
#ifdef PROBE_ATT
        unsigned long long ta_ = 0; if (threadIdx.x == 0) ta_ = __builtin_amdgcn_s_memrealtime();
#endif
        setup(lds, mode, cur, pitch, b, h, kmean, ff, fbias, pass);
#ifdef PROBE_ATT
        if (threadIdx.x == 0) { const unsigned long long tb_ = __builtin_amdgcn_s_memrealtime(); if (PROBE_ATT == 0 && mode == PROBE_ATT_MODE) ((volatile unsigned*)(lds + MISC_OFF))[20] += (unsigned)(tb_ - ta_); ta_ = tb_; }
#endif
        if (pass == 0) prime(cur, lds, S, pitch);
        Blk nxt = cur;
        if (pass == 0) { nxt.P0 = (7 - x) * 256; nxt.O = obase + (size_t)nxt.P0 * 2048; }
        const int t_ = otid();
        const unsigned sel = selm[(t_ >> 6) * 32 + (t_ & 31)];
        block(cur, nxt, lds, S, pitch, 2048, sel, biasL);
#ifdef PROBE_ATT
        if (threadIdx.x == 0) { const unsigned long long tb_ = __builtin_amdgcn_s_memrealtime(); if (PROBE_ATT == 1 && mode == PROBE_ATT_MODE) ((volatile unsigned*)(lds + MISC_OFF))[20] += (unsigned)(tb_ - ta_); }
#endif
        cur = nxt;
    }
}
}

template <int DV, bool HGRN>
__device__ __forceinline__ void ref_lin(LAS unsigned char* lds, const int tid, const int G, const bf16* u, const int pitch, const int qoff, const int koff, const int voff, const int goff,
                                        const float* glr, const float* w2, const float* gb, const float* lbraw, const float* gain, bf16* mix, const int mixoff) {
    constexpr int NDP = 512 / DV, DPP = 128 / NDP, NHEADS = HGRN ? 8 : 4, TPG = 16 / NDP, NWG = DV / 64;
    LAS float* qs = (LAS float*)lds; LAS float* ks = qs + 16 * 128; LAS float* dcs = ks + 16 * 128; LAS float* ored = dcs + 16 * 128; LAS float* wred = ored + NDP * 16 * DV;
    const int e = tid % DV, dp = tid / DV, lane = tid & 63, wave = tid >> 6;
    for (int unit = blockIdx.x; unit < NB * NHEADS; unit += G) {
        const int b = unit / NHEADS, head = unit % NHEADS;
        float S[DPP];
#pragma unroll
        for (int i = 0; i < DPP; ++i) S[i] = 0.f;
        for (int t0 = 0; t0 < SEQ; t0 += 16) {
            for (int idx = tid; idx < 16 * 128; idx += 512) { const int tt = idx >> 7, d = idx & 127; const size_t tok = (size_t)(b * SEQ + t0 + tt);
                float q, k, dc;
                if (!HGRN) { float z = gb[head * 128 + d]; for (int r = 0; r < 16; ++r) z += glr[tok * 16 + r] * w2[r * 512 + head * 128 + d];
                    dc = expf(log_sigmoid(z) * (1.0f / 16.0f)); q = bf2f(u[UOFF((int)tok, qoff + head * 128 + d, pitch)]) * QSCALE; k = bf2f(u[UOFF((int)tok, koff + head * 128 + d, pitch)]); }
                else { const float lb = sigmoidf(lbraw[1024 + head * 128 + d] - lbraw[head * 128 + d]); const float f = lb + (1.f - lb) * sigmoidf(bf2f(u[UOFF((int)tok, koff + head * 128 + d, pitch)]));
                    dc = f; k = 1.f - f; const float hq = bf2f(u[UOFF((int)tok, qoff + head * 128 + d, pitch)]); q = hq * sigmoidf(hq); }
                qs[idx] = q; ks[idx] = k; dcs[idx] = dc; }
            __syncthreads();
            for (int tt = 0; tt < 16; ++tt) { const size_t tok = (size_t)(b * SEQ + t0 + tt); const float v = bf2f(u[UOFF((int)tok, voff + head * DV + e, pitch)]); float op = 0.f;
#pragma unroll
                for (int i = 0; i < DPP; ++i) { const int d = dp * DPP + i; S[i] = dcs[tt * 128 + d] * S[i] + ks[tt * 128 + d] * v; op += S[i] * qs[tt * 128 + d]; }
                ored[(dp * 16 + tt) * DV + e] = op; }
            __syncthreads();
            float ov[TPG];
#pragma unroll
            for (int j = 0; j < TPG; ++j) { const int tt = dp * TPG + j; float o = 0.f;
#pragma unroll
                for (int p = 0; p < NDP; ++p) o += ored[(p * 16 + tt) * DV + e];
                ov[j] = o; const float sq = wave_sum(o * o); if (lane == 0) wred[wave * TPG + j] = sq; }
            __syncthreads();
#pragma unroll
            for (int j = 0; j < TPG; ++j) { const int tt = dp * TPG + j; float tot = 0.f;
#pragma unroll
                for (int w = 0; w < NWG; ++w) tot += wred[(dp * NWG + w) * TPG + j];
                const float rs = 1.0f / sqrtf(tot * (1.0f / DV) + EPS); const size_t tok = (size_t)(b * SEQ + t0 + tt);
                const float g = bf2f(u[UOFF((int)tok, goff + head * DV + e, pitch)]);
                mix[tok * 2048 + mixoff + head * DV + e] = f2bf(ov[j] * rs * gain[e] * (g * sigmoidf(g))); }
            __syncthreads();
        }
    }
}
__device__ __forceinline__ void ref_cfox(const float* ff, const float* fbias, float* cfox, const int G, const int tid) {
    const int gid = blockIdx.x * 512 + tid;
    if (gid < 64) { const int b = gid >> 3, h = gid & 7; float run = 0.f;
        for (int s = 0; s < SEQ; ++s) { run += log_sigmoid(ff[(size_t)(b * SEQ + s) * 8 + h] + fbias[h]); cfox[(size_t)gid * SEQ + s] = run; } }
}
__device__ __forceinline__ void ref_att(LAS unsigned char* lds, const int tid, const int G, const int mode, const bf16* u, const int pitch, const int qoff, const int koff, const int voff,
                                        bf16* mix, const int mixoff, const float* kmean, const float* cfox) {
    const int lane = tid & 63, wave = tid >> 6;
    LAS float* qf = (LAS float*)lds + wave * 128;
    for (int rowid = blockIdx.x * NWAVES + wave; rowid < NB * 8 * SEQ; rowid += G * NWAVES) {
        const int b = rowid >> 14, h = (rowid >> 11) & 7, t = rowid & 2047, j = t >> 8;
        const unsigned qq = *(const unsigned*)(u + UOFF(b * SEQ + t, qoff + h * 128 + 2 * lane, pitch));
        const float q0 = __uint_as_float(qq << 16), q1 = __uint_as_float(qq & 0xffff0000u);
        qf[2 * lane] = q0; qf[2 * lane + 1] = q1;
        unsigned bits = 0xffu;
        if (mode == 0) {
            float gate[7];
#pragma unroll
            for (int n = 0; n < 7; ++n) { const float* km = kmean + (size_t)((b * 8 + h) * 8 + n) * 128; gate[n] = wave_sum(q0 * km[2 * lane] + q1 * km[2 * lane + 1]); }
            if (j <= 3) bits = (1u << j) - 1u;
            else { bits = 0u;
#pragma unroll
                for (int pick = 0; pick < 3; ++pick) { float best = -__builtin_inff(); int bi = 0;
#pragma unroll
                    for (int n = 0; n < 7; ++n) if (n < j && !((bits >> n) & 1u) && gate[n] > best) { best = gate[n]; bi = n; }
                    bits |= 1u << bi; } }
        }
        const float slope = exp2f(-(float)(h + 1));
        const float ct = mode ? cfox[(size_t)(b * 8 + h) * SEQ + t] : 0.f;
        float m = -1e30f, l = 0.f, o0 = 0.f, o1 = 0.f;
        for (int kb = 0; kb <= t; kb += 64) {
            const int s = kb + lane; const int sc = s <= t ? s : t;
            bool valid = s <= t;
            if (mode == 0 && valid) { const int n = s >> 8; valid = (n == j) || ((bits >> n) & 1u); }
            float dot = 0.f;
            for (int c = 0; c < 16; ++c) { const bf16x8 kv = *(const bf16x8*)(u + UOFF(b * SEQ + sc, koff + h * 128 + 8 * c, pitch));
#pragma unroll
                for (int e = 0; e < 8; ++e) dot += qf[8 * c + e] * bf2f((unsigned short)kv[e]); }
            const float bias = mode ? (ct - cfox[(size_t)(b * 8 + h) * SEQ + sc]) : -slope * (float)(t - sc);
            const float logit = valid ? dot * QSCALE + bias : -__builtin_inff();
            const float mx = wave_max(logit), mnew = fmaxf(m, mx), alpha = expf(m - mnew);
            const float p = valid ? expf(logit - mnew) : 0.f;
            l = l * alpha + wave_sum(p); o0 *= alpha; o1 *= alpha; m = mnew;
            const int nk = (t - kb + 1) < 64 ? (t - kb + 1) : 64;
            for (int jj = 0; jj < nk; ++jj) { const float pj = __shfl(p, jj); const unsigned vv = *(const unsigned*)(u + UOFF(b * SEQ + kb + jj, voff + h * 128 + 2 * lane, pitch));
                o0 += pj * __uint_as_float(vv << 16); o1 += pj * __uint_as_float(vv & 0xffff0000u); }
        }
        const float inv = 1.0f / l;
        *(unsigned*)(mix + (size_t)(b * SEQ + t) * 2048 + mixoff + h * 128 + 2 * lane) = cvtpk(o0 * inv, o1 * inv);
    }
}

#ifndef ONE_LAUNCH
#define ONE_LAUNCH 1
#endif
#ifndef REF_LIN0
#define REF_LIN0 0
#endif
#ifndef REF_LIN1
#define REF_LIN1 0
#endif
#ifndef REF_ATT0
#define REF_ATT0 0
#endif
#ifndef REF_ATT1
#define REF_ATT1 0
#endif
#ifndef PROBES
#define PROBES 0
#endif
#if PROBES
#define KV(x) (K->variant & (x))
#else
#define KV(x) 0
#endif
#ifndef PG_SP2
#define PG_SP2 true
#endif
#ifndef PG_ALIGN
#define PG_ALIGN true
#endif
#ifndef STAGGER_STEPS
#define STAGGER_STEPS 0
#endif
#define STAGGER() do { if (STAGGER_STEPS > 0) { const int n_ = (int)((blockIdx.x >> 3) & 15u); for (int i_ = 0; i_ < n_; ++i_) __builtin_amdgcn_s_sleep(STAGGER_STEPS); } } while (0)
constexpr int N_PHASES = 20;
__global__ void __launch_bounds__(NWAVES * 64, 2) fwd(Args a_unused) {
    extern __shared__ __attribute__((aligned(16))) unsigned char lds_raw[];
    LAS unsigned char* lds = (LAS unsigned char*)lds_raw;
    volatile LAS unsigned* MISC = (volatile LAS unsigned*)(lds + MISC_OFF);
    const int G = gridDim.x;
    if (threadIdx.x < 64) MISC[threadIdx.x] = 0u;
    __syncthreads();
    int lo, hi;
    XcdBarrier bar;
    { KArgsP K = kargs(); lo = K->ph_lo; hi = K->ph_hi; unsigned char* ws = K->ws;
      bar.bar = (unsigned*)(ws + WS_CTL) + CW_BAR; bar.x = 0; bar.st = nullptr;
      if (hi - lo > 1) bar = xcd_barrier_post((unsigned*)(ws + WS_CTL) + CW_BAR, MISC + 8); }
#define PH(k) (lo <= (k) && (k) < hi)
#ifndef SEAM_REPS
#define SEAM_REPS 1
#endif
#ifndef PROBE_WAIT_MASK
#define PROBE_WAIT_MASK 0xffffffffu
#endif
#ifdef PROBE_WAIT
#define SEAM(k) do { if (PH(k) && PH((k) + 1)) { unsigned long long t0_ = 0; if (threadIdx.x == 0) t0_ = __builtin_amdgcn_s_memrealtime(); xcd_barrier(bar); \
        if (threadIdx.x == 0 && ((PROBE_WAIT_MASK >> (k)) & 1u)) MISC[20] += (unsigned)(__builtin_amdgcn_s_memrealtime() - t0_); } } while (0)
#else
#define SEAM(k) do { if (PH(k) && PH((k) + 1)) { for (int r_ = 0; r_ < SEAM_REPS; ++r_) xcd_barrier(bar); } } while (0)
#endif
#define WSP(T, off) ((T*)(ws + (off)))

    if (PH(0)) { KArgsP K = kargs(); const int tid = otid(), lane = tid & 63, wave = __builtin_amdgcn_readfirstlane(tid >> 6); (void)lane; (void)wave; if (!KV(32)) phase_transposes(lds, K, G, wave, lane); __syncthreads(); if (!KV(64)) phase_norm0(lds, K, G, tid, wave, lane); __syncthreads(); }
    SEAM(0);
    for (int layer = 0; layer < 2; ++layer) {
        const int pb = 1 + 9 * layer;
        if (PH(pb + 0)) {
            KArgsP K = kargs(); const int tid = otid(), lane = tid & 63, wave = __builtin_amdgcn_readfirstlane(tid >> 6); (void)lane; (void)wave; unsigned char* ws = K->ws; const int NU = layer ? NU1 : NU0;
            const bf16* h16 = (const bf16*)((unsigned char*)K->out + OUT_H16);
            if (layer == 1) phase_ff(lds, K->in[11], K->in[10], h16, WSP(float, WS_ROWSS2), WSP(float, WS_FF), G, tid, wave, lane);
            pg8::Gemm g{h16, WSP(bf16, layer ? WS_WIN1 : WS_WIN0), MTOK, NU, DM, KV(4), 1, WTILED}; pg8::StaticOrder S; S.init(MTOK, NU, G, (int)blockIdx.x);
            int pm0 = -1; { pg8::Unit u0; if (S.next(0, u0)) pm0 = u0.pm; }
            LAS float* rtab = (LAS float*)(lds + 131072);
            if (pm0 >= 0 && tid < 256) { const f32x4* pp = (const f32x4*)(WSP(float, layer ? WS_ROWSS2 : WS_ROWSS) + (size_t)(pm0 * 256 + tid) * 32); float sq = 0.f;
#pragma unroll
                for (int q = 0; q < 8; ++q) { const f32x4 t = pp[q]; sq += (t[0] + t[1]) + (t[2] + t[3]); }
                rtab[tid] = __builtin_amdgcn_rsqf(sq * (1.0f / 2048.0f) + EPS); }
            __syncthreads();
            pg8::EpiScale<0, UTILED != 0> E{WSP(bf16, WS_U), NU, WSP(float, layer ? WS_ROWSS2 : WS_ROWSS), 0, rtab, pm0};
            STAGGER();
            pg8::gemm_phase<pg8::EpiScale<0, UTILED != 0>, pg8::StaticOrder, PG_ALIGN, PG_SP2>(lds, g, S, E);
        }
        SEAM(pb + 0);
        if (PH(pb + 1)) {
            KArgsP K = kargs(); const int tid = otid(), lane = tid & 63, wave = __builtin_amdgcn_readfirstlane(tid >> 6); (void)lane; (void)wave; unsigned char* ws = K->ws;
            if (layer == 0) {
#ifdef PROBE_KMEAN
                unsigned long long tk_ = 0; if (threadIdx.x == 0) tk_ = __builtin_amdgcn_s_memrealtime();
#endif
                phase_kmean(lds, WSP(bf16, WS_U), WSP(float, WS_KMEAN), G, tid);
#ifdef PROBE_KMEAN
                __syncthreads(); if (threadIdx.x == 0) MISC[20] += (unsigned)(__builtin_amdgcn_s_memrealtime() - tk_);
#endif
#if !REF_LIN0
                LinArgs L{WSP(bf16, WS_U), NU0, C0_GQ, C0_GK, C0_GV, C0_GG, WSP(float, WS_BCUM), nullptr, K->in[5], WSP(float, WS_P), WSP(float, WS_DSC), WSP(bf16, WS_S), WSP(bf16, WS_P), 0};
                for (int unit = blockIdx.x; unit < 256; unit += G) { const int sc = unit & 7; if (sc < 7) lin_unit<256, 8, false, false>(lds, tid, L, unit >> 5, (unit >> 3) & 3, sc); }
#endif
            } else {
#if !REF_LIN1
                LinArgs L{WSP(bf16, WS_U), NU1, C1_HQ, C1_HF, C1_HI, C1_HG, nullptr, K->in[18], K->in[13], WSP(float, WS_P), WSP(float, WS_DSC), WSP(bf16, WS_S), WSP(bf16, WS_P), 1024};
                for (int unit = blockIdx.x; unit < 256; unit += G) { const int sc = unit & 7; if (sc < 7) lin_unit<128, 4, true, false>(lds, tid, L, unit >> 5, 2 * ((unit >> 3) & 3), sc); }
#endif
            }
        }
        SEAM(pb + 1);
        if (PH(pb + 2)) {
            KArgsP K = kargs(); const int tid = otid(), lane = tid & 63, wave = __builtin_amdgcn_readfirstlane(tid >> 6); (void)lane; (void)wave; unsigned char* ws = K->ws; (void)ws;
#ifdef PROBE_BURN
            if (KV(16)) {
                const bf16x8 a0 = *(const bf16x8*)(WSP(bf16, WS_U) + (size_t)tid * 64), b0 = *(const bf16x8*)(WSP(bf16, WS_U) + (size_t)tid * 64 + 8);
                const bf16x8 a1 = *(const bf16x8*)(WSP(bf16, WS_U) + (size_t)tid * 64 + 16), b1 = *(const bf16x8*)(WSP(bf16, WS_U) + (size_t)tid * 64 + 24);
                f32x4 acc[16];
#pragma unroll
                for (int i = 0; i < 16; ++i) acc[i] = (f32x4){0.f, 0.f, 0.f, 0.f};
                for (int it = 0; it < 32768 / 16; ++it) {
#pragma unroll
                    for (int i = 0; i < 16; ++i) acc[i] = __builtin_amdgcn_mfma_f32_16x16x32_bf16((i & 1) ? a1 : a0, (i & 2) ? b1 : b0, acc[i], 0, 0, 0);
                }
                float sum = 0.f;
#pragma unroll
                for (int i = 0; i < 16; ++i) sum += acc[i][0] + acc[i][1] + acc[i][2] + acc[i][3];
                if (sum == 1.2345f) WSP(float, WS_CFOX)[tid] = sum;
            } else
#endif
            if (layer == 0) {
#if !REF_LIN0
                phase_scan<256>(WSP(float, WS_P), WSP(float, WS_DSC), WSP(bf16, WS_S), G, tid);
#endif
            } else {
#if !REF_LIN1
                phase_scan<128>(WSP(float, WS_P), WSP(float, WS_DSC), WSP(bf16, WS_S), G, tid);
#endif
#if REF_ATT1
                ref_cfox(WSP(float, WS_FF), K->in[12], WSP(float, WS_CFOX), G, tid);
#endif
            }
        }
        SEAM(pb + 2);
        if (PH(pb + 3)) {
            KArgsP K = kargs(); const int tid = otid(), lane = tid & 63, wave = __builtin_amdgcn_readfirstlane(tid >> 6); (void)lane; (void)wave; unsigned char* ws = K->ws;
            const int variant = KV(0xff);
            if (variant & 1) {} else
            if (layer == 0) {
#if REF_LIN0
                ref_lin<256, false>(lds, tid, G, WSP(bf16, WS_U), NU0, C0_GQ, C0_GK, C0_GV, C0_GG, WSP(float, WS_GLR), K->in[3], K->in[4], nullptr, K->in[5], WSP(bf16, WS_P), 0);
#else
                { LinArgs L{WSP(bf16, WS_U), NU0, C0_GQ, C0_GK, C0_GV, C0_GG, WSP(float, WS_BCUM), nullptr, K->in[5], WSP(float, WS_P), WSP(float, WS_DSC), WSP(bf16, WS_S), WSP(bf16, WS_P), 0};
                  for (int unit = blockIdx.x; unit < 256; unit += G) lin_unit<256, 8, false, true>(lds, tid, L, unit >> 5, (unit >> 3) & 3, unit & 7); }
#endif
#if REF_ATT0
                ref_att(lds, tid, G, 0, WSP(bf16, WS_U), NU0, C0_MQ, C0_MK, C0_MV, WSP(bf16, WS_P), 1024, WSP(float, WS_KMEAN), nullptr);
#endif
            } else {
#if REF_LIN1
                ref_lin<128, true>(lds, tid, G, WSP(bf16, WS_U), NU1, C1_HQ, C1_HF, C1_HI, C1_HG, nullptr, nullptr, nullptr, K->in[18], K->in[13], WSP(bf16, WS_P), 1024);
#else
                { LinArgs L{WSP(bf16, WS_U), NU1, C1_HQ, C1_HF, C1_HI, C1_HG, nullptr, K->in[18], K->in[13], WSP(float, WS_P), WSP(float, WS_DSC), WSP(bf16, WS_S), WSP(bf16, WS_P), 1024};
                  for (int unit = blockIdx.x; unit < 256; unit += G) lin_unit<128, 4, true, true>(lds, tid, L, unit >> 5, 2 * ((unit >> 3) & 3), unit & 7); }
#endif
#if REF_ATT1
                ref_att(lds, tid, G, 1, WSP(bf16, WS_U), NU1, C1_FQ, C1_FK, C1_FV, WSP(bf16, WS_P), 0, nullptr, WSP(float, WS_CFOX));
#endif
            }
            if (!(variant & 2) && ((layer == 0 && !REF_ATT0) || (layer == 1 && !REF_ATT1))) {
                const int pitch = layer ? NU1 : NU0, qoff = layer ? C1_FQ : C0_MQ, koff = layer ? C1_FK : C0_MK, voff = layer ? C1_FV : C0_MV, mixoff = layer ? 0 : 1024;
                for (int item = blockIdx.x; item < 256; item += G) att::pair_item((char*)lds_raw, item, layer, WSP(bf16, WS_U), pitch, qoff, koff, voff, WSP(bf16, WS_P), mixoff, WSP(float, WS_KMEAN), WSP(float, WS_FF), K->in[12]);
            }
        }
        SEAM(pb + 3);
        if (PH(pb + 4)) {
            KArgsP K = kargs(); const int tid = otid(), lane = tid & 63, wave = __builtin_amdgcn_readfirstlane(tid >> 6); (void)lane; (void)wave; unsigned char* ws = K->ws;
            pg8::Gemm g{WSP(bf16, WS_P), WSP(bf16, layer ? WS_WOUT1 : WS_WOUT0), MTOK, DM, DM, 0, 0, WTILED}; pg8::StaticOrder S; S.init(MTOK, DM, G, (int)blockIdx.x);
            bf16* h16 = (bf16*)((unsigned char*)K->out + OUT_H16);
            if (layer == 0) { pg8::EpiResid<true, false> E{K->in[0], h16, WSP(float, WS_ROWSS), 0, nullptr}; pg8::gemm_phase<pg8::EpiResid<true, false>, pg8::StaticOrder, PG_ALIGN, PG_SP2>(lds, g, S, E); }
            else { pg8::EpiResid<false, false> E{h16, h16, WSP(float, WS_ROWSS), 0, nullptr}; pg8::gemm_phase<pg8::EpiResid<false, false>, pg8::StaticOrder, PG_ALIGN, PG_SP2>(lds, g, S, E); }
        }
        SEAM(pb + 4);
        for (int half = 0; half < MLP_SPLIT; ++half) {
            if (PH(pb + 5 + 2 * half)) {
                KArgsP K = kargs(); const int tid = otid(), lane = tid & 63, wave = __builtin_amdgcn_readfirstlane(tid >> 6); (void)lane; (void)wave; unsigned char* ws = K->ws;
                pg8::Gemm g{(const bf16*)((unsigned char*)K->out + OUT_H16) + (size_t)half * MHALF * DM, WSP(bf16, layer ? WS_WUP1 : WS_WUP0), MHALF, DFF, DM, KV(4), 1, WTILED}; pg8::StaticOrder S; S.init(MHALF, DFF, G, (int)blockIdx.x);
                pg8::EpiSqRelu E{WSP(bf16, WS_HID + (size_t)half * HID_STRIDE), DFF};
                STAGGER();
#ifdef PROBE_EPINULL
                if (KV(8)) { pg8::EpiSqReluNS E0{WSP(bf16, WS_HID), DFF}; pg8::gemm_phase<pg8::EpiSqReluNS, pg8::StaticOrder, PG_ALIGN, PG_SP2>(lds, g, S, E0); } else
#endif
                pg8::gemm_phase<pg8::EpiSqRelu, pg8::StaticOrder, PG_ALIGN, PG_SP2>(lds, g, S, E);
            }
            SEAM(pb + 5 + 2 * half);
            if (PH(pb + 6 + 2 * half)) {
                KArgsP K = kargs(); const int tid = otid(), lane = tid & 63, wave = __builtin_amdgcn_readfirstlane(tid >> 6); (void)lane; (void)wave; unsigned char* ws = K->ws;
                pg8::Gemm g{WSP(bf16, WS_HID + (size_t)half * HID_STRIDE), WSP(bf16, layer ? WS_WDN1 : WS_WDN0), MHALF, DM, DFF, 0, 1, WTILED}; pg8::StaticOrder S; S.init(MHALF, DM, G, (int)blockIdx.x);
                bf16* h16 = (bf16*)((unsigned char*)K->out + OUT_H16);
                pg8::EpiResid<false, true> E{h16, layer ? WSP(bf16, WS_HFIN) : h16, WSP(float, WS_ROWSS2), half * MHALF, WSP(float, WS_ROWSS)};
                pg8::gemm_phase<pg8::EpiResid<false, true>, pg8::StaticOrder, PG_ALIGN, PG_SP2>(lds, g, S, E);
            }
            if (!HID_DB || half == MLP_SPLIT - 1) SEAM(pb + 6 + 2 * half);
        }
    }
#ifdef PROBE_WAIT
    float probe_scale = 1.f;
    if (PH(19)) { KArgsP K = kargs(); unsigned* acc = (unsigned*)(K->ws + WS_CTL) + 64;
        if (threadIdx.x == 0) atomicAdd(acc, MISC[20]);
        xcd_barrier(bar);
        const unsigned tot = __hip_atomic_load(acc, __ATOMIC_RELAXED, __HIP_MEMORY_SCOPE_AGENT);
        const float avg_us = (float)tot * 0.01f / (float)G;
        probe_scale = 1.f + sqrtf(avg_us * PROBE_WAIT_UNIT); }
#endif
    if (PH(19)) { KArgsP K = kargs(); const int tid = otid(), lane = tid & 63, wave = __builtin_amdgcn_readfirstlane(tid >> 6); (void)lane; (void)wave; unsigned char* ws = K->ws; phase_final_norm(WSP(bf16, WS_HFIN), K->out, K->in[19], WSP(float, WS_ROWSS2), G, wave, lane
#ifdef PROBE_WAIT
        , probe_scale
#endif
        ); }
#undef PH
#undef SEAM
#undef WSP
}

extern "C" void kernel_launch(void* const* d_in, const int* in_sizes, int n_in, void* d_out, int out_size, void* d_ws, size_t ws_size, hipStream_t stream) {
    static int grid = 0;
    if (grid == 0) {
        if (n_in != 20 || in_sizes[0] != MTOK * DM || out_size != MTOK * DM || ws_size < WS_END) {
            fprintf(stderr, "kernel_launch: unexpected problem (n_in %d, in0 %d, out %d, ws %zu; need ws >= %zu); nothing launched\n", n_in, n_in > 0 ? in_sizes[0] : -1, out_size, ws_size, (size_t)WS_END); grid = -1; return; }
        int dev = 0, cus = 0, per_cu = 0;
        if (hipGetDevice(&dev) != hipSuccess || hipDeviceGetAttribute(&cus, hipDeviceAttributeMultiprocessorCount, dev) != hipSuccess) { fprintf(stderr, "kernel_launch: device query failed\n"); grid = -1; return; }
        if (hipFuncSetAttribute((const void*)fwd, hipFuncAttributeMaxDynamicSharedMemorySize, LDS_BYTES) != hipSuccess) { fprintf(stderr, "kernel_launch: hipFuncSetAttribute failed\n"); grid = -1; return; }
        if (hipOccupancyMaxActiveBlocksPerMultiprocessor(&per_cu, (const void*)fwd, NWAVES * 64, LDS_BYTES) != hipSuccess || per_cu < 1)
            fprintf(stderr, "kernel_launch: note: occupancy query reports %d workgroups per CU\n", per_cu);
        (void)hipGetLastError();
        grid = cus;
    }
    if (grid < 0) return;
    if (hipMemsetAsync((char*)d_ws + WS_CTL, 0, CTL_ZERO_BYTES, stream) != hipSuccess) { fprintf(stderr, "kernel_launch: memset failed\n"); return; }
    Args a{};
    for (int i = 0; i < 20; ++i) a.in[i] = (const float*)d_in[i];
    a.out = (float*)d_out; a.ws = (unsigned char*)d_ws;
#if ONE_LAUNCH
    a.ph_lo = 0; a.ph_hi = N_PHASES;
    hipLaunchKernelGGL(fwd, dim3(grid), dim3(NWAVES * 64), LDS_BYTES, stream, a);
#else
#ifndef REPEAT_MASK
#define REPEAT_MASK 0u
#endif
#ifndef REPEAT_VARIANT
#define REPEAT_VARIANT 0
#endif
    for (int p = 0; p < N_PHASES; ++p) { a.ph_lo = p; a.ph_hi = p + 1;
        if ((REPEAT_MASK >> p) & 1u) { a.variant = REPEAT_VARIANT; hipLaunchKernelGGL(fwd, dim3(grid), dim3(NWAVES * 64), LDS_BYTES, stream, a); a.variant = 0; }
        hipLaunchKernelGGL(fwd, dim3(grid), dim3(NWAVES * 64), LDS_BYTES, stream, a); }
#endif
    const hipError_t le = hipPeekAtLastError();
    if (le != hipSuccess) fprintf(stderr, "kernel_launch: launch failed: %s\n", hipGetErrorName(le));
}
```

```cpp
#include <hip/hip_runtime.h>
#include <cstdio>
#include <cstdint>
#include <cmath>
__device__ __forceinline__ int otid() { int t = threadIdx.x; asm volatile("" : "+v"(t)); return t; }
#define ONE_LAUNCH 1
namespace pg8 {
#define PG8_LAS __attribute__((address_space(3)))
typedef unsigned short bf16_t;
typedef short bf16x8 __attribute__((ext_vector_type(8)));
typedef float f32x4 __attribute__((ext_vector_type(4)));
typedef unsigned u32x4 __attribute__((ext_vector_type(4)));
constexpr int BM = 256, BK = 64, HALF = 128, HTB = HALF * BK * 2  , STAGE_BYTES = 8 * HTB, NXCD = 8, WGM = 8;

__host__ __device__ __forceinline__ int lds_byte(int r, int c) { const int st = (r >> 4) * 2 + (c >> 5), rr = r & 15, cc = c & 31, ob = rr * 64 + cc * 2; return st * 1024 + (ob ^ (((ob >> 9) & 1) << 5)); }
__host__ __device__ __forceinline__ void stage_rc(int b, int& R, int& C) { const int st = b / 1024, sb = b % 1024, swz = sb ^ (((sb >> 9) & 1) << 5); R = (st >> 1) * 16 + swz / 64; C = (st & 1) * 32 + (swz % 64) / 2; }
__host__ __device__ __forceinline__ int perm32(int rho) { const int n = rho >> 4, i = rho & 15; return 8 * (i >> 2) + 4 * n + (i & 3); }

struct Unit { int pm, pn; };
struct Gemm { const bf16_t* A; const bf16_t* Bt; int M, N, K; int sp; int atile; int btile; };

struct StaticOrder {
    int nM, nN, nwg, G, c;
    __host__ __device__ void init(int M, int N, int G_, int c_) { nM = M / BM; nN = N / BM; nwg = nM * nN; G = G_; c = c_; }
    __host__ __device__ __forceinline__ bool next(int i, Unit& u) const {
        const long L = (long)i * G + c; if (L >= nwg) return false;
        int wgid = (int)L; { const int q = nwg / NXCD, r = nwg % NXCD, xcd = wgid % NXCD, off = wgid / NXCD; wgid = (xcd < r ? xcd * (q + 1) : r * (q + 1) + (xcd - r) * q) + off; }
        const int nig = WGM * nN, gid = wgid / nig, fm = gid * WGM, gsz = (nM - fm) < WGM ? (nM - fm) : WGM;
        u.pm = fm + ((wgid % nig) % gsz); u.pn = (wgid % nig) / gsz; return true;
    }
    __device__ __forceinline__ void a_ready(const Unit&) const {}
    __device__ __forceinline__ void done(const Unit&) const {}
};
__device__ __forceinline__ unsigned cvt_pk_bf16(float lo, float hi) { unsigned r; asm volatile("v_cvt_pk_bf16_f32 %0, %1, %2" : "=v"(r) : "v"(lo), "v"(hi)); return r; }
#ifndef PG_EPIWAIT
#define PG_EPIWAIT 0
#endif
#define EPI_FENCE() asm volatile("" ::: "memory")
__host__ __device__ __forceinline__ unsigned atile_off(int R, int C) { return (unsigned)(((((R >> 6) * 2 + (C >> 5)) * 4 + ((R >> 4) & 3)) * 1024) + (((R & 15) * 4 + ((C >> 3) & 3)) * 16) + (C & 7) * 2); }
constexpr float RMS_EPS = 1e-6f;
template <int ACT, bool TILED> struct EpiScale {
    static constexpr bool PERM = true, AFTER_DRAIN = false; static constexpr int NVM = 16;
    bf16_t* O; int ldc; const float* rowss; int row_base;
    const PG8_LAS float* tab; int tab_pm;
    __device__ __forceinline__ void operator()(const f32x4 (&acc)[2][2][4][2], const Unit& u, int wr, int wc, int fr, int fq) const {
        const int lrow0 = u.pm * BM + wr * 64 + fr; const int col0 = u.pn * BM + wc * 32 + 8 * fq;
        float rsv[2][4];
        if (u.pm == tab_pm) {
#pragma unroll
            for (int ai = 0; ai < 2; ++ai)
#pragma unroll
                for (int m = 0; m < 4; ++m) rsv[ai][m] = tab[wr * 64 + fr + ai * HALF + m * 16];
        } else {
#pragma unroll
            for (int ai = 0; ai < 2; ++ai)
#pragma unroll
                for (int m = 0; m < 4; ++m) { const f32x4* pp = (const f32x4*)(rowss + (size_t)(row_base + lrow0 + ai * HALF + m * 16) * 32 + 8 * fq); const f32x4 t0 = pp[0], t1 = pp[1];
                    float s = ((t0[0] + t0[1]) + (t0[2] + t0[3])) + ((t1[0] + t1[1]) + (t1[2] + t1[3]));
                    s += __shfl_xor(s, 16); s += __shfl_xor(s, 32); rsv[ai][m] = __builtin_amdgcn_rsqf(s * (1.0f / 2048.0f) + RMS_EPS); EPI_FENCE(); }
        }
#pragma unroll
        for (int ai = 0; ai < 2; ++ai)
#pragma unroll
            for (int m = 0; m < 4; ++m) { const int lrow = lrow0 + ai * HALF + m * 16;
                const float rs = rsv[ai][m];
                bf16_t* rowp = O + (size_t)lrow * ldc + col0;
#pragma unroll
                for (int bj = 0; bj < 2; ++bj) { f32x4 v0 = acc[ai][bj][m][0] * rs, v1 = acc[ai][bj][m][1] * rs;
                    if (ACT == 1) {
#pragma unroll
                        for (int e = 0; e < 4; ++e) { const float a = fmaxf(v0[e], 0.f), b = fmaxf(v1[e], 0.f); v0[e] = a * a; v1[e] = b * b; } }
                    u32x4 w; w.x = cvt_pk_bf16(v0[0], v0[1]); w.y = cvt_pk_bf16(v0[2], v0[3]); w.z = cvt_pk_bf16(v1[0], v1[1]); w.w = cvt_pk_bf16(v1[2], v1[3]);
                    if (TILED) *(u32x4*)((unsigned char*)O + ((size_t)(u.pm * 2 + ai) * (ldc >> 6) + (u.pn * 4 + bj * 2 + (wc >> 1))) * 16384 + ((wr * 2 + (wc & 1)) * 4 + m) * 1024 + (fr * 4 + fq) * 16) = w;
                    else *(u32x4*)(rowp + bj * HALF) = w; } }
    }
};
struct EpiSqRelu {
    static constexpr bool PERM = true, AFTER_DRAIN = false; static constexpr int NVM = 16;
    bf16_t* O; int ldc;
    __device__ __forceinline__ void operator()(const f32x4 (&acc)[2][2][4][2], const Unit& u, int wr, int wc, int fr, int fq) const {
        const int ktn = ldc >> 6;
#pragma unroll
        for (int ai = 0; ai < 2; ++ai)
#pragma unroll
            for (int bj = 0; bj < 2; ++bj) { unsigned char* tile = (unsigned char*)O + ((size_t)(u.pm * 2 + ai) * ktn + (u.pn * 4 + bj * 2 + (wc >> 1))) * 16384 + ((wr * 2 + (wc & 1)) * 4) * 1024 + (fr * 4 + fq) * 16;
#pragma unroll
                for (int m = 0; m < 4; ++m) { f32x4 v0 = acc[ai][bj][m][0], v1 = acc[ai][bj][m][1];
#pragma unroll
                    for (int e = 0; e < 4; ++e) { float a, b; asm("v_max_f32_e32 %0, 0, %1" : "=v"(a) : "v"(v0[e])); asm("v_max_f32_e32 %0, 0, %1" : "=v"(b) : "v"(v1[e])); v0[e] = a * a; v1[e] = b * b; }
                    u32x4 w; w.x = cvt_pk_bf16(v0[0], v0[1]); w.y = cvt_pk_bf16(v0[2], v0[3]); w.z = cvt_pk_bf16(v1[0], v1[1]); w.w = cvt_pk_bf16(v1[2], v1[3]);
                    *(u32x4*)(tile + m * 1024) = w; } }
    }
};
struct EpiSqReluNS {
    static constexpr bool PERM = true, AFTER_DRAIN = false; static constexpr int NVM = 0;
    bf16_t* O; int ldc;
    __device__ __forceinline__ void operator()(const f32x4 (&acc)[2][2][4][2], const Unit& u, int wr, int wc, int fr, int fq) const {
        const int lrow0 = u.pm * BM + wr * 64 + fr; const int col0 = u.pn * BM + wc * 32 + 8 * fq;
#pragma unroll
        for (int ai = 0; ai < 2; ++ai)
#pragma unroll
            for (int m = 0; m < 4; ++m) { bf16_t* rowp = O + (size_t)(lrow0 + ai * HALF + m * 16) * ldc + col0;
#pragma unroll
                for (int bj = 0; bj < 2; ++bj) { f32x4 v0 = acc[ai][bj][m][0], v1 = acc[ai][bj][m][1];
#pragma unroll
                    for (int e = 0; e < 4; ++e) { float a, b; asm("v_max_f32_e32 %0, 0, %1" : "=v"(a) : "v"(v0[e])); asm("v_max_f32_e32 %0, 0, %1" : "=v"(b) : "v"(v1[e])); v0[e] = a * a; v1[e] = b * b; }
                    u32x4 w; w.x = cvt_pk_bf16(v0[0], v0[1]); w.y = cvt_pk_bf16(v0[2], v0[3]); w.z = cvt_pk_bf16(v1[0], v1[1]); w.w = cvt_pk_bf16(v1[2], v1[3]);
                    *(u32x4*)(O + (((size_t)(u.pm * 32 + u.pn) * 8 + (wr * 4 + wc)) * 16 + (ai * 8 + m * 2 + bj)) * 512 + (fq * 16 + fr) * 8) = w;     } }
    }
};
template <bool F32IN, bool RS2> struct EpiResid {
    static constexpr bool PERM = true, AFTER_DRAIN = false; static constexpr int NVM = 16;
    const void* hin; bf16_t* hout; float* rowss; int row_base; const float* rowss_in;
    __device__ __forceinline__ void operator()(const f32x4 (&acc)[2][2][4][2], const Unit& u, int wr, int wc, int fr, int fq) const {
        const int row0 = row_base + u.pm * BM + wr * 64 + fr; const int col0 = u.pn * BM + wc * 32 + 8 * fq;
        const size_t tb0 = ((size_t)((row_base >> 7) + u.pm * 2) * 32 + (u.pn * 4 + (wc >> 1))) * 16384 + ((wr * 2 + (wc & 1)) * 4) * 1024 + (fr * 4 + fq) * 16;
#define EPI_TOFF(ai_, m_, bj_) (tb0 + ((size_t)(ai_) * 32 + (bj_) * 2) * 16384 + (m_) * 1024)
        float rs2[2][4];
        if (RS2) { f32x4 pr[2][4][2];
#pragma unroll
            for (int ai = 0; ai < 2; ++ai)
#pragma unroll
                for (int m = 0; m < 4; ++m) { const f32x4* pp = (const f32x4*)(rowss_in + (size_t)(row0 + ai * HALF + m * 16) * 32 + 8 * fq); pr[ai][m][0] = pp[0]; pr[ai][m][1] = pp[1]; }
            EPI_FENCE();
#pragma unroll
            for (int ai = 0; ai < 2; ++ai)
#pragma unroll
                for (int m = 0; m < 4; ++m) { const f32x4 t0 = pr[ai][m][0], t1 = pr[ai][m][1]; float sq = ((t0[0] + t0[1]) + (t0[2] + t0[3])) + ((t1[0] + t1[1]) + (t1[2] + t1[3]));
                    sq += __shfl_xor(sq, 16); sq += __shfl_xor(sq, 32); rs2[ai][m] = __builtin_amdgcn_rcpf(sq * (1.0f / 2048.0f) + RMS_EPS); }
        }
        f32x4 hb[2][2][2][2];
#define EPI_LOAD(buf, k) do { _Pragma("unroll") for (int q_ = 0; q_ < 2; ++q_) { const int ai_ = (k) >> 1, m_ = 2 * ((k) & 1) + q_;                                                                          \
            _Pragma("unroll") for (int bj = 0; bj < 2; ++bj) {                                                                                                                                                  \
                if (F32IN) { const float* p_ = (const float*)hin + (size_t)(row0 + ai_ * HALF + m_ * 16) * 2048 + col0 + bj * HALF; hb[buf][q_][bj][0] = *(const f32x4*)p_; hb[buf][q_][bj][1] = *(const f32x4*)(p_ + 4); } \
                else { const u32x4 t_ = *(const u32x4*)((const unsigned char*)hin + EPI_TOFF(ai_, m_, bj));                                                                                                   \
                       hb[buf][q_][bj][0] = (f32x4){__uint_as_float(t_.x << 16), __uint_as_float(t_.x & 0xffff0000u), __uint_as_float(t_.y << 16), __uint_as_float(t_.y & 0xffff0000u)};                         \
                       hb[buf][q_][bj][1] = (f32x4){__uint_as_float(t_.z << 16), __uint_as_float(t_.z & 0xffff0000u), __uint_as_float(t_.w << 16), __uint_as_float(t_.w & 0xffff0000u)}; } } } } while (0)
        EPI_LOAD(0, 0); EPI_FENCE();
#pragma unroll
        for (int k = 0; k < 4; ++k) {
            if (k < 3) { if (k & 1) EPI_LOAD(0, k + 1); else EPI_LOAD(1, k + 1); }
            EPI_FENCE();
#pragma unroll
            for (int q = 0; q < 2; ++q) { const int ai = k >> 1, m = 2 * (k & 1) + q; const int row = row0 + ai * HALF + m * 16; float ss = 0.f;
#pragma unroll
                for (int bj = 0; bj < 2; ++bj) {
                    const f32x4 v0 = (RS2 ? acc[ai][bj][m][0] * rs2[ai][m] : acc[ai][bj][m][0]) + hb[k & 1][q][bj][0], v1 = (RS2 ? acc[ai][bj][m][1] * rs2[ai][m] : acc[ai][bj][m][1]) + hb[k & 1][q][bj][1];
                    u32x4 p; p.x = cvt_pk_bf16(v0[0], v0[1]); p.y = cvt_pk_bf16(v0[2], v0[3]); p.z = cvt_pk_bf16(v1[0], v1[1]); p.w = cvt_pk_bf16(v1[2], v1[3]);
                    *(u32x4*)((unsigned char*)hout + EPI_TOFF(ai, m, bj)) = p;
                    const float r0 = __uint_as_float(p.x << 16), r1 = __uint_as_float(p.x & 0xffff0000u), r2 = __uint_as_float(p.y << 16), r3 = __uint_as_float(p.y & 0xffff0000u);
                    const float r4 = __uint_as_float(p.z << 16), r5 = __uint_as_float(p.z & 0xffff0000u), r6 = __uint_as_float(p.w << 16), r7 = __uint_as_float(p.w & 0xffff0000u);
                    ss += ((r0 * r0 + r1 * r1) + (r2 * r2 + r3 * r3)) + ((r4 * r4 + r5 * r5) + (r6 * r6 + r7 * r7)); }
                ss += __shfl_xor(ss, 16); ss += __shfl_xor(ss, 32);
                if (fq == 0) rowss[(size_t)row * 32 + u.pn * 4 + wc] = ss; }
            EPI_FENCE();
        }
#undef EPI_LOAD
#undef EPI_TOFF
    }
};
struct EpiNull {
    static constexpr bool PERM = true, AFTER_DRAIN = false; static constexpr int NVM = 0;
    __device__ __forceinline__ void operator()(const f32x4 (&acc)[2][2][4][2], const Unit&, int, int, int, int) const {
#pragma unroll
        for (int ai = 0; ai < 2; ++ai)
#pragma unroll
            for (int bj = 0; bj < 2; ++bj)
#pragma unroll
                for (int m = 0; m < 4; ++m)
#pragma unroll
                    for (int n = 0; n < 2; ++n) asm volatile("" :: "v"(acc[ai][bj][m][n]));
    }
};
template <class Epi, class Sched, bool ALIGN_EPI = false, bool SP2 = false>
__device__ __forceinline__ void gemm_phase(PG8_LAS unsigned char* lds, const Gemm g, const Sched& S, const Epi& E) {
    const int tid = otid(), wid = __builtin_amdgcn_readfirstlane(tid >> 6), lane = tid & 63, wr = wid >> 2, wc = wid & 3, fr = lane & 15, fq = lane >> 4;
    const int K = g.K, nt = K / BK;
    unsigned voffA[2], voffB[2];
#pragma unroll
    for (int i = 0; i < 2; ++i) { int R, C; stage_rc(tid * 16 + i * 8192, R, C); const int Rb = Epi::PERM ? ((R & ~31) + perm32(R & 31)) : R;
        voffA[i] = g.atile ? atile_off(R, C) : (unsigned)(R * K + C) * 2u; voffB[i] = g.btile ? atile_off(Rb, C) : (unsigned)(Rb * K + C) * 2u; }
    const size_t kstepB = g.btile ? (size_t)16384 : (size_t)(BK * 2), kstepA = g.atile ? (size_t)16384 : (size_t)(BK * 2);
    const size_t hstepB = (size_t)HALF * K * 2, hstepA = hstepB;
    const size_t tstepB = 2 * hstepB, tstepA = 2 * hstepA;
    const unsigned ldsw = (unsigned)wid * 1024u;
    const int aoff = lds_byte(wr * 64 + fr, fq * 8), boff = lds_byte(wc * 32 + fr, fq * 8);
#define PG8_SA(b, h) (((b) * 2 + (h)) * HTB)
#define PG8_SB(b, h) ((4 + (b) * 2 + (h)) * HTB)
#define PG8_STAGE(bufoff, gbase, voff) do { _Pragma("unroll") for (int _i = 0; _i < 2; ++_i) \
        __builtin_amdgcn_global_load_lds((const unsigned*)((const char*)(gbase) + (voff)[_i]), (PG8_LAS unsigned*)(lds + (bufoff) + ldsw + _i * 8192), 16, 0, 0); } while (0)
#define PG8_LDA(dst, b, h) do { _Pragma("unroll") for (int m = 0; m < 4; ++m) _Pragma("unroll") for (int k = 0; k < 2; ++k) dst[m][k] = *(const PG8_LAS bf16x8*)(lds + PG8_SA(b, h) + aoff + m * 2048 + k * 1024); } while (0)
#define PG8_LDB(dst, b, h) do { _Pragma("unroll") for (int n = 0; n < 2; ++n) _Pragma("unroll") for (int k = 0; k < 2; ++k) dst[n][k] = *(const PG8_LAS bf16x8*)(lds + PG8_SB(b, h) + boff + n * 2048 + k * 1024); } while (0)
#define PG8_MMA(ai, bj, At, Bt) do { __builtin_amdgcn_s_setprio(1); _Pragma("unroll") for (int m = 0; m < 4; ++m) _Pragma("unroll") for (int n = 0; n < 2; ++n) _Pragma("unroll") for (int k = 0; k < 2; ++k) \
        acc[ai][bj][m][n] = __builtin_amdgcn_mfma_f32_16x16x32_bf16(Bt[n][k], At[m][k], acc[ai][bj][m][n], 0, 0, 0); __builtin_amdgcn_s_setprio(0); } while (0)
#define PG8_WAIT_V(n) asm volatile("s_waitcnt vmcnt(" #n ")" ::: "memory")
#define PG8_WAIT_VE do { if (PG_EPIWAIT && Epi::NVM >= 16) asm volatile("s_cmp_eq_u32 %0, 0\n\ts_cbranch_scc1 .LPG8A%=\n\ts_waitcnt vmcnt(24)\n\ts_branch .LPG8B%=\n.LPG8A%=:\n\ts_waitcnt vmcnt(8)\n.LPG8B%=:" :: "s"(epi_first) : "memory", "scc"); else PG8_WAIT_V(8); } while (0)
#define PG8_WAIT_L(n) asm volatile("s_waitcnt lgkmcnt(" #n ")" ::: "memory")
#define PG8_BAR __builtin_amdgcn_s_barrier()
#define PG8_SCHED __builtin_amdgcn_sched_barrier(0)
    Unit cur, nxt; int ui = 0;
    if (!S.next(0, cur)) return;
    f32x4 acc[2][2][4][2];
#pragma unroll
    for (int a = 0; a < 2; ++a)
#pragma unroll
        for (int b = 0; b < 2; ++b)
#pragma unroll
            for (int m = 0; m < 4; ++m)
#pragma unroll
                for (int n = 0; n < 2; ++n) acc[a][b][m][n] = (f32x4){0.f, 0.f, 0.f, 0.f};
    bf16x8 At[4][2], B0[2][2], B1[2][2];
    const char* cA = (const char*)g.A + (size_t)(g.sp ? 0 : cur.pm) * tstepA; const char* cB = (const char*)g.Bt + (size_t)(g.sp ? 0 : cur.pn) * tstepB;
    S.a_ready(cur);
    if constexpr (SP2) {
        PG8_STAGE(PG8_SB(0, 0), cB, voffB); PG8_STAGE(PG8_SB(0, 1), cB + hstepB, voffB); PG8_STAGE(PG8_SA(0, 0), cA, voffA); PG8_STAGE(PG8_SA(0, 1), cA + hstepA, voffA);
        if (wr == 1) PG8_BAR;
        PG8_WAIT_V(2); PG8_BAR;
        PG8_STAGE(PG8_SB(1, 0), cB + kstepB, voffB); PG8_STAGE(PG8_SA(1, 0), cA + kstepA, voffA); PG8_STAGE(PG8_SB(1, 1), cB + hstepB + kstepB, voffB);
        PG8_WAIT_V(6); PG8_BAR;
    } else {
        PG8_STAGE(PG8_SB(0, 0), cB, voffB); PG8_STAGE(PG8_SA(0, 0), cA, voffA); PG8_STAGE(PG8_SB(0, 1), cB + hstepB, voffB); PG8_STAGE(PG8_SA(0, 1), cA + hstepA, voffA);
        if (wr == 1) PG8_BAR;
        PG8_WAIT_V(4); PG8_BAR;
        PG8_STAGE(PG8_SB(1, 0), cB + kstepB, voffB); PG8_STAGE(PG8_SA(1, 0), cA + kstepA, voffA); PG8_STAGE(PG8_SB(1, 1), cB + hstepB + kstepB, voffB);
        PG8_WAIT_V(6); PG8_BAR;
    }
    for (;;) {
        const bool has_next = S.next(ui + 1, nxt);
        const char* nA = has_next ? (const char*)g.A + (size_t)(g.sp ? 0 : nxt.pm) * tstepA : cA; const char* nB = has_next ? (const char*)g.Bt + (size_t)(g.sp ? 0 : nxt.pn) * tstepB : cB;
        for (int t = 0; t < nt; t += 2) {
            const bool last = (t == nt - 2);
            const int epi_first = __builtin_amdgcn_readfirstlane((t == 0 && ui > 0) ? 1 : 0);
            const char* a1 = cA + (size_t)(t + 1) * kstepA;
            const char* a2 = last ? nA : cA + (size_t)(t + 2) * kstepA; const char* b2 = last ? nB : cB + (size_t)(t + 2) * kstepB;
            const char* a3 = a2 + kstepA; const char* b3 = b2 + kstepB;
            if (last && has_next) S.a_ready(nxt);
            if constexpr (SP2) {
            PG8_LDB(B0, 0, 0); PG8_LDB(B1, 0, 1); PG8_SCHED; PG8_LDA(At, 0, 0); PG8_STAGE(PG8_SA(1, 1), a1 + hstepA, voffA);
            PG8_WAIT_VE; PG8_WAIT_L(0); PG8_BAR; PG8_MMA(0, 0, At, B0); PG8_MMA(0, 1, At, B1); PG8_BAR; PG8_SCHED;
            PG8_LDA(At, 0, 1); PG8_STAGE(PG8_SB(0, 0), b2, voffB); PG8_STAGE(PG8_SB(0, 1), b2 + hstepB, voffB); PG8_STAGE(PG8_SA(0, 0), a2, voffA);
            PG8_WAIT_VE; PG8_WAIT_L(0); PG8_BAR; PG8_MMA(1, 0, At, B0); PG8_MMA(1, 1, At, B1); PG8_BAR; PG8_SCHED;
            PG8_LDB(B0, 1, 0); PG8_LDB(B1, 1, 1); PG8_SCHED; PG8_LDA(At, 1, 0); PG8_STAGE(PG8_SA(0, 1), a2 + hstepA, voffA);
            PG8_WAIT_V(8); PG8_WAIT_L(0); PG8_BAR; PG8_MMA(0, 0, At, B0); PG8_MMA(0, 1, At, B1); PG8_BAR; PG8_SCHED;
            PG8_LDA(At, 1, 1); PG8_STAGE(PG8_SB(1, 0), b3, voffB); PG8_STAGE(PG8_SB(1, 1), b3 + hstepB, voffB); PG8_STAGE(PG8_SA(1, 0), a3, voffA);
            PG8_WAIT_V(8); PG8_WAIT_L(0); PG8_BAR; PG8_MMA(1, 0, At, B0); PG8_MMA(1, 1, At, B1); PG8_BAR; PG8_SCHED;
            } else {
            PG8_LDB(B0, 0, 0); PG8_SCHED; PG8_LDA(At, 0, 0); PG8_STAGE(PG8_SA(1, 1), a1 + hstepA, voffA);
            PG8_WAIT_L(8); PG8_BAR; PG8_WAIT_L(0); PG8_MMA(0, 0, At, B0); PG8_BAR; PG8_SCHED;
            PG8_LDB(B1, 0, 1); PG8_STAGE(PG8_SB(0, 0), b2, voffB);
            PG8_BAR; PG8_WAIT_L(0); PG8_MMA(0, 1, At, B1); PG8_BAR;
            PG8_LDA(At, 0, 1); PG8_STAGE(PG8_SA(0, 0), a2, voffA);
            PG8_BAR; PG8_WAIT_L(0); PG8_MMA(1, 0, At, B0); PG8_BAR; PG8_SCHED;
            PG8_STAGE(PG8_SB(0, 1), b2 + hstepB, voffB);
            PG8_WAIT_V(6); PG8_BAR; PG8_MMA(1, 1, At, B1); PG8_BAR;
            PG8_LDB(B0, 1, 0); PG8_SCHED; PG8_LDA(At, 1, 0); PG8_STAGE(PG8_SA(0, 1), a2 + hstepA, voffA);
            PG8_WAIT_L(8); PG8_BAR; PG8_WAIT_L(0); PG8_MMA(0, 0, At, B0); PG8_BAR; PG8_SCHED;
            PG8_LDB(B1, 1, 1); PG8_STAGE(PG8_SB(1, 0), b3, voffB);
            PG8_BAR; PG8_WAIT_L(0); PG8_MMA(0, 1, At, B1); PG8_BAR;
            PG8_LDA(At, 1, 1); PG8_STAGE(PG8_SA(1, 0), a3, voffA);
            PG8_BAR; PG8_WAIT_L(0); PG8_MMA(1, 0, At, B0); PG8_BAR; PG8_SCHED;
            PG8_STAGE(PG8_SB(1, 1), b3 + hstepB, voffB);
            PG8_WAIT_V(6); PG8_BAR; PG8_MMA(1, 1, At, B1); PG8_BAR;
            }
        }
        if constexpr (ALIGN_EPI) { if (wr == 0) PG8_BAR; }
        if constexpr (!Epi::AFTER_DRAIN) { E(acc, cur, wr, wc, fr, fq); S.done(cur); }
        if (!has_next) break;
#pragma unroll
        for (int a = 0; a < 2; ++a)
#pragma unroll
            for (int b = 0; b < 2; ++b)
#pragma unroll
                for (int m = 0; m < 4; ++m)
#pragma unroll
                    for (int n = 0; n < 2; ++n) acc[a][b][m][n] = (f32x4){0.f, 0.f, 0.f, 0.f};
        cur = nxt; cA = nA; cB = nB; ++ui;
        if constexpr (ALIGN_EPI) { if (wr == 1) PG8_BAR; }
    }
    PG8_WAIT_V(0);
    if constexpr (!ALIGN_EPI) { if (wr == 0) PG8_BAR; }
    PG8_BAR;
    if constexpr (Epi::AFTER_DRAIN) { E.fused(acc, cur, wr, wc, fr, fq, lds, wid, lane); S.done(cur); }
#undef PG8_SA
#undef PG8_SB
#undef PG8_STAGE
#undef PG8_LDA
#undef PG8_LDB
#undef PG8_MMA
#undef PG8_WAIT_V
#undef PG8_WAIT_L
#undef PG8_BAR
#undef PG8_SCHED
}
}

#ifndef MLP_SPLIT
#define MLP_SPLIT 2
#endif
constexpr int NB = 8, SEQ = 2048, DM = 2048, MTOK = NB * SEQ, DFF = 8192, MHALF = MTOK / MLP_SPLIT;
constexpr int NU0 = 6144, NU1 = 7168;
constexpr int LD_IN0 = 6160, LD_IN1 = 7176;
constexpr int C0_GQ = 0, C0_GK = 512, C0_GV = 1024, C0_GG = 2048, C0_MQ = 3072, C0_MK = 4096, C0_MV = 5120;
constexpr int C1_FQ = 0, C1_FK = 1024, C1_FV = 2048, C1_HQ = 3072, C1_HF = 4096, C1_HI = 5120, C1_HG = 6144;
constexpr float EPS = 1e-6f;
constexpr float QSCALE = 0.08838834764831845f;
constexpr size_t MiB = 1u << 20;
constexpr size_t WS_CTL = 0, CTL_ZERO_BYTES = 65536;
constexpr size_t WS_ROWSS = 1 * MiB;
constexpr size_t WS_GLR = 3 * MiB;
constexpr size_t WS_FF = 4 * MiB;
constexpr size_t WS_KMEAN = 4 * MiB + 512 * 1024;
constexpr size_t WS_DSC = 4 * MiB + 768 * 1024;
constexpr size_t WS_CFOX = 5 * MiB;
constexpr size_t WS_WIN0 = 6 * MiB, WS_WOUT0 = 30 * MiB, WS_WUP0 = 38 * MiB, WS_WDN0 = 70 * MiB;
constexpr size_t WS_WIN1 = 102 * MiB, WS_WOUT1 = 130 * MiB, WS_WUP1 = 138 * MiB, WS_WDN1 = 170 * MiB;
constexpr size_t WS_U = 202 * MiB;
constexpr size_t WS_BCUM = WS_U + 192 * MiB;
constexpr size_t WS_HFIN = WS_WIN0, WS_HID = WS_U;
constexpr size_t OUT_H16 = 64 * MiB;
#ifndef LIN_PREFETCH
#define LIN_PREFETCH 5
#endif
#ifndef LIN_PARK
#define LIN_PARK 1
#endif
#ifndef PARK_MASK
#define PARK_MASK 7
#endif
#ifndef LIN_PADB
#define LIN_PADB 1
#endif
#ifndef LIN_GATE_EARLY
#define LIN_GATE_EARLY 2
#endif
#ifndef LIN_SU_EARLY
#define LIN_SU_EARLY 2
#endif
#ifndef LIN_QLATE
#define LIN_QLATE 1
#endif
#ifndef HID_DB
#define HID_DB 1
#endif
constexpr size_t HID_STRIDE = (HID_DB && MLP_SPLIT == 2) ? 128 * MiB : 0;
constexpr size_t WS_P = 426 * MiB;
constexpr size_t WS_S = 490 * MiB;
constexpr size_t WS_ROWSS2 = 506 * MiB;
constexpr size_t WS_END = 508 * MiB;
constexpr int CW_BAR = 4096;
constexpr int LDS_BYTES = 147456, MISC_OFF = LDS_BYTES - 256;
constexpr int NWAVES = 8;

#define GAS __attribute__((address_space(1)))
#define LAS __attribute__((address_space(3)))
typedef unsigned short bf16;
typedef unsigned u32x4 __attribute__((ext_vector_type(4)));
typedef unsigned u32x2 __attribute__((ext_vector_type(2)));
typedef float f32x4 __attribute__((ext_vector_type(4)));
typedef float f32x2 __attribute__((ext_vector_type(2)));
typedef float f32x16 __attribute__((ext_vector_type(16)));
typedef short bf16x8 __attribute__((ext_vector_type(8)));
typedef short s16x4 __attribute__((ext_vector_type(4)));
typedef __bf16 bf16x2_t __attribute__((ext_vector_type(2)));
#define LDS_WAIT() asm volatile("s_waitcnt lgkmcnt(0)" ::: "memory")
__device__ __forceinline__ float bf2f(unsigned short b) { return __uint_as_float((unsigned)b << 16); }
__device__ __forceinline__ unsigned cvtpk(float lo, float hi) { f32x2 v = {lo, hi}; bf16x2_t b = __builtin_convertvector(v, bf16x2_t); return __builtin_bit_cast(unsigned, b); }
__device__ __forceinline__ unsigned short f2bf(float f) { return (unsigned short)(cvtpk(f, 0.f) & 0xffffu); }
__device__ __forceinline__ float wave_sum(float v) {
#pragma unroll
    for (int o = 1; o < 64; o <<= 1) v += __shfl_xor(v, o);
    return v;
}
__device__ __forceinline__ float wave_max(float v) {
#pragma unroll
    for (int o = 1; o < 64; o <<= 1) v = fmaxf(v, __shfl_xor(v, o));
    return v;
}
__device__ __forceinline__ float log_sigmoid(float z) { return fminf(z, 0.f) - log1pf(expf(-fabsf(z))); }
__device__ __forceinline__ float sigmoidf(float z) { return 1.0f / (1.0f + expf(-z)); }
__device__ __forceinline__ int crow(int r, int hi) { return (r & 3) + 8 * (r >> 2) + 4 * hi; }
#ifndef UTILED
#define UTILED 1
#endif
__device__ __forceinline__ size_t UOFF(int tok, int col, int pitch) {
#if UTILED
    return ((size_t)((tok >> 7) * (pitch >> 6) + (col >> 6)) << 13) + (pg8::atile_off(tok & 127, col & 63) >> 1);
#else
    return (size_t)tok * pitch + col;
#endif
}
__device__ __forceinline__ size_t TOFF(int row, int col) { return ((size_t)((row >> 7) * 32 + (col >> 6)) << 13) + (pg8::atile_off(row & 127, col & 63) >> 1); }
struct Args { const float* in[20]; float* out; unsigned char* ws; int ph_lo, ph_hi, variant, pad; };
typedef const __attribute__((address_space(4))) Args* KArgsP;
__device__ __forceinline__ KArgsP kargs() { KArgsP p = (KArgsP)__builtin_amdgcn_kernarg_segment_ptr(); asm volatile("" : "+s"(p)); return p; }
#define XB_TMO      128
#define XB_XCNT(j)  (256  + 64 * (j))
#define XB_XSUB(j)  (1280 + 64 * (j))
#define XB_XGEN(j)  (2304 + 64 * (j))
#define XB_TOP      3328
#define XB_TOPGEN   3392
#define XCD_BAR_WORDS 3456
#define XB_SPIN_CAP (1u << 18)

__device__ __forceinline__ unsigned xb_ld(unsigned* p)              { return __hip_atomic_load(p, __ATOMIC_RELAXED, __HIP_MEMORY_SCOPE_AGENT); }
__device__ __forceinline__ unsigned xb_add(unsigned* p, unsigned v) { return __hip_atomic_fetch_add(p, v, __ATOMIC_RELAXED, __HIP_MEMORY_SCOPE_AGENT); }
__device__ __forceinline__ unsigned xb_xcc_id() { return (unsigned)__builtin_amdgcn_s_getreg((3 << 11) | 20) & 0xFu; }
#define XB_SPIN(cond, bar) do { unsigned _sp = 0; while (cond) { __builtin_amdgcn_s_sleep(1); \
    if ((++_sp & 255u) == 0u) { if (xb_ld(&(bar)[XB_TMO])) break; if (_sp > XB_SPIN_CAP) { atomicAdd(&(bar)[XB_TMO], 1u); break; } } } } while (0)

struct XcdBarrier {
    unsigned* bar; unsigned x;
    volatile LAS unsigned* st;
};

__device__ __forceinline__ XcdBarrier xcd_barrier_post(unsigned* bar, volatile LAS unsigned* st) {
    XcdBarrier b; b.bar = bar; b.x = xb_xcc_id(); b.st = st;
    if (threadIdx.x == 0) (void)xb_add(&bar[XB_XCNT(b.x)], 1u);
    return b;
}
__device__ __forceinline__ void xcd_barrier_complete(unsigned* bar, unsigned x, unsigned& nloc, unsigned& nx) {
    const unsigned G = gridDim.x * gridDim.y * gridDim.z;
    unsigned sum, cnt, mine, sp = 0u;
    for (;;) {
        sum = 0u; cnt = 0u; mine = 0u;
#pragma unroll
        for (unsigned j = 0; j < 16; ++j) { const unsigned c = xb_ld(&bar[XB_XCNT(j)]); sum += c; cnt += (c > 0u) ? 1u : 0u; mine = (j == x) ? c : mine; }
        if (sum == G) break;
        __builtin_amdgcn_s_sleep(1);
        if ((++sp & 255u) == 0u) { if (xb_ld(&bar[XB_TMO])) break; if (sp > XB_SPIN_CAP) { atomicAdd(&bar[XB_TMO], 1u); break; } }
    }
    nloc = mine > 0u ? mine : 1u; nx = cnt > 0u ? cnt : 1u;
}

__device__ __forceinline__ void xcd_barrier(const XcdBarrier& b) {
    asm volatile("s_waitcnt vmcnt(0)" ::: "memory");
    __syncthreads();
    if (threadIdx.x == 0) {
        unsigned* bar = b.bar;
        __builtin_amdgcn_s_waitcnt(0);
        unsigned nloc = b.st[0], nx = b.st[1];
        if (nloc == 0u) { xcd_barrier_complete(bar, b.x, nloc, nx); b.st[0] = nloc; b.st[1] = nx; }
        const unsigned old = xb_add(&bar[XB_XSUB(b.x)], 1u);
        const unsigned gen = old / nloc;
        if (old + 1u == (gen + 1u) * nloc) {
            __builtin_amdgcn_fence(__ATOMIC_RELEASE, "agent");
            asm volatile("s_waitcnt vmcnt(0)" ::: "memory");
            const unsigned og = xb_add(&bar[XB_TOP], 1u);
            const unsigned tg = og / nx;
            if (og + 1u == (tg + 1u) * nx) xb_add(&bar[XB_TOPGEN], 1u);
            else XB_SPIN(xb_ld(&bar[XB_TOPGEN]) == tg, bar);
            __builtin_amdgcn_fence(__ATOMIC_ACQUIRE, "agent");
            xb_add(&bar[XB_XGEN(b.x)], 1u);
            asm volatile("s_waitcnt vmcnt(0)" ::: "memory");
        } else {
            XB_SPIN(xb_ld(&bar[XB_XGEN(b.x)]) == gen, bar);
            __builtin_amdgcn_fence(__ATOMIC_ACQUIRE, "agent");
            asm volatile("s_waitcnt vmcnt(0)" ::: "memory");
        }
    }
    __syncthreads();
}

#ifndef PROLOGUE_NT
#define PROLOGUE_NT 0
#endif
#if PROLOGUE_NT
#define NT_LOAD4(p) __builtin_nontemporal_load(p)
#else
#define NT_LOAD4(p) (*(p))
#endif

#ifndef WTILED
#define WTILED 1
#endif
#if WTILED
#define WTILED_BASE(n0_, k0_, K_) ((((size_t)((n0_) >> 7) * ((K_) >> 6) + ((k0_) >> 6)) << 13) + (pg8::atile_off((n0_) & 127, 0) >> 1))
#define WTILED_OFF(n_, c_, K_) ((pg8::atile_off(((n_) & 31), (c_)) >> 1))
#else
#define WTILED_BASE(n0_, k0_, K_) ((size_t)(n0_) * (K_) + (k0_))
#define WTILED_OFF(n_, c_, K_) ((size_t)(n_) * (K_) + (c_))
#endif
struct TrItem { const float* src; const float* gain; bf16* dst; int ld, K; };
__device__ __forceinline__ TrItem tr_decode(KArgsP K, int r) {
    unsigned char* ws = K->ws; TrItem t;
#define TJ(idx, gidx, ld_, co_, nc_, K_, off_, ro_) { const int items_ = ((K_) / 64) * ((nc_) / 32); if (r < items_) { const int nblk = (nc_) / 32, kb = r / nblk, nb = r % nblk, k0 = 64 * kb, n0 = 32 * nb; \
        t.src = K->in[idx] + (size_t)k0 * (ld_) + (co_) + n0; t.gain = (gidx) >= 0 ? K->in[(gidx) >= 0 ? (gidx) : 0] + k0 : nullptr; t.dst = (bf16*)(ws + (off_)) + WTILED_BASE((ro_) + n0, k0, K_); t.ld = (ld_); t.K = (K_); return t; } r -= items_; }
    TJ(2, 1, LD_IN0, 0, 3072, 2048, WS_WIN0, 0)
    TJ(2, 1, LD_IN0, 3088, 3072, 2048, WS_WIN0, 3072)
    TJ(6, -1, 2048, 0, 2048, 2048, WS_WOUT0, 0)
    TJ(8, 7, 8192, 0, 8192, 2048, WS_WUP0, 0)
    TJ(9, -1, 2048, 0, 2048, 8192, WS_WDN0, 0)
    TJ(11, 10, LD_IN1, 0, 3072, 2048, WS_WIN1, 0)
    TJ(11, 10, LD_IN1, 3080, 4096, 2048, WS_WIN1, 3072)
    TJ(14, -1, 2048, 0, 2048, 2048, WS_WOUT1, 0)
    TJ(16, 15, 8192, 0, 8192, 2048, WS_WUP1, 0)
    TJ(17, -1, 2048, 0, 2048, 8192, WS_WDN1, 0)
#undef TJ
    t.src = nullptr; t.gain = nullptr; t.dst = nullptr; t.ld = 0; t.K = 0; return t;
}
#define TR_LOAD(t, tv) do { _Pragma("unroll") for (int i = 0; i < 8; ++i) tv[i] = NT_LOAD4((const f32x4*)((t).src + (size_t)(8 * i + (lane >> 3)) * (t).ld + 4 * (lane & 7))); } while (0)
__device__ __forceinline__ void tr_process(const TrItem& t, const f32x4 (&tv)[8], LAS float* scr, int lane) {
#pragma unroll
    for (int i = 0; i < 8; ++i) { LAS float* d_ = scr + (8 * i + (lane >> 3)) * 33 + 4 * (lane & 7); d_[0] = tv[i][0]; d_[1] = tv[i][1]; d_[2] = tv[i][2]; d_[3] = tv[i][3]; }
    const int c = lane & 7;
    f32x4 g0 = {1.f, 1.f, 1.f, 1.f}, g1 = g0;
    if (t.gain) { g0 = *(const f32x4*)(t.gain + 8 * c); g1 = *(const f32x4*)(t.gain + 8 * c + 4); }
    LDS_WAIT(); asm volatile("" ::: "memory");
#pragma unroll
    for (int j = 0; j < 4; ++j) { const int n = (lane >> 3) + 8 * j; const LAS float* s = scr + (8 * c) * 33 + n;
        u32x4 o; o.x = cvtpk(s[0 * 33] * g0[0], s[1 * 33] * g0[1]); o.y = cvtpk(s[2 * 33] * g0[2], s[3 * 33] * g0[3]); o.z = cvtpk(s[4 * 33] * g1[0], s[5 * 33] * g1[1]); o.w = cvtpk(s[6 * 33] * g1[2], s[7 * 33] * g1[3]);
        *(GAS u32x4*)(t.dst + WTILED_OFF(n, 8 * c, t.K)) = o; }
    LDS_WAIT(); asm volatile("" ::: "memory");
}
#ifndef TR_STATIC
#define TR_STATIC 17
#endif
__device__ __forceinline__ void phase_transposes(LAS unsigned char* lds, KArgsP K, int G, int wave, int lane) {
    LAS float* scr = (LAS float*)(lds + wave * 16384);
    const int gw = blockIdx.x * NWAVES + wave, NGW = G * NWAVES;
    constexpr int TOTAL = 2 * (32 * 96) + 32 * 64 + 32 * 256 + 128 * 64 + 32 * 96 + 32 * 128 + 32 * 64 + 32 * 256 + 128 * 64;
    const int NSTAT = (TR_STATIC > 0 && TR_STATIC * NGW < TOTAL) ? TR_STATIC * NGW : TOTAL;
    f32x4 ta[8], tb[8];
    int it = gw;
    if (it < NSTAT) {
        TrItem j0 = tr_decode(K, it), j1; TR_LOAD(j0, ta);
        for (;;) {
            const int it1 = it + NGW; const bool h1 = it1 < NSTAT;
            if (h1) { j1 = tr_decode(K, it1); TR_LOAD(j1, tb); }
            asm volatile("" ::: "memory");
            tr_process(j0, ta, scr, lane);
            if (!h1) break;
            const int it2 = it1 + NGW; const bool h2 = it2 < NSTAT;
            if (h2) { j0 = tr_decode(K, it2); TR_LOAD(j0, ta); }
            asm volatile("" ::: "memory");
            tr_process(j1, tb, scr, lane);
            if (!h2) break;
            it = it2;
        }
    }
    if (NSTAT < TOTAL) {
        unsigned* ctr = (unsigned*)(K->ws + WS_CTL) + 12288;
        volatile LAS unsigned* qslot = (volatile LAS unsigned*)(lds + MISC_OFF) + 24;
        const int nch = (TOTAL - NSTAT + 15) / 16;
        const bool lead = wave == 0 && lane == 0;
        if (lead) qslot[0] = __hip_atomic_fetch_add(ctr, 1u, __ATOMIC_RELAXED, __HIP_MEMORY_SCOPE_AGENT);
        __syncthreads();
        int q = (int)qslot[0];
        while (q < nch) {
            unsigned qn = 0u; if (lead) qn = __hip_atomic_fetch_add(ctr, 1u, __ATOMIC_RELAXED, __HIP_MEMORY_SCOPE_AGENT);
            const int ia = NSTAT + 16 * q + 2 * wave, ib = ia + 1;
            const bool ha = ia < TOTAL, hb = ib < TOTAL;
            TrItem ja, jb;
            if (ha) { ja = tr_decode(K, ia); TR_LOAD(ja, ta); }
            if (hb) { jb = tr_decode(K, ib); TR_LOAD(jb, tb); }
            asm volatile("" ::: "memory");
            if (ha) tr_process(ja, ta, scr, lane);
            if (hb) tr_process(jb, tb, scr, lane);
            __syncthreads();
            if (lead) qslot[0] = qn;
            __syncthreads();
            q = (int)qslot[0];
        }
    }
}
__device__ __forceinline__ void phase_norm0(LAS unsigned char* lds, KArgsP K, int G, int tid, int wave, int lane) {
    unsigned char* ws = K->ws; const float* x = K->in[0]; const float* g0 = K->in[1]; const float* win = K->in[2]; const float* w2 = K->in[3]; const float* gb = K->in[4];
    bf16* xn = (bf16*)((unsigned char*)K->out + OUT_H16); float* rowss = (float*)(ws + WS_ROWSS); float* glr = (float*)(ws + WS_GLR); float* bcum = (float*)(ws + WS_BCUM);
    LAS float* WT = (LAS float*)lds;
    LAS float* glr_s = (LAS float*)(lds + 131072);
    if ((int)blockIdx.x >= MTOK / 64) return;
    for (int idx = tid; idx < 2048 * 4; idx += 512) { const int k = idx >> 2, j4 = idx & 3; const f32x4 v = *(const f32x4*)(win + (size_t)k * LD_IN0 + 3072 + 4 * j4) * g0[k];
        WT[(4 * j4 + 0) * 2048 + k] = v[0]; WT[(4 * j4 + 1) * 2048 + k] = v[1]; WT[(4 * j4 + 2) * 2048 + k] = v[2]; WT[(4 * j4 + 3) * 2048 + k] = v[3]; }
    float w2c[16];
#pragma unroll
    for (int r = 0; r < 16; ++r) w2c[r] = w2[r * 512 + tid];
    const float bc = gb[tid];
    __syncthreads();
    for (int item = blockIdx.x; item < MTOK / 64; item += G) {
        const int r0 = item * 64;
        for (int i = 0; i < 8; i += 2) {
            const int row = r0 + 8 * wave + i;
            f32x4 va[8], vb[8]; float ssa = 0.f, ssb = 0.f;
#pragma unroll
            for (int jj = 0; jj < 8; ++jj) { va[jj] = NT_LOAD4((const f32x4*)(x + (size_t)row * DM) + 64 * jj + lane); vb[jj] = NT_LOAD4((const f32x4*)(x + (size_t)(row + 1) * DM) + 64 * jj + lane); }
            asm volatile("" ::: "memory");
#pragma unroll
            for (int jj = 0; jj < 8; ++jj) { ssa += (va[jj][0] * va[jj][0] + va[jj][1] * va[jj][1]) + (va[jj][2] * va[jj][2] + va[jj][3] * va[jj][3]); ssb += (vb[jj][0] * vb[jj][0] + vb[jj][1] * vb[jj][1]) + (vb[jj][2] * vb[jj][2] + vb[jj][3] * vb[jj][3]); }
#pragma unroll
            for (int jj = 0; jj < 8; ++jj) { u32x2 pa, pb; pa.x = cvtpk(va[jj][0], va[jj][1]); pa.y = cvtpk(va[jj][2], va[jj][3]); pb.x = cvtpk(vb[jj][0], vb[jj][1]); pb.y = cvtpk(vb[jj][2], vb[jj][3]);
                *(u32x2*)(xn + TOFF(row, 256 * jj + 4 * lane)) = pa; *(u32x2*)(xn + TOFF(row + 1, 256 * jj + 4 * lane)) = pb; }
            float acca[16], accb[16];
#pragma unroll 2
            for (int j = 0; j < 16; ++j) { float a = 0.f, b = 0.f;
#pragma unroll
                for (int jj = 0; jj < 8; ++jj) { const f32x4 w = *(const LAS f32x4*)(WT + j * 2048 + 256 * jj + 4 * lane);
                    a += (va[jj][0] * w[0] + va[jj][1] * w[1]) + (va[jj][2] * w[2] + va[jj][3] * w[3]); b += (vb[jj][0] * w[0] + vb[jj][1] * w[1]) + (vb[jj][2] * w[2] + vb[jj][3] * w[3]); }
                acca[j] = a; accb[j] = b; }
#pragma unroll
            for (int st = 0; st < 4; ++st) { const int half = 8 >> st; const unsigned um = 0u - (((unsigned)lane >> st) & 1u);
#pragma unroll
                for (int q = 0; q < 8; ++q) if (q < half) {
                    const unsigned alo = __float_as_uint(acca[q]), ahi = __float_as_uint(acca[q + half]), blo = __float_as_uint(accb[q]), bhi = __float_as_uint(accb[q + half]);
                    const float sa = __uint_as_float((alo & um) | (ahi & ~um)), sb = __uint_as_float((blo & um) | (bhi & ~um));
                    const float ka = __uint_as_float((ahi & um) | (alo & ~um)), kb = __uint_as_float((bhi & um) | (blo & ~um));
                    acca[q] = ka + __shfl_xor(sa, 1 << st); accb[q] = kb + __shfl_xor(sb, 1 << st); } }
            float ta = acca[0], tb = accb[0];
            ta += __shfl_xor(ta, 16); ta += __shfl_xor(ta, 32); tb += __shfl_xor(tb, 16); tb += __shfl_xor(tb, 32);
            ssa = wave_sum(ssa); ssb = wave_sum(ssb);
            const float rsa = 1.0f / sqrtf(ssa * (1.0f / DM) + EPS), rsb = 1.0f / sqrtf(ssb * (1.0f / DM) + EPS);
            const int col = ((lane & 1) << 3) | ((lane & 2) << 1) | ((lane & 4) >> 1) | ((lane & 8) >> 3);
            if (lane < 16) { glr_s[(8 * wave + i) * 16 + col] = ta * rsa; glr[(size_t)row * 16 + col] = ta * rsa; glr_s[(8 * wave + i + 1) * 16 + col] = tb * rsb; glr[(size_t)(row + 1) * 16 + col] = tb * rsb; }
            if (lane < 32) { rowss[(size_t)row * 32 + lane] = (lane == 0) ? ssa : 0.f; rowss[(size_t)(row + 1) * 32 + lane] = (lane == 0) ? ssb : 0.f; }
        }
        __syncthreads();
        float run = 0.f;
        for (int t = 0; t < 64; ++t) { float z = bc;
#pragma unroll
            for (int q = 0; q < 4; ++q) { const f32x4 gq = *(const LAS f32x4*)(glr_s + t * 16 + 4 * q); z += (gq[0] * w2c[4 * q] + gq[1] * w2c[4 * q + 1]) + (gq[2] * w2c[4 * q + 2] + gq[3] * w2c[4 * q + 3]); }
            run += (fminf(z, 0.f) - __logf(1.0f + __expf(-fabsf(z)))) * (1.0f / 16.0f); bcum[(size_t)(r0 + t) * 512 + tid] = run; }
        __syncthreads();
    }
}
__device__ __forceinline__ void phase_final_norm(const bf16* h16, float* out, const float* g, const float* rowss, int G, int wave, int lane, float pscale = 1.f) {
    f32x4 gv[8];
#pragma unroll
    for (int jj = 0; jj < 8; ++jj) gv[jj] = ((const f32x4*)g)[64 * jj + lane];
    for (int row = blockIdx.x * NWAVES + wave; row < MTOK; row += G * NWAVES) {
        float s = lane < 32 ? rowss[(size_t)row * 32 + lane] : 0.f;
        u32x2 hv[8];
#pragma unroll
        for (int jj = 0; jj < 8; ++jj) hv[jj] = *(const u32x2*)(h16 + TOFF(row, 256 * jj + 4 * lane));
        asm volatile("" ::: "memory");
        s = wave_sum(s);
        const float rs = pscale / sqrtf(s * (1.0f / DM) + EPS);
        f32x4* orow = (f32x4*)(out + (size_t)row * DM);
#pragma unroll
        for (int jj = 0; jj < 8; ++jj) { const f32x4 v = {__uint_as_float(hv[jj].x << 16), __uint_as_float(hv[jj].x & 0xffff0000u), __uint_as_float(hv[jj].y << 16), __uint_as_float(hv[jj].y & 0xffff0000u)};
            orow[64 * jj + lane] = v * rs * gv[jj]; }
    }
}
__device__ __forceinline__ void phase_kmean(LAS unsigned char* lds, const bf16* u, float* kmean, int G, int tid) {
    LAS float* red = (LAS float*)lds;
    const int c8 = tid & 15, tg = tid >> 4;
    for (int item = blockIdx.x; item < 512; item += G) {
        const int n = item & 7, bh = item >> 3, b = bh >> 3, h = bh & 7;
        float a[8] = {0, 0, 0, 0, 0, 0, 0, 0}; bf16x8 kv[8];
#pragma unroll
        for (int i = 0; i < 8; ++i) { const int tok = b * SEQ + n * 256 + tg * 8 + i; kv[i] = *(const bf16x8*)(u + UOFF(tok, C0_MK + h * 128 + 8 * c8, NU0)); }
        asm volatile("" ::: "memory");
#pragma unroll
        for (int i = 0; i < 8; ++i)
#pragma unroll
            for (int e = 0; e < 8; ++e) a[e] += bf2f((unsigned short)kv[i][e]);
#pragma unroll
        for (int e = 0; e < 8; ++e) red[tg * 128 + 8 * c8 + e] = a[e];
        __syncthreads();
        if (tid < 128) { float s = 0.f; for (int g = 0; g < 32; ++g) s += red[g * 128 + tid]; kmean[(size_t)item * 128 + tid] = s * (1.0f / 256.0f); }
        __syncthreads();
    }
}
__device__ __forceinline__ void phase_ff(LAS unsigned char* lds, const float* win1, const float* gain, const bf16* xn, const float* rowss, float* ff, int G, int tid, int wave, int lane) {
    LAS float* WT = (LAS float*)lds;
    if ((int)blockIdx.x >= MTOK / 64) return;
    for (int idx = tid; idx < 2048 * 2; idx += 512) { const int k = idx >> 1, j4 = idx & 1; const f32x4 v = *(const f32x4*)(win1 + (size_t)k * LD_IN1 + 3072 + 4 * j4) * gain[k];
        WT[(4 * j4 + 0) * 2048 + k] = v[0]; WT[(4 * j4 + 1) * 2048 + k] = v[1]; WT[(4 * j4 + 2) * 2048 + k] = v[2]; WT[(4 * j4 + 3) * 2048 + k] = v[3]; }
    __syncthreads();
    for (int item = blockIdx.x; item < MTOK / 64; item += G) {
        for (int i = 0; i < 8; ++i) {
            const int row = item * 64 + 8 * wave + i;
            float xf[4][8]; bf16x8 xv[4];
#pragma unroll
            for (int jj = 0; jj < 4; ++jj) xv[jj] = *(const bf16x8*)(xn + TOFF(row, 512 * jj + 8 * lane));
            float s = lane < 32 ? rowss[(size_t)row * 32 + lane] : 0.f;
            asm volatile("" ::: "memory");
#pragma unroll
            for (int jj = 0; jj < 4; ++jj)
#pragma unroll
                for (int e = 0; e < 8; ++e) xf[jj][e] = bf2f((unsigned short)xv[jj][e]);
            s = wave_sum(s);
            const float rs = 1.0f / sqrtf(s * (1.0f / DM) + EPS);
            float mine = 0.f;
#pragma unroll 1
            for (int j = 0; j < 8; ++j) { float a = 0.f;
#pragma unroll
                for (int jj = 0; jj < 4; ++jj) { const f32x4 w0 = *(const LAS f32x4*)(WT + j * 2048 + 512 * jj + 8 * lane), w1 = *(const LAS f32x4*)(WT + j * 2048 + 512 * jj + 8 * lane + 4);
                    a += (xf[jj][0] * w0[0] + xf[jj][1] * w0[1]) + (xf[jj][2] * w0[2] + xf[jj][3] * w0[3]) + (xf[jj][4] * w1[0] + xf[jj][5] * w1[1]) + (xf[jj][6] * w1[2] + xf[jj][7] * w1[3]); }
                const float t = wave_sum(a) * rs; if (lane == j) mine = t; }
            if (lane < 8) ff[(size_t)row * 8 + lane] = mine;
        }
    }
    __syncthreads();
}
template <int DV>
__device__ __forceinline__ void phase_scan(const float* sloc, const float* dsc, bf16* sstart, int G, int tid) {
    constexpr int GPB = 128 * DV / 4, TOTAL = (DV == 256 ? 32 : 64) * GPB;
    for (int item = blockIdx.x * 512 + tid; item < TOTAL; item += G * 512) {
        const int p4 = item % GPB, bh = item / GPB;
        const int g = p4 & 3, ln = (p4 >> 2) & 63, dt = (p4 >> 8) & 3;
        const int d0 = 32 * dt + 8 * g + 4 * (ln >> 5);
        f32x4 s = {0.f, 0.f, 0.f, 0.f}; f32x4 ddv[7]; f32x4 lv[7];
#pragma unroll
        for (int sc = 0; sc < 7; ++sc) { const int ui = bh * 8 + sc; ddv[sc] = *(const f32x4*)(dsc + ui * 128 + d0); lv[sc] = *(const f32x4*)(sloc + (size_t)ui * 128 * DV + 4 * (size_t)p4); }
        asm volatile("" ::: "memory");
#pragma unroll
        for (int sc = 0; sc < 7; ++sc) { const int ui = bh * 8 + sc;
            s = s * ddv[sc] + lv[sc]; u32x2 p; p.x = cvtpk(s[0], s[1]); p.y = cvtpk(s[2], s[3]); *(u32x2*)(sstart + (size_t)(ui + 1) * 128 * DV + 4 * (size_t)p4) = p; }
    }
}

__device__ __forceinline__ unsigned offb(unsigned row, unsigned ch) { return 256u * row + 16u * (ch ^ (((row & 3u) << 2) | ((row >> 2) & 3u))); }
__device__ __forceinline__ unsigned tr_addr(unsigned lane, unsigned c, unsigned ks, unsigned t) {
    const unsigned h = lane >> 5, blk = (lane >> 4) & 1, q = (lane & 15) >> 2, p = lane & 3;
    return offb(16 * ks + 8 * h + 4 * t + q, 4 * c + 2 * blk + (p >> 1)) + 8 * (p & 1);
}
typedef short v4i16_t __attribute__((ext_vector_type(4)));
__device__ __forceinline__ s16x4 ds_tr(LAS const unsigned char* p) { return __builtin_bit_cast(s16x4, __builtin_amdgcn_ds_read_tr16_b64_v4i16((LAS v4i16_t*)p)); }
__device__ __forceinline__ bf16x8 ld_tr_frag(LAS const unsigned char* tile, unsigned lane, unsigned c, unsigned ks) {
    const s16x4 lo = ds_tr(tile + tr_addr(lane, c, ks, 0)), hi = ds_tr(tile + tr_addr(lane, c, ks, 1));
    return __builtin_shufflevector(lo, hi, 0, 1, 2, 3, 4, 5, 6, 7);
}
__device__ __forceinline__ bf16x8 ld_row_frag(LAS const unsigned char* tile, unsigned row, unsigned ch) { return *(const LAS bf16x8*)(tile + offb(row, ch)); }
template <int S> __device__ __forceinline__ bf16x8 pack_step(const f32x16& x) {
    u32x4 w = {cvtpk(x[8 * S], x[8 * S + 1]), cvtpk(x[8 * S + 2], x[8 * S + 3]), cvtpk(x[8 * S + 4], x[8 * S + 5]), cvtpk(x[8 * S + 6], x[8 * S + 7])};
    return __builtin_bit_cast(bf16x8, w);
}
#define LD_FENCE() asm volatile("" ::: "memory")
#define MFMA32(a, b, c) __builtin_amdgcn_mfma_f32_32x32x16_bf16((a), (b), (c), 0, 0, 0)

struct LinArgs {
    const bf16* u; int pitch; int qoff, koff, voff, goff;
    const float* bcum;
    const float* lbraw;
    const float* gain;
    float* sloc; float* dsc; const bf16* sstart; bf16* mix; int mixoff;
};
#ifdef PROBE_LIN
#define LIN_T(k) do { if (PROBE_LIN_SEL) { if (threadIdx.x == 0) { const unsigned long long t_ = __builtin_amdgcn_s_memrealtime(); if ((k) == 0) tfirst_ = t_; if ((k) == PROBE_LIN + 1) ((volatile LAS unsigned*)(lds + MISC_OFF))[20] += (unsigned)(t_ - tprev_); if (PROBE_LIN == 9 && (k) == 4) ((volatile LAS unsigned*)(lds + MISC_OFF))[20] += (unsigned)(t_ - tfirst_); tprev_ = t_; } } } while (0)
#else
#define LIN_T(k) do {} while (0)
#endif
template <int DV, int NWH, bool HGRN, bool PB>
__device__ __forceinline__ void lin_unit(LAS unsigned char* lds, const int tid, const LinArgs& A, const int b, const int hbase, const int sc) {
    constexpr int NTH = 64 * NWH, NTQ = NTH / 128, TPT = 64 / NTQ, NHEADS = HGRN ? 8 : 4;
    constexpr int VS_OFF = 32768, AS_OFF = VS_OFF + DV * 128, DS_OFF = AS_OFF + 9216, RED_OFF = DS_OFF + 512, BT_OFF = RED_OFF + 2048, GT_OFF = BT_OFF + 4096, HEAD_LDS = GT_OFF + 4 * DV;
    static_assert(HEAD_LDS * (8 / NWH) <= MISC_OFF, "LDS");
    const int wv = __builtin_amdgcn_readfirstlane(tid >> 6), wl = wv % NWH, hs = wv / NWH, head = hbase + hs;
    LAS unsigned char* hl = lds + hs * HEAD_LDS;
    LAS unsigned char* Qs = hl; LAS unsigned char* Ks = hl + 16384; LAS unsigned char* Vs = hl + VS_OFF; LAS unsigned char* As = hl + AS_OFF;
    LAS float* Ds = (LAS float*)(hl + DS_OFF); LAS float* red = (LAS float*)(hl + RED_OFF); LAS float* btot = (LAS float*)(hl + BT_OFF); LAS float* gtab = (LAS float*)(hl + GT_OFF);
    const int ui = (b * NHEADS + head) * 8 + sc;
    f32x16 Sacc[4];
#pragma unroll
    for (int dt = 0; dt < 4; ++dt)
#pragma unroll
        for (int i = 0; i < 16; ++i) Sacc[dt][i] = 0.f;
    constexpr int NP = HGRN ? 1 : 1024 / NTH;
    u32x4 rk[NP], rq[NP], vv[4]; f32x4 b0[NP], b1[NP]; u32x2 hraw[8], qraw[8];
#define LIN_LOADS_K(tokb_) do { int tl_ = tid; asm volatile("" : "+v"(tl_)); const int th_ = tl_ - hs * NTH, tokb = (tokb_); \
        if (!HGRN) { _Pragma("unroll") for (int j = 0; j < NP; ++j) { const int item = th_ + j * NTH, t = item >> 4, c8 = item & 15; \
                rk[j] = *(const u32x4*)(A.u + UOFF(tokb + t, A.koff + head * 128 + 8 * c8, A.pitch)); \
                const f32x4* bp = (const f32x4*)(A.bcum + (size_t)(tokb + t) * 512 + head * 128 + 8 * c8); b0[j] = bp[0]; b1[j] = bp[1]; } } \
        else { const int dbase_ = 4 * (th_ & 31), tq8_ = th_ >> 5; _Pragma("unroll") for (int i = 0; i < 8; ++i) { const int tk = tokb + tq8_ * 8 + i; \
                hraw[i] = *(const u32x2*)(A.u + UOFF(tk, A.koff + head * 128 + dbase_, A.pitch)); } } \
        LD_FENCE(); } while (0)
#define LIN_LOADS_V(tokb_) do { int tl_ = tid; asm volatile("" : "+v"(tl_)); const int th_ = tl_ - hs * NTH, tokb = (tokb_); \
        _Pragma("unroll") for (int j = 0; j < 4; ++j) { const int item = th_ + j * NTH, t = item / (DV / 8), c8 = item % (DV / 8); vv[j] = *(const u32x4*)(A.u + UOFF(tokb + t, A.voff + head * DV + 8 * c8, A.pitch)); } \
        LD_FENCE(); } while (0)
#define LIN_LOADS_Q(tokb_) do { if (PB) { int tl_ = tid; asm volatile("" : "+v"(tl_)); const int th_ = tl_ - hs * NTH, tokb = (tokb_); \
        if (!HGRN) { _Pragma("unroll") for (int j = 0; j < NP; ++j) { const int item = th_ + j * NTH, t = item >> 4, c8 = item & 15; rq[j] = *(const u32x4*)(A.u + UOFF(tokb + t, A.qoff + head * 128 + 8 * c8, A.pitch)); } } \
        else { const int dbase_ = 4 * (th_ & 31), tq8_ = th_ >> 5; _Pragma("unroll") for (int i = 0; i < 8; ++i) { const int tk = tokb + tq8_ * 8 + i; qraw[i] = *(const u32x2*)(A.u + UOFF(tk, A.qoff + head * 128 + dbase_, A.pitch)); } } \
        LD_FENCE(); } } while (0)
#define LIN_LOADS(tokb_) do { LIN_LOADS_K(tokb_); LIN_LOADS_V(tokb_); LIN_LOADS_Q(tokb_); } while (0)
    constexpr bool PRE = ((LIN_PREFETCH >> ((PB ? 2 : 0) + (HGRN ? 1 : 0))) & 1) != 0;
    if (PRE && !(HGRN && PB)) LIN_LOADS(b * SEQ + sc * 256);
    constexpr bool PARK = LIN_PARK != 0 && HGRN && PB && !PRE && NWH == 4 && DV == 128;
#define LIN_DMA4(tokb_, Kd_, Qd_, Vd_, m_) do { int tp_ = tid; asm volatile("" : "+v"(tp_)); const int l_ = tp_ & 63, tokd = (tokb_); \
        _Pragma("unroll") for (int j = 0; j < 4; ++j) { const int row = 16 * wl + 4 * j + (l_ >> 4), ch = (l_ & 15) ^ ((((l_ >> 4) & 3) << 2) | j); const unsigned pofs = (unsigned)(wl * 4 + j) * 1024u; \
            if ((m_) & 1) __builtin_amdgcn_global_load_lds((const unsigned*)(A.u + UOFF(tokd + row, A.koff + head * 128 + 8 * ch, A.pitch)), (LAS unsigned*)((Kd_) + pofs), 16, 0, 0); \
            if ((m_) & 2) __builtin_amdgcn_global_load_lds((const unsigned*)(A.u + UOFF(tokd + row, A.qoff + head * 128 + 8 * ch, A.pitch)), (LAS unsigned*)((Qd_) + pofs), 16, 0, 0); \
            if ((m_) & 4) __builtin_amdgcn_global_load_lds((const unsigned*)(A.u + UOFF(tokd + row, A.voff + head * DV + 8 * ch, A.pitch)), (LAS unsigned*)((Vd_) + pofs), 16, 0, 0); } } while (0)
#define LIN_DMA(tokb_) LIN_DMA4(tokb_, Ks, Qs, Vs, PARK_MASK)
    constexpr bool PADB = LIN_PADB != 0 && HGRN && !PB && !PRE && NWH == 4 && DV == 128;
    static_assert(!PADB || (2 * HEAD_LDS + 1024 + 8192 <= MISC_OFF && AS_OFF + 16384 <= HEAD_LDS), "LDS (PADB)");
    if (PADB) { Ds = (LAS float*)(lds + 2 * HEAD_LDS + hs * 512); btot = (LAS float*)(lds + 2 * HEAD_LDS + 1024 + hs * 4096); LIN_DMA4(b * SEQ + sc * 256, Ks, Qs, Vs, 5); }
    if (PB) { const int th_g = tid - hs * NTH; if (th_g < DV) gtab[th_g] = A.gain[th_g]; }
    if (PARK) LIN_DMA(b * SEQ + sc * 256);
    if (PB && sc > 0) {
        const bf16* sp = A.sstart + ((((size_t)ui * (DV / 32) + wl) * 4) * 64 + (tid & 63)) * 16;
        u32x4 rw[4][2];
#pragma unroll
        for (int dt = 0; dt < 4; ++dt) { rw[dt][0] = *(const u32x4*)(sp + dt * 1024); rw[dt][1] = *(const u32x4*)(sp + dt * 1024 + 8); }
        LD_FENCE();
#pragma unroll
        for (int dt = 0; dt < 4; ++dt)
#pragma unroll
            for (int h2 = 0; h2 < 2; ++h2)
#pragma unroll
                for (int q = 0; q < 4; ++q) { const unsigned w = rw[dt][h2][q]; Sacc[dt][8 * h2 + 2 * q] = __uint_as_float(w << 16); Sacc[dt][8 * h2 + 2 * q + 1] = __uint_as_float(w & 0xffff0000u); }
    }
    if (PRE && HGRN && PB) LIN_LOADS(b * SEQ + sc * 256);
    float dsum = 0.f, lb = 0.f, oml = 1.f; float dsum8[8] = {0.f, 0.f, 0.f, 0.f, 0.f, 0.f, 0.f, 0.f};
    float lb4[4] = {0.f, 0.f, 0.f, 0.f}, oml4[4] = {1.f, 1.f, 1.f, 1.f};
    if (HGRN) {
#pragma unroll
        for (int e = 0; e < 4; ++e) { int tlb_ = tid; asm volatile("" : "+v"(tlb_)); const int d0_ = 4 * ((tlb_ - hs * NTH) & 31) + e; lb4[e] = sigmoidf(A.lbraw[1024 + head * 128 + d0_] - A.lbraw[head * 128 + d0_]); oml4[e] = 1.f - lb4[e]; } }
    if (PARK || PADB) { asm volatile("s_waitcnt vmcnt(0)" ::: "memory"); __syncthreads(); }
    for (int c = 0; c < 4; ++c) {
        const int tok0 = b * SEQ + sc * 256 + c * 64;
        int tid_c = tid; asm volatile("" : "+v"(tid_c));
#ifdef PROBE_LIN
        unsigned long long tprev_ = 0, tfirst_ = 0;
#endif
        LIN_T(0);
        const int th = tid_c - hs * NTH, lane = tid_c & 63, r = lane & 31, hb = lane >> 5;
        const int d = th & 127, tq = th >> 7;
        const unsigned wofs = 2u * (d & 7);
        if (PADB) { Ks = (c & 1) ? hl : hl + 16384; Vs = (c & 1) ? hl + AS_OFF : hl + VS_OFF;
            if (c < 3) LIN_DMA4(tok0 + 64, ((c & 1) ? hl + 16384 : hl), Qs, ((c & 1) ? hl + VS_OFF : hl + AS_OFF), 5); }
        if (!PRE && !PARK && !PADB) LIN_LOADS(tok0);
        if (PARK || PADB) { const int dbase_ = 4 * (th & 31), tq8_ = th >> 5;
#pragma unroll
            for (int i = 0; i < 8; ++i) { const int t = tq8_ * 8 + i; if (PARK_MASK & 1) hraw[i] = *(const LAS u32x2*)(Ks + offb(t, dbase_ >> 3) + 2 * (dbase_ & 7)); if (PB && (PARK_MASK & 2)) qraw[i] = *(const LAS u32x2*)(Qs + offb(t, dbase_ >> 3) + 2 * (dbase_ & 7)); }
            if ((PARK_MASK & 7) != 7) { if (!(PARK_MASK & 1)) LIN_LOADS_K(tok0); if (!(PARK_MASK & 4)) LIN_LOADS_V(tok0); if (!(PARK_MASK & 2)) LIN_LOADS_Q(tok0); } }
        if (!(PARK || PADB) || !(PARK_MASK & 4)) {
#pragma unroll
          for (int j = 0; j < 4; ++j) { const int item = th + j * NTH, t = item / (DV / 8), c8 = item % (DV / 8); *(LAS u32x4*)(Vs + (c8 >> 4) * 16384 + offb(t, c8 & 15)) = vv[j]; } }
        float blast;
        if (!HGRN) {
#pragma unroll
            for (int j = 0; j < NP; ++j) { const int item = th + j * NTH, t = item >> 4, c8 = item & 15;
                float bb[8] = {b0[j][0], b0[j][1], b0[j][2], b0[j][3], b1[j][0], b1[j][1], b1[j][2], b1[j][3]};
                float kf[8], qf[8];
#pragma unroll
                for (int e = 0; e < 4; ++e) { kf[2 * e] = __uint_as_float(rk[j][e] << 16); kf[2 * e + 1] = __uint_as_float(rk[j][e] & 0xffff0000u); if (PB) { qf[2 * e] = __uint_as_float(rq[j][e] << 16); qf[2 * e + 1] = __uint_as_float(rq[j][e] & 0xffff0000u); } }
                u32x4 ko, qo;
#pragma unroll
                for (int e = 0; e < 4; ++e) { ko[e] = cvtpk(kf[2 * e] * __expf(-bb[2 * e]), kf[2 * e + 1] * __expf(-bb[2 * e + 1]));
                    if (PB) qo[e] = cvtpk(qf[2 * e] * QSCALE * __expf(bb[2 * e]), qf[2 * e + 1] * QSCALE * __expf(bb[2 * e + 1])); }
                *(LAS u32x4*)(Ks + offb(t, c8)) = ko; if (PB) *(LAS u32x4*)(Qs + offb(t, c8)) = qo;
                if (t == 63) {
#pragma unroll
                    for (int e = 0; e < 8; ++e) { Ds[8 * c8 + e] = __expf(bb[e]); dsum8[e] += bb[e]; } } }
            blast = 0.f;
        } else {
            constexpr int TP = 8; const int dbase = 4 * (th & 31), tq8 = th >> 5;
            float kl[TP][4], ql[TP][4];
            f32x4 lip = {1.f, 1.f, 1.f, 1.f};
#pragma unroll
            for (int i = 0; i < TP; ++i) { const float hv[4] = {__uint_as_float(hraw[i].x << 16), __uint_as_float(hraw[i].x & 0xffff0000u), __uint_as_float(hraw[i].y << 16), __uint_as_float(hraw[i].y & 0xffff0000u)};
                const float hq[4] = {__uint_as_float(qraw[i].x << 16), __uint_as_float(qraw[i].x & 0xffff0000u), __uint_as_float(qraw[i].y << 16), __uint_as_float(qraw[i].y & 0xffff0000u)};
#pragma unroll
                for (int e = 0; e < 4; ++e) { const float eh = __expf(-hv[e]), g = __builtin_amdgcn_rcpf(1.0f + lb4[e] * eh); kl[i][e] = __builtin_fmaf(-lb4[e], eh, eh) * (g * lip[e]); lip[e] *= (1.0f + eh) * g;
                    if (PB) { const float eq = __expf(-hq[e]); ql[i][e] = hq[e] * __builtin_amdgcn_rcpf((1.0f + eq) * lip[e]); } } }
            *(LAS f32x4*)(btot + tq8 * 128 + dbase) = lip;
            __syncthreads();
            f32x4 offi = {1.f, 1.f, 1.f, 1.f}, toti = offi;
#pragma unroll
            for (int q = 0; q < 8; ++q) { const f32x4 v = *(const LAS f32x4*)(btot + q * 128 + dbase); toti *= v; if (q < tq8) offi *= v; }
            f32x4 poff = {1.f, 1.f, 1.f, 1.f};
            if (PB) {
#pragma unroll
                for (int e = 0; e < 4; ++e) poff[e] = __builtin_amdgcn_rcpf(offi[e]); }
#pragma unroll
            for (int i = 0; i < TP; ++i) { const int t = tq8 * TP + i;
                u32x2 kp; kp.x = cvtpk(kl[i][0] * offi[0], kl[i][1] * offi[1]); kp.y = cvtpk(kl[i][2] * offi[2], kl[i][3] * offi[3]); *(LAS u32x2*)(Ks + offb(t, dbase >> 3) + 2 * (dbase & 7)) = kp;
                if (PB) { u32x2 qp; qp.x = cvtpk(ql[i][0] * poff[0], ql[i][1] * poff[1]); qp.y = cvtpk(ql[i][2] * poff[2], ql[i][3] * poff[3]); *(LAS u32x2*)(Qs + offb(t, dbase >> 3) + 2 * (dbase & 7)) = qp; } }
            if (tq8 == 0) {
#pragma unroll
                for (int e = 0; e < 4; ++e) { Ds[dbase + e] = __builtin_amdgcn_rcpf(toti[e]); dsum8[e] -= __logf(toti[e]); } }
            blast = 0.f;
        }
        __syncthreads(); LIN_T(1);
        f32x16 o0, o1;
        u32x2 ggv[4][2]; float gsl[4][2][4];
        constexpr bool GE = PB && ((LIN_GATE_EARLY >> (HGRN ? 1 : 0)) & 1) != 0;
        constexpr bool SUE = PB && ((LIN_SU_EARLY >> (HGRN ? 1 : 0)) & 1) != 0;
        if (PB) {
#pragma unroll
            for (int g = 0; g < 4; ++g) { const int e0 = 32 * wl + 8 * g + 4 * hb;
#pragma unroll
                for (int tt = 0; tt < 2; ++tt) ggv[g][tt] = *(const u32x2*)(A.u + UOFF(tok0 + 32 * tt + r, A.goff + head * DV + e0, A.pitch)); }
            LD_FENCE();
        }
        if (PRE && !(LIN_QLATE && HGRN && PB) && c < 3) { LIN_LOADS_K(tok0 + 64); LIN_LOADS_V(tok0 + 64); LIN_LOADS_Q(tok0 + 64); }
        bf16x8 vf[4];
        if (PARK || SUE) {
#pragma unroll
            for (int ks = 0; ks < 4; ++ks) vf[ks] = ld_tr_frag(Vs + (wl >> 2) * 16384, lane, wl & 3, ks); }
        if (PB) {
            if (wl < 4) {
                const int tt = wl >> 1, st = wl & 1;
                f32x16 sa;
#pragma unroll
                for (int i = 0; i < 16; ++i) sa[i] = 0.f;
                if (st <= tt) {
#pragma unroll
                    for (int ks = 0; ks < 8; ++ks) { const bf16x8 af = ld_row_frag(Ks, 32 * st + r, 2 * ks + hb), bq = ld_row_frag(Qs, 32 * tt + r, 2 * ks + hb); sa = MFMA32(af, bq, sa); }
                    if (st == tt) {
#pragma unroll
                        for (int i = 0; i < 16; ++i) if (crow(i, hb) > r) sa[i] = 0.f; }
                }
#pragma unroll
                for (int g = 0; g < 4; ++g) { u32x2 p; p.x = cvtpk(sa[4 * g], sa[4 * g + 1]); p.y = cvtpk(sa[4 * g + 2], sa[4 * g + 3]);
                    *(LAS u32x2*)(As + (32 * tt + r) * 144 + (32 * st + 8 * g + 4 * hb) * 2) = p; }
            }
#pragma unroll
            for (int i = 0; i < 16; ++i) { o0[i] = 0.f; o1[i] = 0.f; }
#pragma unroll
            for (int dt = 0; dt < 4; ++dt) {
                const bf16x8 sf0 = pack_step<0>(Sacc[dt]), sf1 = pack_step<1>(Sacc[dt]);
#pragma unroll
                for (int s2 = 0; s2 < 2; ++s2) {
                    const u32x2 qa0 = *(const LAS u32x2*)(Qs + offb(r, 4 * dt + 2 * s2) + 8 * hb), qb0 = *(const LAS u32x2*)(Qs + offb(r, 4 * dt + 2 * s2 + 1) + 8 * hb);
                    const u32x2 qa1 = *(const LAS u32x2*)(Qs + offb(32 + r, 4 * dt + 2 * s2) + 8 * hb), qb1 = *(const LAS u32x2*)(Qs + offb(32 + r, 4 * dt + 2 * s2 + 1) + 8 * hb);
                    const u32x4 q0 = {qa0.x, qa0.y, qb0.x, qb0.y}, q1 = {qa1.x, qa1.y, qb1.x, qb1.y};
                    o0 = MFMA32(s2 ? sf1 : sf0, __builtin_bit_cast(bf16x8, q0), o0); o1 = MFMA32(s2 ? sf1 : sf0, __builtin_bit_cast(bf16x8, q1), o1); } }
            if (SUE) {
#pragma unroll
        for (int ks = 0; ks < 4; ++ks)
#pragma unroll
            for (int dt = 0; dt < 4; ++dt) { const bf16x8 kf = ld_tr_frag(Ks, lane, dt, ks); Sacc[dt] = MFMA32(kf, vf[ks], Sacc[dt]); }
#pragma unroll
        for (int dt = 0; dt < 4; ++dt)
#pragma unroll
            for (int g = 0; g < 4; ++g) { const f32x4 dv = *(const LAS f32x4*)(Ds + 32 * dt + 8 * g + 4 * hb);
#pragma unroll
                for (int e = 0; e < 4; ++e) Sacc[dt][4 * g + e] *= dv[e]; }
            if (GE) {
#pragma unroll
                for (int g = 0; g < 4; ++g) { const int e0 = 32 * wl + 8 * g + 4 * hb; const f32x4 gn = *(const LAS f32x4*)(gtab + e0);
#pragma unroll
                    for (int tt = 0; tt < 2; ++tt) { const u32x2 gg = ggv[g][tt];
                        const float gv[4] = {__uint_as_float(gg.x << 16), __uint_as_float(gg.x & 0xffff0000u), __uint_as_float(gg.y << 16), __uint_as_float(gg.y & 0xffff0000u)};
#pragma unroll
                        for (int e = 0; e < 4; ++e) gsl[g][tt][e] = gn[e] * (gv[e] * __builtin_amdgcn_rcpf(1.0f + __expf(-gv[e]))); } } }
            }
            __syncthreads(); LIN_T(2);
            if (PARK) {
#pragma unroll
                for (int g = 0; g < 4; ++g) { asm volatile("" :: "v"(ggv[g][0])); asm volatile("" :: "v"(ggv[g][1])); } }
            if (PARK && c < 3) LIN_DMA4(tok0 + 64, Ks, Qs, Vs, PARK_MASK & (SUE ? 7 : 4));
        }
        if (!PARK && !SUE) {
#pragma unroll
            for (int ks = 0; ks < 4; ++ks) vf[ks] = ld_tr_frag(Vs + (wl >> 2) * 16384, lane, wl & 3, ks); }
        if (PB) {
#pragma unroll
            for (int ks = 0; ks < 4; ++ks) {
                const bf16x8 a1 = *(const LAS bf16x8*)(As + (32 + r) * 144 + 32 * ks + 16 * hb); o1 = MFMA32(vf[ks], a1, o1);
                if (ks < 2) { const bf16x8 a0 = *(const LAS bf16x8*)(As + r * 144 + 32 * ks + 16 * hb); o0 = MFMA32(vf[ks], a0, o0); } }
            if (GE && !SUE) {
#pragma unroll
                for (int g = 0; g < 4; ++g) { const int e0 = 32 * wl + 8 * g + 4 * hb; const f32x4 gn = *(const LAS f32x4*)(gtab + e0);
#pragma unroll
                    for (int tt = 0; tt < 2; ++tt) { const u32x2 gg = ggv[g][tt];
                        const float gv[4] = {__uint_as_float(gg.x << 16), __uint_as_float(gg.x & 0xffff0000u), __uint_as_float(gg.y << 16), __uint_as_float(gg.y & 0xffff0000u)};
#pragma unroll
                        for (int e = 0; e < 4; ++e) gsl[g][tt][e] = gn[e] * (gv[e] * __builtin_amdgcn_rcpf(1.0f + __expf(-gv[e]))); } } }
        }
        if (!SUE) {
#pragma unroll
        for (int ks = 0; ks < 4; ++ks)
#pragma unroll
            for (int dt = 0; dt < 4; ++dt) { const bf16x8 kf = ld_tr_frag(Ks, lane, dt, ks); Sacc[dt] = MFMA32(kf, vf[ks], Sacc[dt]); }
#pragma unroll
        for (int dt = 0; dt < 4; ++dt)
#pragma unroll
            for (int g = 0; g < 4; ++g) { const f32x4 dv = *(const LAS f32x4*)(Ds + 32 * dt + 8 * g + 4 * hb);
#pragma unroll
                for (int e = 0; e < 4; ++e) Sacc[dt][4 * g + e] *= dv[e]; }
        }
        if (PRE && LIN_QLATE && HGRN && PB && c < 3) { LIN_LOADS_K(tok0 + 64); LIN_LOADS_V(tok0 + 64); LIN_LOADS_Q(tok0 + 64); }
        if (PB) {
            float s0 = 0.f, s1 = 0.f;
#pragma unroll
            for (int i = 0; i < 16; ++i) { s0 += o0[i] * o0[i]; s1 += o1[i] * o1[i]; }
            s0 += __shfl_xor(s0, 32); s1 += __shfl_xor(s1, 32);
            if (hb == 0) { red[wl * 64 + r] = s0; red[wl * 64 + 32 + r] = s1; }
            __syncthreads(); LIN_T(3);
            if (PARK && !SUE && c < 3) LIN_DMA4(tok0 + 64, Ks, Qs, Vs, PARK_MASK & 3);
#ifdef PARK_DEBUG_SYNC
            if (PARK) { asm volatile("s_waitcnt vmcnt(0)" ::: "memory"); __syncthreads(); }
#endif
            float t0 = 0.f, t1 = 0.f;
#pragma unroll
            for (int w = 0; w < NWH; ++w) { t0 += red[w * 64 + r]; t1 += red[w * 64 + 32 + r]; }
            const float rs0 = 1.0f / sqrtf(t0 * (1.0f / DV) + EPS), rs1 = 1.0f / sqrtf(t1 * (1.0f / DV) + EPS);
#pragma unroll
            for (int g = 0; g < 4; ++g) { const int e0 = 32 * wl + 8 * g + 4 * hb; const f32x4 gn = *(const LAS f32x4*)(gtab + e0);
#pragma unroll
                for (int tt = 0; tt < 2; ++tt) { const size_t tok = (size_t)(tok0 + 32 * tt + r); const u32x2 gg = ggv[g][tt];
                    const float g0 = __uint_as_float(gg.x << 16), g1 = __uint_as_float(gg.x & 0xffff0000u), g2 = __uint_as_float(gg.y << 16), g3 = __uint_as_float(gg.y & 0xffff0000u);
                    const float rs = tt ? rs1 : rs0;
                    float v0, v1, v2, v3;
                    if (GE) { v0 = (tt ? o1[4 * g] : o0[4 * g]) * rs * gsl[g][tt][0]; v1 = (tt ? o1[4 * g + 1] : o0[4 * g + 1]) * rs * gsl[g][tt][1]; v2 = (tt ? o1[4 * g + 2] : o0[4 * g + 2]) * rs * gsl[g][tt][2]; v3 = (tt ? o1[4 * g + 3] : o0[4 * g + 3]) * rs * gsl[g][tt][3]; }
                    else { v0 = (tt ? o1[4 * g] : o0[4 * g]) * rs * gn[0] * (g0 * __builtin_amdgcn_rcpf(1.0f + __expf(-g0))); v1 = (tt ? o1[4 * g + 1] : o0[4 * g + 1]) * rs * gn[1] * (g1 * __builtin_amdgcn_rcpf(1.0f + __expf(-g1)));
                        v2 = (tt ? o1[4 * g + 2] : o0[4 * g + 2]) * rs * gn[2] * (g2 * __builtin_amdgcn_rcpf(1.0f + __expf(-g2))); v3 = (tt ? o1[4 * g + 3] : o0[4 * g + 3]) * rs * gn[3] * (g3 * __builtin_amdgcn_rcpf(1.0f + __expf(-g3))); }
                    u32x2 p; p.x = cvtpk(v0, v1); p.y = cvtpk(v2, v3); *(u32x2*)(A.mix + tok * 2048 + A.mixoff + head * DV + e0) = p; } }
        }
        if (PARK || PADB) asm volatile("s_waitcnt vmcnt(0)" ::: "memory");
        __syncthreads(); LIN_T(4);
    }
    if (!PB) {
        int tid_e = tid; asm volatile("" : "+v"(tid_e));
        const int th = tid_e - hs * NTH, d = th & 127, tq = th >> 7;
        float* sp = A.sloc + ((((size_t)ui * (DV / 32) + wl) * 4) * 64 + (tid_e & 63)) * 16;
#pragma unroll
        for (int dt = 0; dt < 4; ++dt)
#pragma unroll
            for (int g = 0; g < 4; ++g) *(f32x4*)(sp + dt * 1024 + 4 * g) = (f32x4){Sacc[dt][4 * g], Sacc[dt][4 * g + 1], Sacc[dt][4 * g + 2], Sacc[dt][4 * g + 3]};
        if (HGRN) { if ((th >> 5) == 0) {
#pragma unroll
            for (int e = 0; e < 4; ++e) A.dsc[ui * 128 + 4 * (th & 31) + e] = __expf(dsum8[e]); } }
        else if (th >= NTH - 16) {
#pragma unroll
            for (int e = 0; e < 8; ++e) A.dsc[ui * 128 + 8 * (th - (NTH - 16)) + e] = __expf(dsum8[e]); }
    }
}

namespace att {
constexpr int D = 128;
constexpr float SCALE = 0.08838834764831845f, INV_SCALE = 11.313708498984761f;
constexpr float THR = 8.f;
constexpr int NW = 8, QBLK = 32, KVBLK = 64, QB = NW * QBLK;
constexpr int SHM_V = KVBLK * D * 2, SHM_K = KVBLK * D * 2;
constexpr int LDS_CORE = 2 * SHM_V + 2 * SHM_K + NW * 64 * 4;
constexpr int OFF_BIAS = LDS_CORE, OFF_SEL = OFF_BIAS + 8192, OFF_KM = OFF_SEL + 1024, OFF_SCAN = OFF_KM + 3584, LDS_ATT = OFF_SCAN + 64;
static_assert(LDS_ATT <= MISC_OFF, "attention LDS");
#define KSWZ(row, colB) ((row) * 256 + ((colB) ^ (((row) & 7) << 4)))
#define SBAR() __builtin_amdgcn_sched_barrier(0)
__device__ __forceinline__ int v_st(int k, int c) { const int kk = (k & ~0xC) | ((k & 4) << 1) | ((k & 8) >> 1); return ((kk >> 3) * 4 + (c >> 5)) * 512 + ((kk & 7) * 32 + (c & 31)) * 2; }
__device__ __forceinline__ int v_rd_base(int lane) { return ((lane & 3) << 3) | (((lane >> 2) & 3) << 6) | (((lane >> 4) & 1) << 5) | (((lane >> 5) & 1) << 8); }
constexpr int v_rd_off(int d0, int ks, int half) { return d0 * 512 + ks * 4096 + half * 2048; }
__device__ __forceinline__ unsigned cvtpk_a(float lo, float hi) { unsigned r; asm volatile("v_cvt_pk_bf16_f32 %0, %1, %2" : "=v"(r) : "v"(lo), "v"(hi)); return r; }
__device__ __forceinline__ bf16x8 load8(const bf16* p) { return *reinterpret_cast<const bf16x8*>(p); }
__device__ __forceinline__ void mask_tile(f32x16& p0, f32x16& p1, int dq) {
    const float NEG = -__builtin_inff();
#pragma unroll
    for (int r = 0; r < 16; ++r) {
        const int c = (r & 3) + 8 * (r >> 2);
        if (dq - c < 0) p0[r] = NEG;
        if (dq - c - 32 < 0) p1[r] = NEG;
    }
}
__device__ __forceinline__ void partialSM(f32x16& p0, f32x16& p1, float& m_reg, float& mn, float& alpha, const bool keep) {
    float pmax = p0[0]; for (int r = 1; r < 16; ++r) pmax = fmaxf(pmax, p0[r]); for (int r = 0; r < 16; ++r) pmax = fmaxf(pmax, p1[r]);
    { auto rr = __builtin_amdgcn_permlane32_swap(__float_as_uint(pmax), __float_as_uint(pmax), false, false);
      pmax = fmaxf(__uint_as_float(rr[0]), __uint_as_float(rr[1])); }
    pmax = keep ? pmax : -__builtin_inff();
    constexpr float C2 = 1.4426950408889634f * SCALE;
    if (__builtin_expect(__all((pmax - m_reg) * SCALE <= THR), 1)) { mn = m_reg; alpha = 1.f; }
    else { mn = fmaxf(m_reg, pmax); alpha = __builtin_amdgcn_exp2f((m_reg - mn) * C2); m_reg = mn; }
    const float mnL = keep ? -mn * C2 : -__builtin_inff();
    for (int r = 0; r < 16; ++r) p0[r] = fmaf(p0[r], C2, mnL); for (int r = 0; r < 16; ++r) p1[r] = fmaf(p1[r], C2, mnL);
    for (int r = 0; r < 16; ++r) p0[r] = __builtin_amdgcn_exp2f(p0[r]);
}
__device__ __forceinline__ void finishSM(f32x16& p0, f32x16& p1, float alpha, float& l_reg, bf16x8& pa0, bf16x8& pa1, bf16x8& pa2, bf16x8& pa3) {
    for (int r = 0; r < 16; ++r) p1[r] = __builtin_amdgcn_exp2f(p1[r]);
    float ps = 0; for (int r = 0; r < 16; ++r) ps += p0[r]; for (int r = 0; r < 16; ++r) ps += p1[r];
    { auto rr = __builtin_amdgcn_permlane32_swap(__float_as_uint(ps), __float_as_uint(ps), false, false);
      ps = __uint_as_float(rr[0]) + __uint_as_float(rr[1]); }
    l_reg = l_reg * alpha + ps;
#define PK4(P, B_, OUT) do { unsigned a0 = cvtpk_a(P[B_+0], P[B_+1]), a1 = cvtpk_a(P[B_+2], P[B_+3]);                          \
        unsigned b0 = cvtpk_a(P[B_+4], P[B_+5]), b1 = cvtpk_a(P[B_+6], P[B_+7]);                                             \
        auto r0 = __builtin_amdgcn_permlane32_swap(a0, b0, false, false); auto r1 = __builtin_amdgcn_permlane32_swap(a1, b1, false, false); \
        u32x4 w = {r0[0], r1[0], r0[1], r1[1]}; OUT = *reinterpret_cast<bf16x8*>(&w); } while (0)
    PK4(p0, 0, pa0); PK4(p0, 8, pa1); PK4(p1, 0, pa2); PK4(p1, 8, pa3);
#undef PK4
}
template <int KB>
__device__ __forceinline__ void qkt(f32x16& p0, f32x16& p1, const char* K_lds, int r32, int hi, const bf16x8* qr, const float* bp) {
#pragma unroll
    for (int g = 0; g < 4; ++g) { const f32x4 b0 = *(const f32x4*)(bp + 8 * g), b1 = *(const f32x4*)(bp + 32 + 8 * g);
#pragma unroll
        for (int e = 0; e < 4; ++e) { p0[4 * g + e] = b0[e]; p1[4 * g + e] = b1[e]; } }
    const char* kb[4];
#pragma unroll
    for (int dd = 0; dd < 4; ++dd) kb[dd] = K_lds + KB * SHM_K + KSWZ(r32, (dd * 16 + hi * 8) * 2);
#pragma unroll
    for (int d0 = 0; d0 < 8; ++d0) { const char* a = kb[d0 & 3] + (d0 >> 2) * 128;
        bf16x8 b0 = *reinterpret_cast<const bf16x8*>(a);
        bf16x8 b1 = *reinterpret_cast<const bf16x8*>(a + 32 * 256);
        p0 = __builtin_amdgcn_mfma_f32_32x32x16_bf16(b0, qr[d0], p0, 0, 0, 0);
        p1 = __builtin_amdgcn_mfma_f32_32x32x16_bf16(b1, qr[d0], p1, 0, 0, 0); }
}
template <int VB>
__device__ __forceinline__ void pv_tile(f32x16* o, int vb0, bf16x8 pa0, bf16x8 pa1, bf16x8 pa2, bf16x8 pa3) {
#define TRRD(dst, off) asm volatile("ds_read_b64_tr_b16 %0, %1 offset:%2" : "=&v"(dst) : "v"(vb0), "i"(off) : "memory")
#define PV_D0(d0) do { s16x4 l0, l1, l2, l3, h0, h1, h2, h3; constexpr int b_ = VB * SHM_V + v_rd_off(d0, 0, 0);   \
        TRRD(l0, b_); TRRD(h0, b_ + 2048); TRRD(l1, b_ + 4096); TRRD(h1, b_ + 6144); TRRD(l2, b_ + 8192); TRRD(h2, b_ + 10240); TRRD(l3, b_ + 12288); TRRD(h3, b_ + 14336); \
        asm volatile("s_waitcnt lgkmcnt(0)" ::: "memory"); SBAR();   \
        o[d0] = __builtin_amdgcn_mfma_f32_32x32x16_bf16(pa0, (bf16x8){l0[0], l0[1], l0[2], l0[3], h0[0], h0[1], h0[2], h0[3]}, o[d0], 0, 0, 0);   \
        o[d0] = __builtin_amdgcn_mfma_f32_32x32x16_bf16(pa1, (bf16x8){l1[0], l1[1], l1[2], l1[3], h1[0], h1[1], h1[2], h1[3]}, o[d0], 0, 0, 0);   \
        o[d0] = __builtin_amdgcn_mfma_f32_32x32x16_bf16(pa2, (bf16x8){l2[0], l2[1], l2[2], l2[3], h2[0], h2[1], h2[2], h2[3]}, o[d0], 0, 0, 0);   \
        o[d0] = __builtin_amdgcn_mfma_f32_32x32x16_bf16(pa3, (bf16x8){l3[0], l3[1], l3[2], l3[3], h3[0], h3[1], h3[2], h3[3]}, o[d0], 0, 0, 0); } while (0)
    PV_D0(0); PV_D0(1); PV_D0(2); PV_D0(3);
#undef PV_D0
#undef TRRD
}
struct Blk { const bf16* u; int tokb, qcol, kcol, vcol; bf16* O; int P0; };
struct Seam { bf16x8 qr[8]; bf16x8 st_v0, st_v1, st_k0, st_k1; };
#define ROW(colbase, k0, rr) (Ub + UOFF(tokb_ + (k0) + (rr), (colbase) + sc, pitch))
#define VMW() asm volatile("s_waitcnt vmcnt(0)" ::: "memory")
#define VMWN(n) asm volatile("s_waitcnt vmcnt(%0)" :: "i"(n) : "memory")
#define SLOAD_H(Kp, Vp, k0) do { S.st_v0 = load8(ROW(Vp, k0, sr)); S.st_v1 = load8(ROW(Vp, k0, 32 + sr));              \
                         S.st_k0 = load8(ROW(Kp, k0, sr)); S.st_k1 = load8(ROW(Kp, k0, 32 + sr)); } while (0)
#define SWRITE_HK(bf) do { *(bf16x8*)(K_lds + (bf) * SHM_K + kws) = S.st_k0; *(bf16x8*)(K_lds + (bf) * SHM_K + kws + 32 * 256) = S.st_k1; } while (0)
#define SWRITE_HV(bf) do { *(bf16x8*)(V_lds + (bf) * SHM_V + vst0) = S.st_v0; *(bf16x8*)(V_lds + (bf) * SHM_V + vst1) = S.st_v1; } while (0)
#define SWRITE_H(bf) do { SWRITE_HV(bf); SWRITE_HK(bf); } while (0)
__device__ __forceinline__ void prime(const Blk& cur, char* lds, Seam& S, const int pitch) {
    const int tid = otid(), wid = __builtin_amdgcn_readfirstlane(tid >> 6), lane = tid & 63, r32 = lane & 31, hi = lane >> 5;
    const int sr = tid >> 4, sc = (tid & 15) * 8, kws = KSWZ(sr, sc * 2); char* K_lds = lds + 2 * SHM_V;
    const bf16* Ub = cur.u; const int tokb_ = cur.tokb;
    for (int d0 = 0; d0 < 8; ++d0) S.qr[d0] = load8(cur.u + UOFF(cur.tokb + cur.P0 + wid * QBLK + r32, cur.qcol + d0 * 16 + hi * 8, pitch));
    SLOAD_H(cur.kcol, cur.vcol, 0); VMW(); SWRITE_HK(0);
    __syncthreads();
}
__device__ __forceinline__ void block(const Blk& cur, const Blk& nxt, char* lds, Seam& S, const int pitch, const int opitch, const unsigned selbits, const float* biasL) {
    const int tid = otid(), wid = __builtin_amdgcn_readfirstlane(tid >> 6), lane = tid & 63, r32 = lane & 31, hi = lane >> 5;
    const int NT = cur.P0 / KVBLK + QB / KVBLK;
    const int qbn = cur.P0 >> 8;
    const int qlo = cur.P0 + wid * QBLK, qm = qlo + r32 - 4 * hi;
    char* V_lds = lds; char* K_lds = lds + 2 * SHM_V;
    float* ws = (float*)(lds + 2 * SHM_V + 2 * SHM_K) + wid * 64; float* li_l = ws, * al_l = ws + 32;
    float m_reg = -1e30f, l_reg = 0; f32x16 o[4] = {};
    const int sr = tid >> 4, sc = (tid & 15) * 8, vst0 = v_st(sr, sc), vst1 = v_st(32 + sr, sc), kws = KSWZ(sr, sc * 2);
    const int vb0 = (int)(uintptr_t)V_lds + v_rd_base(lane);
    const int Kh = cur.kcol, Vh = cur.vcol; const bf16* Ub = cur.u; const int tokb_ = cur.tokb;
#define RESC(a) do { if (__any((a) < 1.f)) { if (hi == 0) al_l[r32] = (a); asm volatile("s_waitcnt lgkmcnt(0)" ::: "memory");              \
                     for (int d_ = 0; d_ < 4; ++d_) for (int r = 0; r < 16; ++r) o[d_][r] *= al_l[crow(r, hi)]; } } while (0)
#define KBASE(t) ((t) * KVBLK)
#define MASKT(P0_, P1_, t) do { const int kb_ = KBASE(t); if ((kb_ >> 8) >= qbn && kb_ + KVBLK - 1 > qlo) mask_tile(P0_, P1_, qm - kb_); } while (0)
#define KEEPT(t) ((((t) * KVBLK) >> 8) >= qbn || ((selbits >> (((t) * KVBLK) >> 8)) & 1u))
#define BIASP(t) (biasL + KBASE(t) + 4 * hi)
    constexpr int NQL = 8;
#define SEAM_K0() do { VMWN(NQL); SWRITE_HK(0); SBAR(); } while (0)
    f32x16 pA0, pA1, pB0, pB1; float mnA, mnB, alA, alB; bf16x8 pa0, pa1, pa2, pa3;
    SWRITE_HV(0); SBAR();
    SLOAD_H(Kh, Vh, KBASE(1));
    SBAR(); qkt<0>(pA0, pA1, K_lds, r32, hi, S.qr, BIASP(0));
    MASKT(pA0, pA1, 0); partialSM(pA0, pA1, m_reg, mnA, alA, KEEPT(0));
    VMW(); SWRITE_H(1);
    __syncthreads();
#define HALF_STEP(PX0, PX1, mnX, alX, PY0, PY1, alY, t, KB, VB, SB) do {                                                      \
        SBAR(); qkt<KB>(PX0, PX1, K_lds, r32, hi, S.qr, BIASP(t));                                                           \
        finishSM(PY0, PY1, alY, l_reg, pa0, pa1, pa2, pa3); SBAR();                                                           \
        if ((t) + 1 < NT) { SLOAD_H(Kh, Vh, KBASE((t) + 1)); SBAR(); }                                                        \
        pv_tile<VB>(o, vb0, pa0, pa1, pa2, pa3); MASKT(PX0, PX1, (t)); partialSM(PX0, PX1, m_reg, mnX, alX, KEEPT(t));        \
        __syncthreads();                                                                                                      \
        if ((t) + 1 < NT) { VMW(); SWRITE_H(SB); }                                                                            \
        RESC(alX); __syncthreads(); } while (0)
    for (int t = 1; t + 1 < NT; t += 2) {
        HALF_STEP(pB0, pB1, mnB, alB, pA0, pA1, alA, t, 1, 0, 0);
        HALF_STEP(pA0, pA1, mnA, alA, pB0, pB1, alB, t + 1, 0, 1, 1);
    }
    SBAR(); qkt<1>(pB0, pB1, K_lds, r32, hi, S.qr, BIASP(NT - 1)); SBAR();
    SLOAD_H(nxt.kcol, nxt.vcol, 0); SBAR();
#pragma unroll
    for (int d0 = 0; d0 < 8; ++d0) S.qr[d0] = load8(nxt.u + UOFF(nxt.tokb + nxt.P0 + wid * QBLK + r32, nxt.qcol + d0 * 16 + hi * 8, pitch));
    SBAR();
    finishSM(pA0, pA1, alA, l_reg, pa0, pa1, pa2, pa3); SBAR();
    pv_tile<0>(o, vb0, pa0, pa1, pa2, pa3);
    MASKT(pB0, pB1, NT - 1); partialSM(pB0, pB1, m_reg, mnB, alB, true); __syncthreads(); RESC(alB);
    finishSM(pB0, pB1, alB, l_reg, pa0, pa1, pa2, pa3); SBAR(); pv_tile<1>(o, vb0, pa0, pa1, pa2, pa3);
    SBAR(); SEAM_K0();
#ifdef PROBE_ATT
    unsigned long long te_ = 0; if (threadIdx.x == 0) te_ = __builtin_amdgcn_s_memrealtime();
#endif
    if (hi == 0) li_l[r32] = l_reg; asm volatile("s_waitcnt lgkmcnt(0)" ::: "memory");
    float rli[16];
#pragma unroll
    for (int r = 0; r < 16; ++r) rli[r] = __builtin_amdgcn_rcpf(li_l[crow(r, hi)]);
    bf16* Ow = cur.O + (size_t)(wid * QBLK) * opitch;
#pragma unroll
    for (int r = 0; r < 16; ++r) { const int orow = crow(r, hi);
#pragma unroll
        for (int d0 = 0; d0 < 4; ++d0) { const float v = o[d0][r] * rli[r];
            const float vn = __shfl_xor(v, 1);
            if ((r32 & 1) == 0) *(unsigned*)(Ow + (size_t)orow * opitch + d0 * 32 + r32) = cvtpk_a(v, vn); } }
    __syncthreads();
#ifdef PROBE_ATT
    if (PROBE_ATT == 2 && threadIdx.x == 0) ((volatile unsigned*)(lds + MISC_OFF))[20] += (unsigned)(__builtin_amdgcn_s_memrealtime() - te_);
#endif
#undef RESC
#undef KBASE
#undef MASKT
#undef KEEPT
#undef BIASP
#undef SEAM_K0
#undef HALF_STEP
}
#undef ROW
#undef VMW
#undef VMWN
#undef SLOAD_H
#undef SWRITE_HK
#undef SWRITE_HV
#undef SWRITE_H

__device__ __forceinline__ void setup(char* lds, const int mode, const Blk& cur, const int pitch, const int b, const int h, const float* kmean, const float* ff, const float* fbias, const int pass) {
    const int tid = otid(), lane = tid & 63, wave = tid >> 6;
    float* biasL = (float*)(lds + OFF_BIAS); unsigned* selm = (unsigned*)(lds + OFF_SEL); float* kms = (float*)(lds + OFF_KM); float* scanw = (float*)(lds + OFF_SCAN);
    const int qb = cur.P0 >> 8;
    if (mode == 0) {
        const float slope = exp2f(-(float)(h + 1)) * INV_SCALE;
        if (qb > 3) for (int i = tid; i < qb * 128; i += 512) kms[i] = kmean[(size_t)((b * 8 + h) * 8) * 128 + i];
        for (int s = tid; s < cur.P0 + 256; s += 512) biasL[s] = slope * (float)(s - cur.P0);
        __syncthreads();
        const int row = tid >> 1, dh = tid & 1;
        unsigned bits = (1u << qb) - 1u;
        if (qb > 3) {
            float acc[7] = {0.f, 0.f, 0.f, 0.f, 0.f, 0.f, 0.f};
            bf16x8 qv8[8];
#pragma unroll
            for (int c = 0; c < 8; ++c) qv8[c] = load8(cur.u + UOFF(cur.tokb + cur.P0 + row, cur.qcol + 64 * dh + 8 * c, pitch));
            asm volatile("" ::: "memory");
#pragma unroll
            for (int c = 0; c < 8; ++c) { const bf16x8 qv = qv8[c];
#pragma unroll
                for (int e = 0; e < 8; ++e) { const float qf = bf2f((unsigned short)qv[e]);
#pragma unroll
                    for (int n = 0; n < 7; ++n) acc[n] += qf * kms[n * 128 + 64 * dh + 8 * c + e]; } }
#pragma unroll
            for (int n = 0; n < 7; ++n) acc[n] += __shfl_xor(acc[n], 1);
            bits = 0u;
#pragma unroll
            for (int pick = 0; pick < 3; ++pick) { float best = -__builtin_inff(); int bi = 0;
#pragma unroll
                for (int n = 0; n < 7; ++n) if (n < qb && !((bits >> n) & 1u) && acc[n] > best) { best = acc[n]; bi = n; }
                bits |= 1u << bi; }
        }
        if (dh == 0) selm[row] = bits;
        __syncthreads();
    } else if (pass != 0) {
        const float bref = biasL[cur.P0];
        __syncthreads();
#pragma unroll
        for (int i = 0; i < 4; ++i) biasL[4 * tid + i] -= bref;
        __syncthreads();
    } else {
        const float fb = fbias[h];
        float v[4]; float run = 0.f;
#pragma unroll
        for (int i = 0; i < 4; ++i) v[i] = ff[(size_t)(b * SEQ + 4 * tid + i) * 8 + h];
        asm volatile("" ::: "memory");
#pragma unroll
        for (int i = 0; i < 4; ++i) { run += log_sigmoid(v[i] + fb); v[i] = run; }
        float incl = run;
#pragma unroll
        for (int o = 1; o < 64; o <<= 1) { const float t = __shfl_up(incl, o); if (lane >= o) incl += t; }
        if (lane == 63) scanw[wave] = incl;
        __syncthreads();
        float off = incl - run;
        for (int w = 0; w < wave; ++w) off += scanw[w];
#pragma unroll
        for (int i = 0; i < 4; ++i) { v[i] += off; biasL[4 * tid + i] = v[i]; }
        __syncthreads();
        const float cref = biasL[cur.P0];
        __syncthreads();
#pragma unroll
        for (int i = 0; i < 4; ++i) biasL[4 * tid + i] = (cref - v[i]) * INV_SCALE;
        if (tid < 256) selm[tid] = 0xffu;
        __syncthreads();
    }
}
__device__ __forceinline__ void pair_item(char* lds, const int item, const int mode, const bf16* u, const int pitch, const int qoff, const int koff, const int voff,
                                          bf16* mix, const int mixoff, const float* kmean, const float* ff, const float* fbias) {
    const int bh = item >> 2, x = item & 3, b = bh >> 3, h = bh & 7;
    bf16* obase = mix + (size_t)(b * SEQ) * 2048 + mixoff + h * 128;
    const float* biasL = (const float*)(lds + OFF_BIAS); const unsigned* selm = (const unsigned*)(lds + OFF_SEL);
    Blk cur;
    cur.P0 = x * 256; cur.u = u; cur.tokb = b * SEQ; cur.qcol = qoff + h * 128; cur.kcol = koff + h * 128; cur.vcol = voff + h * 128; cur.O = obase + (size_t)cur.P0 * 2048;
    Seam S;
    for (int pass = 0; pass < 2; ++pass) {
#ifdef PROBE_ATT
        unsigned long long ta_ = 0; if (threadIdx.x == 0) ta_ = __builtin_amdgcn_s_memrealtime();
#endif
        setup(lds, mode, cur, pitch, b, h, kmean, ff, fbias, pass);
#ifdef PROBE_ATT
        if (threadIdx.x == 0) { const unsigned long long tb_ = __builtin_amdgcn_s_memrealtime(); if (PROBE_ATT == 0 && mode == PROBE_ATT_MODE) ((volatile unsigned*)(lds + MISC_OFF))[20] += (unsigned)(tb_ - ta_); ta_ = tb_; }
#endif
        if (pass == 0) prime(cur, lds, S, pitch);
        Blk nxt = cur;
        if (pass == 0) { nxt.P0 = (7 - x) * 256; nxt.O = obase + (size_t)nxt.P0 * 2048; }
        const int t_ = otid();
        const unsigned sel = selm[(t_ >> 6) * 32 + (t_ & 31)];
        block(cur, nxt, lds, S, pitch, 2048, sel, biasL);
#ifdef PROBE_ATT
        if (threadIdx.x == 0) { const unsigned long long tb_ = __builtin_amdgcn_s_memrealtime(); if (PROBE_ATT == 1 && mode == PROBE_ATT_MODE) ((volatile unsigned*)(lds + MISC_OFF))[20] += (unsigned)(tb_ - ta_); }
#endif
        cur = nxt;
    }
}
}

template <int DV, bool HGRN>
__device__ __forceinline__ void ref_lin(LAS unsigned char* lds, const int tid, const int G, const bf16* u, const int pitch, const int qoff, const int koff, const int voff, const int goff,
                                        const float* glr, const float* w2, const float* gb, const float* lbraw, const float* gain, bf16* mix, const int mixoff) {
    constexpr int NDP = 512 / DV, DPP = 128 / NDP, NHEADS = HGRN ? 8 : 4, TPG = 16 / NDP, NWG = DV / 64;
    LAS float* qs = (LAS float*)lds; LAS float* ks = qs + 16 * 128; LAS float* dcs = ks + 16 * 128; LAS float* ored = dcs + 16 * 128; LAS float* wred = ored + NDP * 16 * DV;
    const int e = tid % DV, dp = tid / DV, lane = tid & 63, wave = tid >> 6;
    for (int unit = blockIdx.x; unit < NB * NHEADS; unit += G) {
        const int b = unit / NHEADS, head = unit % NHEADS;
        float S[DPP];
#pragma unroll
        for (int i = 0; i < DPP; ++i) S[i] = 0.f;
        for (int t0 = 0; t0 < SEQ; t0 += 16) {
            for (int idx = tid; idx < 16 * 128; idx += 512) { const int tt = idx >> 7, d = idx & 127; const size_t tok = (size_t)(b * SEQ + t0 + tt);
                float q, k, dc;
                if (!HGRN) { float z = gb[head * 128 + d]; for (int r = 0; r < 16; ++r) z += glr[tok * 16 + r] * w2[r * 512 + head * 128 + d];
                    dc = expf(log_sigmoid(z) * (1.0f / 16.0f)); q = bf2f(u[UOFF((int)tok, qoff + head * 128 + d, pitch)]) * QSCALE; k = bf2f(u[UOFF((int)tok, koff + head * 128 + d, pitch)]); }
                else { const float lb = sigmoidf(lbraw[1024 + head * 128 + d] - lbraw[head * 128 + d]); const float f = lb + (1.f - lb) * sigmoidf(bf2f(u[UOFF((int)tok, koff + head * 128 + d, pitch)]));
                    dc = f; k = 1.f - f; const float hq = bf2f(u[UOFF((int)tok, qoff + head * 128 + d, pitch)]); q = hq * sigmoidf(hq); }
                qs[idx] = q; ks[idx] = k; dcs[idx] = dc; }
            __syncthreads();
            for (int tt = 0; tt < 16; ++tt) { const size_t tok = (size_t)(b * SEQ + t0 + tt); const float v = bf2f(u[UOFF((int)tok, voff + head * DV + e, pitch)]); float op = 0.f;
#pragma unroll
                for (int i = 0; i < DPP; ++i) { const int d = dp * DPP + i; S[i] = dcs[tt * 128 + d] * S[i] + ks[tt * 128 + d] * v; op += S[i] * qs[tt * 128 + d]; }
                ored[(dp * 16 + tt) * DV + e] = op; }
            __syncthreads();
            float ov[TPG];
#pragma unroll
            for (int j = 0; j < TPG; ++j) { const int tt = dp * TPG + j; float o = 0.f;
#pragma unroll
                for (int p = 0; p < NDP; ++p) o += ored[(p * 16 + tt) * DV + e];
                ov[j] = o; const float sq = wave_sum(o * o); if (lane == 0) wred[wave * TPG + j] = sq; }
            __syncthreads();
#pragma unroll
            for (int j = 0; j < TPG; ++j) { const int tt = dp * TPG + j; float tot = 0.f;
#pragma unroll
                for (int w = 0; w < NWG; ++w) tot += wred[(dp * NWG + w) * TPG + j];
                const float rs = 1.0f / sqrtf(tot * (1.0f / DV) + EPS); const size_t tok = (size_t)(b * SEQ + t0 + tt);
                const float g = bf2f(u[UOFF((int)tok, goff + head * DV + e, pitch)]);
                mix[tok * 2048 + mixoff + head * DV + e] = f2bf(ov[j] * rs * gain[e] * (g * sigmoidf(g))); }
            __syncthreads();
        }
    }
}
__device__ __forceinline__ void ref_cfox(const float* ff, const float* fbias, float* cfox, const int G, const int tid) {
    const int gid = blockIdx.x * 512 + tid;
    if (gid < 64) { const int b = gid >> 3, h = gid & 7; float run = 0.f;
        for (int s = 0; s < SEQ; ++s) { run += log_sigmoid(ff[(size_t)(b * SEQ + s) * 8 + h] + fbias[h]); cfox[(size_t)gid * SEQ + s] = run; } }
}
__device__ __forceinline__ void ref_att(LAS unsigned char* lds, const int tid, const int G, const int mode, const bf16* u, const int pitch, const int qoff, const int koff, const int voff,
                                        bf16* mix, const int mixoff, const float* kmean, const float* cfox) {
    const int lane = tid & 63, wave = tid >> 6;
    LAS float* qf = (LAS float*)lds + wave * 128;
    for (int rowid = blockIdx.x * NWAVES + wave; rowid < NB * 8 * SEQ; rowid += G * NWAVES) {
        const int b = rowid >> 14, h = (rowid >> 11) & 7, t = rowid & 2047, j = t >> 8;
        const unsigned qq = *(const unsigned*)(u + UOFF(b * SEQ + t, qoff + h * 128 + 2 * lane, pitch));
        const float q0 = __uint_as_float(qq << 16), q1 = __uint_as_float(qq & 0xffff0000u);
        qf[2 * lane] = q0; qf[2 * lane + 1] = q1;
        unsigned bits = 0xffu;
        if (mode == 0) {
            float gate[7];
#pragma unroll
            for (int n = 0; n < 7; ++n) { const float* km = kmean + (size_t)((b * 8 + h) * 8 + n) * 128; gate[n] = wave_sum(q0 * km[2 * lane] + q1 * km[2 * lane + 1]); }
            if (j <= 3) bits = (1u << j) - 1u;
            else { bits = 0u;
#pragma unroll
                for (int pick = 0; pick < 3; ++pick) { float best = -__builtin_inff(); int bi = 0;
#pragma unroll
                    for (int n = 0; n < 7; ++n) if (n < j && !((bits >> n) & 1u) && gate[n] > best) { best = gate[n]; bi = n; }
                    bits |= 1u << bi; } }
        }
        const float slope = exp2f(-(float)(h + 1));
        const float ct = mode ? cfox[(size_t)(b * 8 + h) * SEQ + t] : 0.f;
        float m = -1e30f, l = 0.f, o0 = 0.f, o1 = 0.f;
        for (int kb = 0; kb <= t; kb += 64) {
            const int s = kb + lane; const int sc = s <= t ? s : t;
            bool valid = s <= t;
            if (mode == 0 && valid) { const int n = s >> 8; valid = (n == j) || ((bits >> n) & 1u); }
            float dot = 0.f;
            for (int c = 0; c < 16; ++c) { const bf16x8 kv = *(const bf16x8*)(u + UOFF(b * SEQ + sc, koff + h * 128 + 8 * c, pitch));
#pragma unroll
                for (int e = 0; e < 8; ++e) dot += qf[8 * c + e] * bf2f((unsigned short)kv[e]); }
            const float bias = mode ? (ct - cfox[(size_t)(b * 8 + h) * SEQ + sc]) : -slope * (float)(t - sc);
            const float logit = valid ? dot * QSCALE + bias : -__builtin_inff();
            const float mx = wave_max(logit), mnew = fmaxf(m, mx), alpha = expf(m - mnew);
            const float p = valid ? expf(logit - mnew) : 0.f;
            l = l * alpha + wave_sum(p); o0 *= alpha; o1 *= alpha; m = mnew;
            const int nk = (t - kb + 1) < 64 ? (t - kb + 1) : 64;
            for (int jj = 0; jj < nk; ++jj) { const float pj = __shfl(p, jj); const unsigned vv = *(const unsigned*)(u + UOFF(b * SEQ + kb + jj, voff + h * 128 + 2 * lane, pitch));
                o0 += pj * __uint_as_float(vv << 16); o1 += pj * __uint_as_float(vv & 0xffff0000u); }
        }
        const float inv = 1.0f / l;
        *(unsigned*)(mix + (size_t)(b * SEQ + t) * 2048 + mixoff + h * 128 + 2 * lane) = cvtpk(o0 * inv, o1 * inv);
    }
}

#ifndef ONE_LAUNCH
#define ONE_LAUNCH 1
#endif
#ifndef REF_LIN0
#define REF_LIN0 0
#endif
#ifndef REF_LIN1
#define REF_LIN1 0
#endif
#ifndef REF_ATT0
#define REF_ATT0 0
#endif
#ifndef REF_ATT1
#define REF_ATT1 0
#endif
#ifndef PROBES
#define PROBES 0
#endif
#if PROBES
#define KV(x) (K->variant & (x))
#else
#define KV(x) 0
#endif
#ifndef PG_SP2
#define PG_SP2 true
#endif
#ifndef PG_ALIGN
#define PG_ALIGN true
#endif
#ifndef STAGGER_STEPS
#define STAGGER_STEPS 0
#endif
#define STAGGER() do { if (STAGGER_STEPS > 0) { const int n_ = (int)((blockIdx.x >> 3) & 15u); for (int i_ = 0; i_ < n_; ++i_) __builtin_amdgcn_s_sleep(STAGGER_STEPS); } } while (0)
constexpr int N_PHASES = 20;
__global__ void __launch_bounds__(NWAVES * 64, 2) fwd(Args a_unused) {
    extern __shared__ __attribute__((aligned(16))) unsigned char lds_raw[];
    LAS unsigned char* lds = (LAS unsigned char*)lds_raw;
    volatile LAS unsigned* MISC = (volatile LAS unsigned*)(lds + MISC_OFF);
    const int G = gridDim.x;
    if (threadIdx.x < 64) MISC[threadIdx.x] = 0u;
    __syncthreads();
    int lo, hi;
    XcdBarrier bar;
    { KArgsP K = kargs(); lo = K->ph_lo; hi = K->ph_hi; unsigned char* ws = K->ws;
      bar.bar = (unsigned*)(ws + WS_CTL) + CW_BAR; bar.x = 0; bar.st = nullptr;
      if (hi - lo > 1) bar = xcd_barrier_post((unsigned*)(ws + WS_CTL) + CW_BAR, MISC + 8); }
#define PH(k) (lo <= (k) && (k) < hi)
#ifndef SEAM_REPS
#define SEAM_REPS 1
#endif
#ifndef PROBE_WAIT_MASK
#define PROBE_WAIT_MASK 0xffffffffu
#endif
#ifdef PROBE_WAIT
#define SEAM(k) do { if (PH(k) && PH((k) + 1)) { unsigned long long t0_ = 0; if (threadIdx.x == 0) t0_ = __builtin_amdgcn_s_memrealtime(); xcd_barrier(bar); \
        if (threadIdx.x == 0 && ((PROBE_WAIT_MASK >> (k)) & 1u)) MISC[20] += (unsigned)(__builtin_amdgcn_s_memrealtime() - t0_); } } while (0)
#else
#define SEAM(k) do { if (PH(k) && PH((k) + 1)) { for (int r_ = 0; r_ < SEAM_REPS; ++r_) xcd_barrier(bar); } } while (0)
#endif
#define WSP(T, off) ((T*)(ws + (off)))

    if (PH(0)) { KArgsP K = kargs(); const int tid = otid(), lane = tid & 63, wave = __builtin_amdgcn_readfirstlane(tid >> 6); (void)lane; (void)wave; if (!KV(32)) phase_transposes(lds, K, G, wave, lane); __syncthreads(); if (!KV(64)) phase_norm0(lds, K, G, tid, wave, lane); __syncthreads(); }
    SEAM(0);
    for (int layer = 0; layer < 2; ++layer) {
        const int pb = 1 + 9 * layer;
        if (PH(pb + 0)) {
            KArgsP K = kargs(); const int tid = otid(), lane = tid & 63, wave = __builtin_amdgcn_readfirstlane(tid >> 6); (void)lane; (void)wave; unsigned char* ws = K->ws; const int NU = layer ? NU1 : NU0;
            const bf16* h16 = (const bf16*)((unsigned char*)K->out + OUT_H16);
            if (layer == 1) phase_ff(lds, K->in[11], K->in[10], h16, WSP(float, WS_ROWSS2), WSP(float, WS_FF), G, tid, wave, lane);
            pg8::Gemm g{h16, WSP(bf16, layer ? WS_WIN1 : WS_WIN0), MTOK, NU, DM, KV(4), 1, WTILED}; pg8::StaticOrder S; S.init(MTOK, NU, G, (int)blockIdx.x);
            int pm0 = -1; { pg8::Unit u0; if (S.next(0, u0)) pm0 = u0.pm; }
            LAS float* rtab = (LAS float*)(lds + 131072);
            if (pm0 >= 0 && tid < 256) { const f32x4* pp = (const f32x4*)(WSP(float, layer ? WS_ROWSS2 : WS_ROWSS) + (size_t)(pm0 * 256 + tid) * 32); float sq = 0.f;
#pragma unroll
                for (int q = 0; q < 8; ++q) { const f32x4 t = pp[q]; sq += (t[0] + t[1]) + (t[2] + t[3]); }
                rtab[tid] = __builtin_amdgcn_rsqf(sq * (1.0f / 2048.0f) + EPS); }
            __syncthreads();
            pg8::EpiScale<0, UTILED != 0> E{WSP(bf16, WS_U), NU, WSP(float, layer ? WS_ROWSS2 : WS_ROWSS), 0, rtab, pm0};
            STAGGER();
            pg8::gemm_phase<pg8::EpiScale<0, UTILED != 0>, pg8::StaticOrder, PG_ALIGN, PG_SP2>(lds, g, S, E);
        }
        SEAM(pb + 0);
        if (PH(pb + 1)) {
            KArgsP K = kargs(); const int tid = otid(), lane = tid & 63, wave = __builtin_amdgcn_readfirstlane(tid >> 6); (void)lane; (void)wave; unsigned char* ws = K->ws;
            if (layer == 0) {
#ifdef PROBE_KMEAN
                unsigned long long tk_ = 0; if (threadIdx.x == 0) tk_ = __builtin_amdgcn_s_memrealtime();
#endif
                phase_kmean(lds, WSP(bf16, WS_U), WSP(float, WS_KMEAN), G, tid);
#ifdef PROBE_KMEAN
                __syncthreads(); if (threadIdx.x == 0) MISC[20] += (unsigned)(__builtin_amdgcn_s_memrealtime() - tk_);
#endif
#if !REF_LIN0
                LinArgs L{WSP(bf16, WS_U), NU0, C0_GQ, C0_GK, C0_GV, C0_GG, WSP(float, WS_BCUM), nullptr, K->in[5], WSP(float, WS_P), WSP(float, WS_DSC), WSP(bf16, WS_S), WSP(bf16, WS_P), 0};
                for (int unit = blockIdx.x; unit < 256; unit += G) { const int sc = unit & 7; if (sc < 7) lin_unit<256, 8, false, false>(lds, tid, L, unit >> 5, (unit >> 3) & 3, sc); }
#endif
            } else {
#if !REF_LIN1
                LinArgs L{WSP(bf16, WS_U), NU1, C1_HQ, C1_HF, C1_HI, C1_HG, nullptr, K->in[18], K->in[13], WSP(float, WS_P), WSP(float, WS_DSC), WSP(bf16, WS_S), WSP(bf16, WS_P), 1024};
                for (int unit = blockIdx.x; unit < 256; unit += G) { const int sc = unit & 7; if (sc < 7) lin_unit<128, 4, true, false>(lds, tid, L, unit >> 5, 2 * ((unit >> 3) & 3), sc); }
#endif
            }
        }
        SEAM(pb + 1);
        if (PH(pb + 2)) {
            KArgsP K = kargs(); const int tid = otid(), lane = tid & 63, wave = __builtin_amdgcn_readfirstlane(tid >> 6); (void)lane; (void)wave; unsigned char* ws = K->ws; (void)ws;
#ifdef PROBE_BURN
            if (KV(16)) {
                const bf16x8 a0 = *(const bf16x8*)(WSP(bf16, WS_U) + (size_t)tid * 64), b0 = *(const bf16x8*)(WSP(bf16, WS_U) + (size_t)tid * 64 + 8);
                const bf16x8 a1 = *(const bf16x8*)(WSP(bf16, WS_U) + (size_t)tid * 64 + 16), b1 = *(const bf16x8*)(WSP(bf16, WS_U) + (size_t)tid * 64 + 24);
                f32x4 acc[16];
#pragma unroll
                for (int i = 0; i < 16; ++i) acc[i] = (f32x4){0.f, 0.f, 0.f, 0.f};
                for (int it = 0; it < 32768 / 16; ++it) {
#pragma unroll
                    for (int i = 0; i < 16; ++i) acc[i] = __builtin_amdgcn_mfma_f32_16x16x32_bf16((i & 1) ? a1 : a0, (i & 2) ? b1 : b0, acc[i], 0, 0, 0);
                }
                float sum = 0.f;
#pragma unroll
                for (int i = 0; i < 16; ++i) sum += acc[i][0] + acc[i][1] + acc[i][2] + acc[i][3];
                if (sum == 1.2345f) WSP(float, WS_CFOX)[tid] = sum;
            } else
#endif
            if (layer == 0) {
#if !REF_LIN0
                phase_scan<256>(WSP(float, WS_P), WSP(float, WS_DSC), WSP(bf16, WS_S), G, tid);
#endif
            } else {
#if !REF_LIN1
                phase_scan<128>(WSP(float, WS_P), WSP(float, WS_DSC), WSP(bf16, WS_S), G, tid);
#endif
#if REF_ATT1
                ref_cfox(WSP(float, WS_FF), K->in[12], WSP(float, WS_CFOX), G, tid);
#endif
            }
        }
        SEAM(pb + 2);
        if (PH(pb + 3)) {
            KArgsP K = kargs(); const int tid = otid(), lane = tid & 63, wave = __builtin_amdgcn_readfirstlane(tid >> 6); (void)lane; (void)wave; unsigned char* ws = K->ws;
            const int variant = KV(0xff);
            if (variant & 1) {} else
            if (layer == 0) {
#if REF_LIN0
                ref_lin<256, false>(lds, tid, G, WSP(bf16, WS_U), NU0, C0_GQ, C0_GK, C0_GV, C0_GG, WSP(float, WS_GLR), K->in[3], K->in[4], nullptr, K->in[5], WSP(bf16, WS_P), 0);
#else
                { LinArgs L{WSP(bf16, WS_U), NU0, C0_GQ, C0_GK, C0_GV, C0_GG, WSP(float, WS_BCUM), nullptr, K->in[5], WSP(float, WS_P), WSP(float, WS_DSC), WSP(bf16, WS_S), WSP(bf16, WS_P), 0};
#ifdef PROBE_LINB
                  unsigned long long tl_ = 0; if (PROBE_LINB == 0 && threadIdx.x == 0) tl_ = __builtin_amdgcn_s_memrealtime();
#endif
                  for (int unit = blockIdx.x; unit < 256; unit += G) lin_unit<256, 8, false, true>(lds, tid, L, unit >> 5, (unit >> 3) & 3, unit & 7);
#ifdef PROBE_LINB
                if (PROBE_LINB == 0 && threadIdx.x == 0) MISC[20] += (unsigned)(__builtin_amdgcn_s_memrealtime() - tl_);
#endif
                }
#endif
#if REF_ATT0
                ref_att(lds, tid, G, 0, WSP(bf16, WS_U), NU0, C0_MQ, C0_MK, C0_MV, WSP(bf16, WS_P), 1024, WSP(float, WS_KMEAN), nullptr);
#endif
            } else {
#if REF_LIN1
                ref_lin<128, true>(lds, tid, G, WSP(bf16, WS_U), NU1, C1_HQ, C1_HF, C1_HI, C1_HG, nullptr, nullptr, nullptr, K->in[18], K->in[13], WSP(bf16, WS_P), 1024);
#else
                { LinArgs L{WSP(bf16, WS_U), NU1, C1_HQ, C1_HF, C1_HI, C1_HG, nullptr, K->in[18], K->in[13], WSP(float, WS_P), WSP(float, WS_DSC), WSP(bf16, WS_S), WSP(bf16, WS_P), 1024};
#ifdef PROBE_LINB
                  unsigned long long tl_ = 0; if (PROBE_LINB == 1 && threadIdx.x == 0) tl_ = __builtin_amdgcn_s_memrealtime();
#endif
                  for (int unit = blockIdx.x; unit < 256; unit += G) lin_unit<128, 4, true, true>(lds, tid, L, unit >> 5, 2 * ((unit >> 3) & 3), unit & 7);
#ifdef PROBE_LINB
                if (PROBE_LINB == 1 && threadIdx.x == 0) MISC[20] += (unsigned)(__builtin_amdgcn_s_memrealtime() - tl_);
#endif
                }
#endif
#if REF_ATT1
                ref_att(lds, tid, G, 1, WSP(bf16, WS_U), NU1, C1_FQ, C1_FK, C1_FV, WSP(bf16, WS_P), 0, nullptr, WSP(float, WS_CFOX));
#endif
            }
            if (!(variant & 2) && ((layer == 0 && !REF_ATT0) || (layer == 1 && !REF_ATT1))) {
                const int pitch = layer ? NU1 : NU0, qoff = layer ? C1_FQ : C0_MQ, koff = layer ? C1_FK : C0_MK, voff = layer ? C1_FV : C0_MV, mixoff = layer ? 0 : 1024;
                for (int item = blockIdx.x; item < 256; item += G) att::pair_item((char*)lds_raw, item, layer, WSP(bf16, WS_U), pitch, qoff, koff, voff, WSP(bf16, WS_P), mixoff, WSP(float, WS_KMEAN), WSP(float, WS_FF), K->in[12]);
            }
        }
        SEAM(pb + 3);
        if (PH(pb + 4)) {
            KArgsP K = kargs(); const int tid = otid(), lane = tid & 63, wave = __builtin_amdgcn_readfirstlane(tid >> 6); (void)lane; (void)wave; unsigned char* ws = K->ws;
            pg8::Gemm g{WSP(bf16, WS_P), WSP(bf16, layer ? WS_WOUT1 : WS_WOUT0), MTOK, DM, DM, 0, 0, WTILED}; pg8::StaticOrder S; S.init(MTOK, DM, G, (int)blockIdx.x);
            bf16* h16 = (bf16*)((unsigned char*)K->out + OUT_H16);
            if (layer == 0) { pg8::EpiResid<true, false> E{K->in[0], h16, WSP(float, WS_ROWSS), 0, nullptr}; pg8::gemm_phase<pg8::EpiResid<true, false>, pg8::StaticOrder, PG_ALIGN, PG_SP2>(lds, g, S, E); }
            else { pg8::EpiResid<false, false> E{h16, h16, WSP(float, WS_ROWSS), 0, nullptr}; pg8::gemm_phase<pg8::EpiResid<false, false>, pg8::StaticOrder, PG_ALIGN, PG_SP2>(lds, g, S, E); }
        }
        SEAM(pb + 4);
        for (int half = 0; half < MLP_SPLIT; ++half) {
            if (PH(pb + 5 + 2 * half)) {
                KArgsP K = kargs(); const int tid = otid(), lane = tid & 63, wave = __builtin_amdgcn_readfirstlane(tid >> 6); (void)lane; (void)wave; unsigned char* ws = K->ws;
                pg8::Gemm g{(const bf16*)((unsigned char*)K->out + OUT_H16) + (size_t)half * MHALF * DM, WSP(bf16, layer ? WS_WUP1 : WS_WUP0), MHALF, DFF, DM, KV(4), 1, WTILED}; pg8::StaticOrder S; S.init(MHALF, DFF, G, (int)blockIdx.x);
                pg8::EpiSqRelu E{WSP(bf16, WS_HID + (size_t)half * HID_STRIDE), DFF};
                STAGGER();
#ifdef PROBE_EPINULL
                if (KV(8)) { pg8::EpiSqReluNS E0{WSP(bf16, WS_HID), DFF}; pg8::gemm_phase<pg8::EpiSqReluNS, pg8::StaticOrder, PG_ALIGN, PG_SP2>(lds, g, S, E0); } else
#endif
                pg8::gemm_phase<pg8::EpiSqRelu, pg8::StaticOrder, PG_ALIGN, PG_SP2>(lds, g, S, E);
            }
            SEAM(pb + 5 + 2 * half);
            if (PH(pb + 6 + 2 * half)) {
                KArgsP K = kargs(); const int tid = otid(), lane = tid & 63, wave = __builtin_amdgcn_readfirstlane(tid >> 6); (void)lane; (void)wave; unsigned char* ws = K->ws;
                pg8::Gemm g{WSP(bf16, WS_HID + (size_t)half * HID_STRIDE), WSP(bf16, layer ? WS_WDN1 : WS_WDN0), MHALF, DM, DFF, 0, 1, WTILED}; pg8::StaticOrder S; S.init(MHALF, DM, G, (int)blockIdx.x);
                bf16* h16 = (bf16*)((unsigned char*)K->out + OUT_H16);
                pg8::EpiResid<false, true> E{h16, layer ? WSP(bf16, WS_HFIN) : h16, WSP(float, WS_ROWSS2), half * MHALF, WSP(float, WS_ROWSS)};
                pg8::gemm_phase<pg8::EpiResid<false, true>, pg8::StaticOrder, PG_ALIGN, PG_SP2>(lds, g, S, E);
            }
            if (!HID_DB || half == MLP_SPLIT - 1) SEAM(pb + 6 + 2 * half);
        }
    }
#ifdef PROBE_WAIT
    float probe_scale = 1.f;
    if (PH(19)) { KArgsP K = kargs(); unsigned* acc = (unsigned*)(K->ws + WS_CTL) + 64;
        if (threadIdx.x == 0) atomicAdd(acc, MISC[20]);
        xcd_barrier(bar);
        const unsigned tot = __hip_atomic_load(acc, __ATOMIC_RELAXED, __HIP_MEMORY_SCOPE_AGENT);
        const float avg_us = (float)tot * 0.01f / (float)G;
        probe_scale = 1.f + sqrtf(avg_us * PROBE_WAIT_UNIT); }
#endif
    if (PH(19)) { KArgsP K = kargs(); const int tid = otid(), lane = tid & 63, wave = __builtin_amdgcn_readfirstlane(tid >> 6); (void)lane; (void)wave; unsigned char* ws = K->ws; phase_final_norm(WSP(bf16, WS_HFIN), K->out, K->in[19], WSP(float, WS_ROWSS2), G, wave, lane
#ifdef PROBE_WAIT
        , probe_scale
#endif
        ); }
#undef PH
#undef SEAM
#undef WSP
}

extern "C" void kernel_launch(void* const* d_in, const int* in_sizes, int n_in, void* d_out, int out_size, void* d_ws, size_t ws_size, hipStream_t stream) {
    static int grid = 0;
    if (grid == 0) {
        if (n_in != 20 || in_sizes[0] != MTOK * DM || out_size != MTOK * DM || ws_size < WS_END) {
            fprintf(stderr, "kernel_launch: unexpected problem (n_in %d, in0 %d, out %d, ws %zu; need ws >= %zu); nothing launched\n", n_in, n_in > 0 ? in_sizes[0] : -1, out_size, ws_size, (size_t)WS_END); grid = -1; return; }
        int dev = 0, cus = 0, per_cu = 0;
        if (hipGetDevice(&dev) != hipSuccess || hipDeviceGetAttribute(&cus, hipDeviceAttributeMultiprocessorCount, dev) != hipSuccess) { fprintf(stderr, "kernel_launch: device query failed\n"); grid = -1; return; }
        if (hipFuncSetAttribute((const void*)fwd, hipFuncAttributeMaxDynamicSharedMemorySize, LDS_BYTES) != hipSuccess) { fprintf(stderr, "kernel_launch: hipFuncSetAttribute failed\n"); grid = -1; return; }
        if (hipOccupancyMaxActiveBlocksPerMultiprocessor(&per_cu, (const void*)fwd, NWAVES * 64, LDS_BYTES) != hipSuccess || per_cu < 1)
            fprintf(stderr, "kernel_launch: note: occupancy query reports %d workgroups per CU\n", per_cu);
        (void)hipGetLastError();
        grid = cus;
    }
    if (grid < 0) return;
    if (hipMemsetAsync((char*)d_ws + WS_CTL, 0, CTL_ZERO_BYTES, stream) != hipSuccess) { fprintf(stderr, "kernel_launch: memset failed\n"); return; }
    Args a{};
    for (int i = 0; i < 20; ++i) a.in[i] = (const float*)d_in[i];
    a.out = (float*)d_out; a.ws = (unsigned char*)d_ws;
#if ONE_LAUNCH
    a.ph_lo = 0; a.ph_hi = N_PHASES;
    hipLaunchKernelGGL(fwd, dim3(grid), dim3(NWAVES * 64), LDS_BYTES, stream, a);
#else
#ifndef REPEAT_MASK
#define REPEAT_MASK 0u
#endif
#ifndef REPEAT_VARIANT
#define REPEAT_VARIANT 0
#endif
    for (int p = 0; p < N_PHASES; ++p) { a.ph_lo = p; a.ph_hi = p + 1;
        if ((REPEAT_MASK >> p) & 1u) { a.variant = REPEAT_VARIANT; hipLaunchKernelGGL(fwd, dim3(grid), dim3(NWAVES * 64), LDS_BYTES, stream, a); a.variant = 0; }
        hipLaunchKernelGGL(fwd, dim3(grid), dim3(NWAVES * 64), LDS_BYTES, stream, a); }
#endif
    const hipError_t le = hipPeekAtLastError();
    if (le != hipSuccess) fprintf(stderr, "kernel_launch: launch failed: %s\n", hipGetErrorName(le));
}
```

```cpp
#include <hip/hip_runtime.h>
#include <cstdio>
#include <cstdint>
#include <cmath>
__device__ __forceinline__ int otid() { int t = threadIdx.x; asm volatile("" : "+v"(t)); return t; }
#define ONE_LAUNCH 1
namespace pg8 {
#define PG8_LAS __attribute__((address_space(3)))
typedef unsigned short bf16_t;
typedef short bf16x8 __attribute__((ext_vector_type(8)));
typedef float f32x4 __attribute__((ext_vector_type(4)));
typedef unsigned u32x4 __attribute__((ext_vector_type(4)));
constexpr int BM = 256, BK = 64, HALF = 128, HTB = HALF * BK * 2  , STAGE_BYTES = 8 * HTB, NXCD = 8, WGM = 8;

__host__ __device__ __forceinline__ int lds_byte(int r, int c) { const int st = (r >> 4) * 2 + (c >> 5), rr = r & 15, cc = c & 31, ob = rr * 64 + cc * 2; return st * 1024 + (ob ^ (((ob >> 9) & 1) << 5)); }
__host__ __device__ __forceinline__ void stage_rc(int b, int& R, int& C) { const int st = b / 1024, sb = b % 1024, swz = sb ^ (((sb >> 9) & 1) << 5); R = (st >> 1) * 16 + swz / 64; C = (st & 1) * 32 + (swz % 64) / 2; }
__host__ __device__ __forceinline__ int perm32(int rho) { const int n = rho >> 4, i = rho & 15; return 8 * (i >> 2) + 4 * n + (i & 3); }

struct Unit { int pm, pn; };
struct Gemm { const bf16_t* A; const bf16_t* Bt; int M, N, K; int sp; int atile; int btile; };

struct StaticOrder {
    int nM, nN, nwg, G, c;
    __host__ __device__ void init(int M, int N, int G_, int c_) { nM = M / BM; nN = N / BM; nwg = nM * nN; G = G_; c = c_; }
    __host__ __device__ __forceinline__ bool next(int i, Unit& u) const {
        const long L = (long)i * G + c; if (L >= nwg) return false;
        int wgid = (int)L; { const int q = nwg / NXCD, r = nwg % NXCD, xcd = wgid % NXCD, off = wgid / NXCD; wgid = (xcd < r ? xcd * (q + 1) : r * (q + 1) + (xcd - r) * q) + off; }
        const int nig = WGM * nN, gid = wgid / nig, fm = gid * WGM, gsz = (nM - fm) < WGM ? (nM - fm) : WGM;
        u.pm = fm + ((wgid % nig) % gsz); u.pn = (wgid % nig) / gsz; return true;
    }
    __device__ __forceinline__ void a_ready(const Unit&) const {}
    __device__ __forceinline__ void done(const Unit&) const {}
};
__device__ __forceinline__ unsigned cvt_pk_bf16(float lo, float hi) { unsigned r; asm volatile("v_cvt_pk_bf16_f32 %0, %1, %2" : "=v"(r) : "v"(lo), "v"(hi)); return r; }
#ifndef PG_EPIWAIT
#define PG_EPIWAIT 0
#endif
#define EPI_FENCE() asm volatile("" ::: "memory")
__host__ __device__ __forceinline__ unsigned atile_off(int R, int C) { return (unsigned)(((((R >> 6) * 2 + (C >> 5)) * 4 + ((R >> 4) & 3)) * 1024) + (((R & 15) * 4 + ((C >> 3) & 3)) * 16) + (C & 7) * 2); }
constexpr float RMS_EPS = 1e-6f;
template <int ACT, bool TILED> struct EpiScale {
    static constexpr bool PERM = true, AFTER_DRAIN = false; static constexpr int NVM = 16;
    bf16_t* O; int ldc; const float* rowss; int row_base;
    const PG8_LAS float* tab; int tab_pm;
    __device__ __forceinline__ void operator()(const f32x4 (&acc)[2][2][4][2], const Unit& u, int wr, int wc, int fr, int fq) const {
        const int lrow0 = u.pm * BM + wr * 64 + fr; const int col0 = u.pn * BM + wc * 32 + 8 * fq;
        float rsv[2][4];
        if (u.pm == tab_pm) {
#pragma unroll
            for (int ai = 0; ai < 2; ++ai)
#pragma unroll
                for (int m = 0; m < 4; ++m) rsv[ai][m] = tab[wr * 64 + fr + ai * HALF + m * 16];
        } else {
#pragma unroll
            for (int ai = 0; ai < 2; ++ai)
#pragma unroll
                for (int m = 0; m < 4; ++m) { const f32x4* pp = (const f32x4*)(rowss + (size_t)(row_base + lrow0 + ai * HALF + m * 16) * 32 + 8 * fq); const f32x4 t0 = pp[0], t1 = pp[1];
                    float s = ((t0[0] + t0[1]) + (t0[2] + t0[3])) + ((t1[0] + t1[1]) + (t1[2] + t1[3]));
                    s += __shfl_xor(s, 16); s += __shfl_xor(s, 32); rsv[ai][m] = __builtin_amdgcn_rsqf(s * (1.0f / 2048.0f) + RMS_EPS); EPI_FENCE(); }
        }
#pragma unroll
        for (int ai = 0; ai < 2; ++ai)
#pragma unroll
            for (int m = 0; m < 4; ++m) { const int lrow = lrow0 + ai * HALF + m * 16;
                const float rs = rsv[ai][m];
                bf16_t* rowp = O + (size_t)lrow * ldc + col0;
#pragma unroll
                for (int bj = 0; bj < 2; ++bj) { f32x4 v0 = acc[ai][bj][m][0] * rs, v1 = acc[ai][bj][m][1] * rs;
                    if (ACT == 1) {
#pragma unroll
                        for (int e = 0; e < 4; ++e) { const float a = fmaxf(v0[e], 0.f), b = fmaxf(v1[e], 0.f); v0[e] = a * a; v1[e] = b * b; } }
                    u32x4 w; w.x = cvt_pk_bf16(v0[0], v0[1]); w.y = cvt_pk_bf16(v0[2], v0[3]); w.z = cvt_pk_bf16(v1[0], v1[1]); w.w = cvt_pk_bf16(v1[2], v1[3]);
                    if (TILED) *(u32x4*)((unsigned char*)O + ((size_t)(u.pm * 2 + ai) * (ldc >> 6) + (u.pn * 4 + bj * 2 + (wc >> 1))) * 16384 + ((wr * 2 + (wc & 1)) * 4 + m) * 1024 + (fr * 4 + fq) * 16) = w;
                    else *(u32x4*)(rowp + bj * HALF) = w; } }
    }
};
struct EpiSqRelu {
    static constexpr bool PERM = true, AFTER_DRAIN = false; static constexpr int NVM = 16;
    bf16_t* O; int ldc;
    __device__ __forceinline__ void operator()(const f32x4 (&acc)[2][2][4][2], const Unit& u, int wr, int wc, int fr, int fq) const {
        const int ktn = ldc >> 6;
#pragma unroll
        for (int ai = 0; ai < 2; ++ai)
#pragma unroll
            for (int bj = 0; bj < 2; ++bj) { unsigned char* tile = (unsigned char*)O + ((size_t)(u.pm * 2 + ai) * ktn + (u.pn * 4 + bj * 2 + (wc >> 1))) * 16384 + ((wr * 2 + (wc & 1)) * 4) * 1024 + (fr * 4 + fq) * 16;
#pragma unroll
                for (int m = 0; m < 4; ++m) { f32x4 v0 = acc[ai][bj][m][0], v1 = acc[ai][bj][m][1];
#pragma unroll
                    for (int e = 0; e < 4; ++e) { float a, b; asm("v_max_f32_e32 %0, 0, %1" : "=v"(a) : "v"(v0[e])); asm("v_max_f32_e32 %0, 0, %1" : "=v"(b) : "v"(v1[e])); v0[e] = a * a; v1[e] = b * b; }
                    u32x4 w; w.x = cvt_pk_bf16(v0[0], v0[1]); w.y = cvt_pk_bf16(v0[2], v0[3]); w.z = cvt_pk_bf16(v1[0], v1[1]); w.w = cvt_pk_bf16(v1[2], v1[3]);
                    *(u32x4*)(tile + m * 1024) = w; } }
    }
};
struct EpiSqReluNS {
    static constexpr bool PERM = true, AFTER_DRAIN = false; static constexpr int NVM = 0;
    bf16_t* O; int ldc;
    __device__ __forceinline__ void operator()(const f32x4 (&acc)[2][2][4][2], const Unit& u, int wr, int wc, int fr, int fq) const {
        const int lrow0 = u.pm * BM + wr * 64 + fr; const int col0 = u.pn * BM + wc * 32 + 8 * fq;
#pragma unroll
        for (int ai = 0; ai < 2; ++ai)
#pragma unroll
            for (int m = 0; m < 4; ++m) { bf16_t* rowp = O + (size_t)(lrow0 + ai * HALF + m * 16) * ldc + col0;
#pragma unroll
                for (int bj = 0; bj < 2; ++bj) { f32x4 v0 = acc[ai][bj][m][0], v1 = acc[ai][bj][m][1];
#pragma unroll
                    for (int e = 0; e < 4; ++e) { float a, b; asm("v_max_f32_e32 %0, 0, %1" : "=v"(a) : "v"(v0[e])); asm("v_max_f32_e32 %0, 0, %1" : "=v"(b) : "v"(v1[e])); v0[e] = a * a; v1[e] = b * b; }
                    u32x4 w; w.x = cvt_pk_bf16(v0[0], v0[1]); w.y = cvt_pk_bf16(v0[2], v0[3]); w.z = cvt_pk_bf16(v1[0], v1[1]); w.w = cvt_pk_bf16(v1[2], v1[3]);
                    *(u32x4*)(O + (((size_t)(u.pm * 32 + u.pn) * 8 + (wr * 4 + wc)) * 16 + (ai * 8 + m * 2 + bj)) * 512 + (fq * 16 + fr) * 8) = w;     } }
    }
};
template <bool F32IN, bool RS2> struct EpiResid {
    static constexpr bool PERM = true, AFTER_DRAIN = false; static constexpr int NVM = 16;
    const void* hin; bf16_t* hout; float* rowss; int row_base; const float* rowss_in;
    __device__ __forceinline__ void operator()(const f32x4 (&acc)[2][2][4][2], const Unit& u, int wr, int wc, int fr, int fq) const {
        const int row0 = row_base + u.pm * BM + wr * 64 + fr; const int col0 = u.pn * BM + wc * 32 + 8 * fq;
        const size_t tb0 = ((size_t)((row_base >> 7) + u.pm * 2) * 32 + (u.pn * 4 + (wc >> 1))) * 16384 + ((wr * 2 + (wc & 1)) * 4) * 1024 + (fr * 4 + fq) * 16;
#define EPI_TOFF(ai_, m_, bj_) (tb0 + ((size_t)(ai_) * 32 + (bj_) * 2) * 16384 + (m_) * 1024)
        float rs2[2][4];
        if (RS2) { f32x4 pr[2][4][2];
#pragma unroll
            for (int ai = 0; ai < 2; ++ai)
#pragma unroll
                for (int m = 0; m < 4; ++m) { const f32x4* pp = (const f32x4*)(rowss_in + (size_t)(row0 + ai * HALF + m * 16) * 32 + 8 * fq); pr[ai][m][0] = pp[0]; pr[ai][m][1] = pp[1]; }
            EPI_FENCE();
#pragma unroll
            for (int ai = 0; ai < 2; ++ai)
#pragma unroll
                for (int m = 0; m < 4; ++m) { const f32x4 t0 = pr[ai][m][0], t1 = pr[ai][m][1]; float sq = ((t0[0] + t0[1]) + (t0[2] + t0[3])) + ((t1[0] + t1[1]) + (t1[2] + t1[3]));
                    sq += __shfl_xor(sq, 16); sq += __shfl_xor(sq, 32); rs2[ai][m] = __builtin_amdgcn_rcpf(sq * (1.0f / 2048.0f) + RMS_EPS); }
        }
        f32x4 hb[2][2][2][2];
#define EPI_LOAD(buf, k) do { _Pragma("unroll") for (int q_ = 0; q_ < 2; ++q_) { const int ai_ = (k) >> 1, m_ = 2 * ((k) & 1) + q_;                                                                          \
            _Pragma("unroll") for (int bj = 0; bj < 2; ++bj) {                                                                                                                                                  \
                if (F32IN) { const float* p_ = (const float*)hin + (size_t)(row0 + ai_ * HALF + m_ * 16) * 2048 + col0 + bj * HALF; hb[buf][q_][bj][0] = *(const f32x4*)p_; hb[buf][q_][bj][1] = *(const f32x4*)(p_ + 4); } \
                else { const u32x4 t_ = *(const u32x4*)((const unsigned char*)hin + EPI_TOFF(ai_, m_, bj));                                                                                                   \
                       hb[buf][q_][bj][0] = (f32x4){__uint_as_float(t_.x << 16), __uint_as_float(t_.x & 0xffff0000u), __uint_as_float(t_.y << 16), __uint_as_float(t_.y & 0xffff0000u)};                         \
                       hb[buf][q_][bj][1] = (f32x4){__uint_as_float(t_.z << 16), __uint_as_float(t_.z & 0xffff0000u), __uint_as_float(t_.w << 16), __uint_as_float(t_.w & 0xffff0000u)}; } } } } while (0)
        EPI_LOAD(0, 0); EPI_FENCE();
#pragma unroll
        for (int k = 0; k < 4; ++k) {
            if (k < 3) { if (k & 1) EPI_LOAD(0, k + 1); else EPI_LOAD(1, k + 1); }
            EPI_FENCE();
#pragma unroll
            for (int q = 0; q < 2; ++q) { const int ai = k >> 1, m = 2 * (k & 1) + q; const int row = row0 + ai * HALF + m * 16; float ss = 0.f;
#pragma unroll
                for (int bj = 0; bj < 2; ++bj) {
                    const f32x4 v0 = (RS2 ? acc[ai][bj][m][0] * rs2[ai][m] : acc[ai][bj][m][0]) + hb[k & 1][q][bj][0], v1 = (RS2 ? acc[ai][bj][m][1] * rs2[ai][m] : acc[ai][bj][m][1]) + hb[k & 1][q][bj][1];
                    u32x4 p; p.x = cvt_pk_bf16(v0[0], v0[1]); p.y = cvt_pk_bf16(v0[2], v0[3]); p.z = cvt_pk_bf16(v1[0], v1[1]); p.w = cvt_pk_bf16(v1[2], v1[3]);
                    *(u32x4*)((unsigned char*)hout + EPI_TOFF(ai, m, bj)) = p;
                    const float r0 = __uint_as_float(p.x << 16), r1 = __uint_as_float(p.x & 0xffff0000u), r2 = __uint_as_float(p.y << 16), r3 = __uint_as_float(p.y & 0xffff0000u);
                    const float r4 = __uint_as_float(p.z << 16), r5 = __uint_as_float(p.z & 0xffff0000u), r6 = __uint_as_float(p.w << 16), r7 = __uint_as_float(p.w & 0xffff0000u);
                    ss += ((r0 * r0 + r1 * r1) + (r2 * r2 + r3 * r3)) + ((r4 * r4 + r5 * r5) + (r6 * r6 + r7 * r7)); }
                ss += __shfl_xor(ss, 16); ss += __shfl_xor(ss, 32);
                if (fq == 0) rowss[(size_t)row * 32 + u.pn * 4 + wc] = ss; }
            EPI_FENCE();
        }
#undef EPI_LOAD
#undef EPI_TOFF
    }
};
struct EpiNull {
    static constexpr bool PERM = true, AFTER_DRAIN = false; static constexpr int NVM = 0;
    __device__ __forceinline__ void operator()(const f32x4 (&acc)[2][2][4][2], const Unit&, int, int, int, int) const {
#pragma unroll
        for (int ai = 0; ai < 2; ++ai)
#pragma unroll
            for (int bj = 0; bj < 2; ++bj)
#pragma unroll
                for (int m = 0; m < 4; ++m)
#pragma unroll
                    for (int n = 0; n < 2; ++n) asm volatile("" :: "v"(acc[ai][bj][m][n]));
    }
};
template <class Epi, class Sched, bool ALIGN_EPI = false, bool SP2 = false>
__device__ __forceinline__ void gemm_phase(PG8_LAS unsigned char* lds, const Gemm g, const Sched& S, const Epi& E) {
    const int tid = otid(), wid = __builtin_amdgcn_readfirstlane(tid >> 6), lane = tid & 63, wr = wid >> 2, wc = wid & 3, fr = lane & 15, fq = lane >> 4;
    const int K = g.K, nt = K / BK;
    unsigned voffA[2], voffB[2];
#pragma unroll
    for (int i = 0; i < 2; ++i) { int R, C; stage_rc(tid * 16 + i * 8192, R, C); const int Rb = Epi::PERM ? ((R & ~31) + perm32(R & 31)) : R;
        voffA[i] = g.atile ? atile_off(R, C) : (unsigned)(R * K + C) * 2u; voffB[i] = g.btile ? atile_off(Rb, C) : (unsigned)(Rb * K + C) * 2u; }
    const size_t kstepB = g.btile ? (size_t)16384 : (size_t)(BK * 2), kstepA = g.atile ? (size_t)16384 : (size_t)(BK * 2);
    const size_t hstepB = (size_t)HALF * K * 2, hstepA = hstepB;
    const size_t tstepB = 2 * hstepB, tstepA = 2 * hstepA;
    const unsigned ldsw = (unsigned)wid * 1024u;
    const int aoff = lds_byte(wr * 64 + fr, fq * 8), boff = lds_byte(wc * 32 + fr, fq * 8);
#define PG8_SA(b, h) (((b) * 2 + (h)) * HTB)
#define PG8_SB(b, h) ((4 + (b) * 2 + (h)) * HTB)
#define PG8_STAGE(bufoff, gbase, voff) do { _Pragma("unroll") for (int _i = 0; _i < 2; ++_i) \
        __builtin_amdgcn_global_load_lds((const unsigned*)((const char*)(gbase) + (voff)[_i]), (PG8_LAS unsigned*)(lds + (bufoff) + ldsw + _i * 8192), 16, 0, 0); } while (0)
#define PG8_LDA(dst, b, h) do { _Pragma("unroll") for (int m = 0; m < 4; ++m) _Pragma("unroll") for (int k = 0; k < 2; ++k) dst[m][k] = *(const PG8_LAS bf16x8*)(lds + PG8_SA(b, h) + aoff + m * 2048 + k * 1024); } while (0)
#define PG8_LDB(dst, b, h) do { _Pragma("unroll") for (int n = 0; n < 2; ++n) _Pragma("unroll") for (int k = 0; k < 2; ++k) dst[n][k] = *(const PG8_LAS bf16x8*)(lds + PG8_SB(b, h) + boff + n * 2048 + k * 1024); } while (0)
#define PG8_MMA(ai, bj, At, Bt) do { __builtin_amdgcn_s_setprio(1); _Pragma("unroll") for (int m = 0; m < 4; ++m) _Pragma("unroll") for (int n = 0; n < 2; ++n) _Pragma("unroll") for (int k = 0; k < 2; ++k) \
        acc[ai][bj][m][n] = __builtin_amdgcn_mfma_f32_16x16x32_bf16(Bt[n][k], At[m][k], acc[ai][bj][m][n], 0, 0, 0); __builtin_amdgcn_s_setprio(0); } while (0)
#define PG8_WAIT_V(n) asm volatile("s_waitcnt vmcnt(" #n ")" ::: "memory")
#define PG8_WAIT_VE do { if (PG_EPIWAIT && Epi::NVM >= 16) asm volatile("s_cmp_eq_u32 %0, 0\n\ts_cbranch_scc1 .LPG8A%=\n\ts_waitcnt vmcnt(24)\n\ts_branch .LPG8B%=\n.LPG8A%=:\n\ts_waitcnt vmcnt(8)\n.LPG8B%=:" :: "s"(epi_first) : "memory", "scc"); else PG8_WAIT_V(8); } while (0)
#define PG8_WAIT_L(n) asm volatile("s_waitcnt lgkmcnt(" #n ")" ::: "memory")
#define PG8_BAR __builtin_amdgcn_s_barrier()
#define PG8_SCHED __builtin_amdgcn_sched_barrier(0)
    Unit cur, nxt; int ui = 0;
    if (!S.next(0, cur)) return;
    f32x4 acc[2][2][4][2];
#pragma unroll
    for (int a = 0; a < 2; ++a)
#pragma unroll
        for (int b = 0; b < 2; ++b)
#pragma unroll
            for (int m = 0; m < 4; ++m)
#pragma unroll
                for (int n = 0; n < 2; ++n) acc[a][b][m][n] = (f32x4){0.f, 0.f, 0.f, 0.f};
    bf16x8 At[4][2], B0[2][2], B1[2][2];
    const char* cA = (const char*)g.A + (size_t)(g.sp ? 0 : cur.pm) * tstepA; const char* cB = (const char*)g.Bt + (size_t)(g.sp ? 0 : cur.pn) * tstepB;
    S.a_ready(cur);
    if constexpr (SP2) {
        PG8_STAGE(PG8_SB(0, 0), cB, voffB); PG8_STAGE(PG8_SB(0, 1), cB + hstepB, voffB); PG8_STAGE(PG8_SA(0, 0), cA, voffA); PG8_STAGE(PG8_SA(0, 1), cA + hstepA, voffA);
        if (wr == 1) PG8_BAR;
        PG8_WAIT_V(2); PG8_BAR;
        PG8_STAGE(PG8_SB(1, 0), cB + kstepB, voffB); PG8_STAGE(PG8_SA(1, 0), cA + kstepA, voffA); PG8_STAGE(PG8_SB(1, 1), cB + hstepB + kstepB, voffB);
        PG8_WAIT_V(6); PG8_BAR;
    } else {
        PG8_STAGE(PG8_SB(0, 0), cB, voffB); PG8_STAGE(PG8_SA(0, 0), cA, voffA); PG8_STAGE(PG8_SB(0, 1), cB + hstepB, voffB); PG8_STAGE(PG8_SA(0, 1), cA + hstepA, voffA);
        if (wr == 1) PG8_BAR;
        PG8_WAIT_V(4); PG8_BAR;
        PG8_STAGE(PG8_SB(1, 0), cB + kstepB, voffB); PG8_STAGE(PG8_SA(1, 0), cA + kstepA, voffA); PG8_STAGE(PG8_SB(1, 1), cB + hstepB + kstepB, voffB);
        PG8_WAIT_V(6); PG8_BAR;
    }
    for (;;) {
        const bool has_next = S.next(ui + 1, nxt);
        const char* nA = has_next ? (const char*)g.A + (size_t)(g.sp ? 0 : nxt.pm) * tstepA : cA; const char* nB = has_next ? (const char*)g.Bt + (size_t)(g.sp ? 0 : nxt.pn) * tstepB : cB;
        for (int t = 0; t < nt; t += 2) {
            const bool last = (t == nt - 2);
            const int epi_first = __builtin_amdgcn_readfirstlane((t == 0 && ui > 0) ? 1 : 0);
            const char* a1 = cA + (size_t)(t + 1) * kstepA;
            const char* a2 = last ? nA : cA + (size_t)(t + 2) * kstepA; const char* b2 = last ? nB : cB + (size_t)(t + 2) * kstepB;
            const char* a3 = a2 + kstepA; const char* b3 = b2 + kstepB;
            if (last && has_next) S.a_ready(nxt);
            if constexpr (SP2) {
            PG8_LDB(B0, 0, 0); PG8_LDB(B1, 0, 1); PG8_SCHED; PG8_LDA(At, 0, 0); PG8_STAGE(PG8_SA(1, 1), a1 + hstepA, voffA);
            PG8_WAIT_VE; PG8_WAIT_L(0); PG8_BAR; PG8_MMA(0, 0, At, B0); PG8_MMA(0, 1, At, B1); PG8_BAR; PG8_SCHED;
            PG8_LDA(At, 0, 1); PG8_STAGE(PG8_SB(0, 0), b2, voffB); PG8_STAGE(PG8_SB(0, 1), b2 + hstepB, voffB); PG8_STAGE(PG8_SA(0, 0), a2, voffA);
            PG8_WAIT_VE; PG8_WAIT_L(0); PG8_BAR; PG8_MMA(1, 0, At, B0); PG8_MMA(1, 1, At, B1); PG8_BAR; PG8_SCHED;
            PG8_LDB(B0, 1, 0); PG8_LDB(B1, 1, 1); PG8_SCHED; PG8_LDA(At, 1, 0); PG8_STAGE(PG8_SA(0, 1), a2 + hstepA, voffA);
            PG8_WAIT_V(8); PG8_WAIT_L(0); PG8_BAR; PG8_MMA(0, 0, At, B0); PG8_MMA(0, 1, At, B1); PG8_BAR; PG8_SCHED;
            PG8_LDA(At, 1, 1); PG8_STAGE(PG8_SB(1, 0), b3, voffB); PG8_STAGE(PG8_SB(1, 1), b3 + hstepB, voffB); PG8_STAGE(PG8_SA(1, 0), a3, voffA);
            PG8_WAIT_V(8); PG8_WAIT_L(0); PG8_BAR; PG8_MMA(1, 0, At, B0); PG8_MMA(1, 1, At, B1); PG8_BAR; PG8_SCHED;
            } else {
            PG8_LDB(B0, 0, 0); PG8_SCHED; PG8_LDA(At, 0, 0); PG8_STAGE(PG8_SA(1, 1), a1 + hstepA, voffA);
            PG8_WAIT_L(8); PG8_BAR; PG8_WAIT_L(0); PG8_MMA(0, 0, At, B0); PG8_BAR; PG8_SCHED;
            PG8_LDB(B1, 0, 1); PG8_STAGE(PG8_SB(0, 0), b2, voffB);
            PG8_BAR; PG8_WAIT_L(0); PG8_MMA(0, 1, At, B1); PG8_BAR;
            PG8_LDA(At, 0, 1); PG8_STAGE(PG8_SA(0, 0), a2, voffA);
            PG8_BAR; PG8_WAIT_L(0); PG8_MMA(1, 0, At, B0); PG8_BAR; PG8_SCHED;
            PG8_STAGE(PG8_SB(0, 1), b2 + hstepB, voffB);
            PG8_WAIT_V(6); PG8_BAR; PG8_MMA(1, 1, At, B1); PG8_BAR;
            PG8_LDB(B0, 1, 0); PG8_SCHED; PG8_LDA(At, 1, 0); PG8_STAGE(PG8_SA(0, 1), a2 + hstepA, voffA);
            PG8_WAIT_L(8); PG8_BAR; PG8_WAIT_L(0); PG8_MMA(0, 0, At, B0); PG8_BAR; PG8_SCHED;
            PG8_LDB(B1, 1, 1); PG8_STAGE(PG8_SB(1, 0), b3, voffB);
            PG8_BAR; PG8_WAIT_L(0); PG8_MMA(0, 1, At, B1); PG8_BAR;
            PG8_LDA(At, 1, 1); PG8_STAGE(PG8_SA(1, 0), a3, voffA);
            PG8_BAR; PG8_WAIT_L(0); PG8_MMA(1, 0, At, B0); PG8_BAR; PG8_SCHED;
            PG8_STAGE(PG8_SB(1, 1), b3 + hstepB, voffB);
            PG8_WAIT_V(6); PG8_BAR; PG8_MMA(1, 1, At, B1); PG8_BAR;
            }
        }
        if constexpr (ALIGN_EPI) { if (wr == 0) PG8_BAR; }
        if constexpr (!Epi::AFTER_DRAIN) { E(acc, cur, wr, wc, fr, fq); S.done(cur); }
        if (!has_next) break;
#pragma unroll
        for (int a = 0; a < 2; ++a)
#pragma unroll
            for (int b = 0; b < 2; ++b)
#pragma unroll
                for (int m = 0; m < 4; ++m)
#pragma unroll
                    for (int n = 0; n < 2; ++n) acc[a][b][m][n] = (f32x4){0.f, 0.f, 0.f, 0.f};
        cur = nxt; cA = nA; cB = nB; ++ui;
        if constexpr (ALIGN_EPI) { if (wr == 1) PG8_BAR; }
    }
    PG8_WAIT_V(0);
    if constexpr (!ALIGN_EPI) { if (wr == 0) PG8_BAR; }
    PG8_BAR;
    if constexpr (Epi::AFTER_DRAIN) { E.fused(acc, cur, wr, wc, fr, fq, lds, wid, lane); S.done(cur); }
#undef PG8_SA
#undef PG8_SB
#undef PG8_STAGE
#undef PG8_LDA
#undef PG8_LDB
#undef PG8_MMA
#undef PG8_WAIT_V
#undef PG8_WAIT_L
#undef PG8_BAR
#undef PG8_SCHED
}
}

#ifndef MLP_SPLIT
#define MLP_SPLIT 2
#endif
constexpr int NB = 8, SEQ = 2048, DM = 2048, MTOK = NB * SEQ, DFF = 8192, MHALF = MTOK / MLP_SPLIT;
constexpr int NU0 = 6144, NU1 = 7168;
constexpr int LD_IN0 = 6160, LD_IN1 = 7176;
constexpr int C0_GQ = 0, C0_GK = 512, C0_GV = 1024, C0_GG = 2048, C0_MQ = 3072, C0_MK = 4096, C0_MV = 5120;
constexpr int C1_FQ = 0, C1_FK = 1024, C1_FV = 2048, C1_HQ = 3072, C1_HF = 4096, C1_HI = 5120, C1_HG = 6144;
constexpr float EPS = 1e-6f;
constexpr float QSCALE = 0.08838834764831845f;
constexpr size_t MiB = 1u << 20;
constexpr size_t WS_CTL = 0, CTL_ZERO_BYTES = 65536;
constexpr size_t WS_ROWSS = 1 * MiB;
constexpr size_t WS_GLR = 3 * MiB;
constexpr size_t WS_FF = 4 * MiB;
constexpr size_t WS_KMEAN = 4 * MiB + 512 * 1024;
constexpr size_t WS_DSC = 4 * MiB + 768 * 1024;
constexpr size_t WS_CFOX = 5 * MiB;
constexpr size_t WS_WIN0 = 6 * MiB, WS_WOUT0 = 30 * MiB, WS_WUP0 = 38 * MiB, WS_WDN0 = 70 * MiB;
constexpr size_t WS_WIN1 = 102 * MiB, WS_WOUT1 = 130 * MiB, WS_WUP1 = 138 * MiB, WS_WDN1 = 170 * MiB;
constexpr size_t WS_U = 202 * MiB;
constexpr size_t WS_BCUM = WS_U + 192 * MiB;
constexpr size_t WS_HFIN = WS_WIN0, WS_HID = WS_U;
constexpr size_t OUT_H16 = 64 * MiB;
#ifndef LIN_PREFETCH
#define LIN_PREFETCH 5
#endif
#ifndef LIN_PARK
#define LIN_PARK 1
#endif
#ifndef PARK_MASK
#define PARK_MASK 7
#endif
#ifndef LIN_PADB
#define LIN_PADB 1
#endif
#ifndef LIN_GATE_EARLY
#define LIN_GATE_EARLY 2
#endif
#ifndef LIN_SU_EARLY
#define LIN_SU_EARLY 3
#endif
#ifndef LIN_GVDB
#define LIN_GVDB 1
#endif
#ifndef LIN_QLATE
#define LIN_QLATE 1
#endif
#ifndef HID_DB
#define HID_DB 1
#endif
constexpr size_t HID_STRIDE = (HID_DB && MLP_SPLIT == 2) ? 128 * MiB : 0;
constexpr size_t WS_P = 426 * MiB;
constexpr size_t WS_S = 490 * MiB;
constexpr size_t WS_ROWSS2 = 506 * MiB;
constexpr size_t WS_END = 508 * MiB;
constexpr int CW_BAR = 4096;
constexpr int LDS_BYTES = 147456, MISC_OFF = LDS_BYTES - 256;
constexpr int NWAVES = 8;

#define GAS __attribute__((address_space(1)))
#define LAS __attribute__((address_space(3)))
typedef unsigned short bf16;
typedef unsigned u32x4 __attribute__((ext_vector_type(4)));
typedef unsigned u32x2 __attribute__((ext_vector_type(2)));
typedef float f32x4 __attribute__((ext_vector_type(4)));
typedef float f32x2 __attribute__((ext_vector_type(2)));
typedef float f32x16 __attribute__((ext_vector_type(16)));
typedef short bf16x8 __attribute__((ext_vector_type(8)));
typedef short s16x4 __attribute__((ext_vector_type(4)));
typedef __bf16 bf16x2_t __attribute__((ext_vector_type(2)));
#define LDS_WAIT() asm volatile("s_waitcnt lgkmcnt(0)" ::: "memory")
__device__ __forceinline__ float bf2f(unsigned short b) { return __uint_as_float((unsigned)b << 16); }
__device__ __forceinline__ unsigned cvtpk(float lo, float hi) { f32x2 v = {lo, hi}; bf16x2_t b = __builtin_convertvector(v, bf16x2_t); return __builtin_bit_cast(unsigned, b); }
__device__ __forceinline__ unsigned short f2bf(float f) { return (unsigned short)(cvtpk(f, 0.f) & 0xffffu); }
__device__ __forceinline__ float wave_sum(float v) {
#pragma unroll
    for (int o = 1; o < 64; o <<= 1) v += __shfl_xor(v, o);
    return v;
}
__device__ __forceinline__ float wave_max(float v) {
#pragma unroll
    for (int o = 1; o < 64; o <<= 1) v = fmaxf(v, __shfl_xor(v, o));
    return v;
}
__device__ __forceinline__ float log_sigmoid(float z) { return fminf(z, 0.f) - log1pf(expf(-fabsf(z))); }
__device__ __forceinline__ float sigmoidf(float z) { return 1.0f / (1.0f + expf(-z)); }
__device__ __forceinline__ int crow(int r, int hi) { return (r & 3) + 8 * (r >> 2) + 4 * hi; }
#ifndef UTILED
#define UTILED 1
#endif
__device__ __forceinline__ size_t UOFF(int tok, int col, int pitch) {
#if UTILED
    return ((size_t)((tok >> 7) * (pitch >> 6) + (col >> 6)) << 13) + (pg8::atile_off(tok & 127, col & 63) >> 1);
#else
    return (size_t)tok * pitch + col;
#endif
}
__device__ __forceinline__ size_t TOFF(int row, int col) { return ((size_t)((row >> 7) * 32 + (col >> 6)) << 13) + (pg8::atile_off(row & 127, col & 63) >> 1); }
struct Args { const float* in[20]; float* out; unsigned char* ws; int ph_lo, ph_hi, variant, pad; };
typedef const __attribute__((address_space(4))) Args* KArgsP;
__device__ __forceinline__ KArgsP kargs() { KArgsP p = (KArgsP)__builtin_amdgcn_kernarg_segment_ptr(); asm volatile("" : "+s"(p)); return p; }
#define XB_TMO      128
#define XB_XCNT(j)  (256  + 64 * (j))
#define XB_XSUB(j)  (1280 + 64 * (j))
#define XB_XGEN(j)  (2304 + 64 * (j))
#define XB_TOP      3328
#define XB_TOPGEN   3392
#define XCD_BAR_WORDS 3456
#define XB_SPIN_CAP (1u << 18)

__device__ __forceinline__ unsigned xb_ld(unsigned* p)              { return __hip_atomic_load(p, __ATOMIC_RELAXED, __HIP_MEMORY_SCOPE_AGENT); }
__device__ __forceinline__ unsigned xb_add(unsigned* p, unsigned v) { return __hip_atomic_fetch_add(p, v, __ATOMIC_RELAXED, __HIP_MEMORY_SCOPE_AGENT); }
__device__ __forceinline__ unsigned xb_xcc_id() { return (unsigned)__builtin_amdgcn_s_getreg((3 << 11) | 20) & 0xFu; }
#define XB_SPIN(cond, bar) do { unsigned _sp = 0; while (cond) { __builtin_amdgcn_s_sleep(1); \
    if ((++_sp & 255u) == 0u) { if (xb_ld(&(bar)[XB_TMO])) break; if (_sp > XB_SPIN_CAP) { atomicAdd(&(bar)[XB_TMO], 1u); break; } } } } while (0)

struct XcdBarrier {
    unsigned* bar; unsigned x;
    volatile LAS unsigned* st;
};

__device__ __forceinline__ XcdBarrier xcd_barrier_post(unsigned* bar, volatile LAS unsigned* st) {
    XcdBarrier b; b.bar = bar; b.x = xb_xcc_id(); b.st = st;
    if (threadIdx.x == 0) (void)xb_add(&bar[XB_XCNT(b.x)], 1u);
    return b;
}
__device__ __forceinline__ void xcd_barrier_complete(unsigned* bar, unsigned x, unsigned& nloc, unsigned& nx) {
    const unsigned G = gridDim.x * gridDim.y * gridDim.z;
    unsigned sum, cnt, mine, sp = 0u;
    for (;;) {
        sum = 0u; cnt = 0u; mine = 0u;
#pragma unroll
        for (unsigned j = 0; j < 16; ++j) { const unsigned c = xb_ld(&bar[XB_XCNT(j)]); sum += c; cnt += (c > 0u) ? 1u : 0u; mine = (j == x) ? c : mine; }
        if (sum == G) break;
        __builtin_amdgcn_s_sleep(1);
        if ((++sp & 255u) == 0u) { if (xb_ld(&bar[XB_TMO])) break; if (sp > XB_SPIN_CAP) { atomicAdd(&bar[XB_TMO], 1u); break; } }
    }
    nloc = mine > 0u ? mine : 1u; nx = cnt > 0u ? cnt : 1u;
}

__device__ __forceinline__ void xcd_barrier(const XcdBarrier& b) {
    asm volatile("s_waitcnt vmcnt(0)" ::: "memory");
    __syncthreads();
    if (threadIdx.x == 0) {
        unsigned* bar = b.bar;
        __builtin_amdgcn_s_waitcnt(0);
        unsigned nloc = b.st[0], nx = b.st[1];
        if (nloc == 0u) { xcd_barrier_complete(bar, b.x, nloc, nx); b.st[0] = nloc; b.st[1] = nx; }
        const unsigned old = xb_add(&bar[XB_XSUB(b.x)], 1u);
        const unsigned gen = old / nloc;
        if (old + 1u == (gen + 1u) * nloc) {
            __builtin_amdgcn_fence(__ATOMIC_RELEASE, "agent");
            asm volatile("s_waitcnt vmcnt(0)" ::: "memory");
            const unsigned og = xb_add(&bar[XB_TOP], 1u);
            const unsigned tg = og / nx;
            if (og + 1u == (tg + 1u) * nx) xb_add(&bar[XB_TOPGEN], 1u);
            else XB_SPIN(xb_ld(&bar[XB_TOPGEN]) == tg, bar);
            __builtin_amdgcn_fence(__ATOMIC_ACQUIRE, "agent");
            xb_add(&bar[XB_XGEN(b.x)], 1u);
            asm volatile("s_waitcnt vmcnt(0)" ::: "memory");
        } else {
            XB_SPIN(xb_ld(&bar[XB_XGEN(b.x)]) == gen, bar);
            __builtin_amdgcn_fence(__ATOMIC_ACQUIRE, "agent");
            asm volatile("s_waitcnt vmcnt(0)" ::: "memory");
        }
    }
    __syncthreads();
}

#ifndef PROLOGUE_NT
#define PROLOGUE_NT 0
#endif
#if PROLOGUE_NT
#define NT_LOAD4(p) __builtin_nontemporal_load(p)
#else
#define NT_LOAD4(p) (*(p))
#endif

#ifndef WTILED
#define WTILED 1
#endif
#if WTILED
#define WTILED_BASE(n0_, k0_, K_) ((((size_t)((n0_) >> 7) * ((K_) >> 6) + ((k0_) >> 6)) << 13) + (pg8::atile_off((n0_) & 127, 0) >> 1))
#define WTILED_OFF(n_, c_, K_) ((pg8::atile_off(((n_) & 31), (c_)) >> 1))
#else
#define WTILED_BASE(n0_, k0_, K_) ((size_t)(n0_) * (K_) + (k0_))
#define WTILED_OFF(n_, c_, K_) ((size_t)(n_) * (K_) + (c_))
#endif
struct TrItem { const float* src; const float* gain; bf16* dst; int ld, K; };
__device__ __forceinline__ TrItem tr_decode(KArgsP K, int r) {
    unsigned char* ws = K->ws; TrItem t;
#define TJ(idx, gidx, ld_, co_, nc_, K_, off_, ro_) { const int items_ = ((K_) / 64) * ((nc_) / 32); if (r < items_) { const int nblk = (nc_) / 32, kb = r / nblk, nb = r % nblk, k0 = 64 * kb, n0 = 32 * nb; \
        t.src = K->in[idx] + (size_t)k0 * (ld_) + (co_) + n0; t.gain = (gidx) >= 0 ? K->in[(gidx) >= 0 ? (gidx) : 0] + k0 : nullptr; t.dst = (bf16*)(ws + (off_)) + WTILED_BASE((ro_) + n0, k0, K_); t.ld = (ld_); t.K = (K_); return t; } r -= items_; }
    TJ(2, 1, LD_IN0, 0, 3072, 2048, WS_WIN0, 0)
    TJ(2, 1, LD_IN0, 3088, 3072, 2048, WS_WIN0, 3072)
    TJ(6, -1, 2048, 0, 2048, 2048, WS_WOUT0, 0)
    TJ(8, 7, 8192, 0, 8192, 2048, WS_WUP0, 0)
    TJ(9, -1, 2048, 0, 2048, 8192, WS_WDN0, 0)
    TJ(11, 10, LD_IN1, 0, 3072, 2048, WS_WIN1, 0)
    TJ(11, 10, LD_IN1, 3080, 4096, 2048, WS_WIN1, 3072)
    TJ(14, -1, 2048, 0, 2048, 2048, WS_WOUT1, 0)
    TJ(16, 15, 8192, 0, 8192, 2048, WS_WUP1, 0)
    TJ(17, -1, 2048, 0, 2048, 8192, WS_WDN1, 0)
#undef TJ
    t.src = nullptr; t.gain = nullptr; t.dst = nullptr; t.ld = 0; t.K = 0; return t;
}
#define TR_LOAD(t, tv) do { _Pragma("unroll") for (int i = 0; i < 8; ++i) tv[i] = NT_LOAD4((const f32x4*)((t).src + (size_t)(8 * i + (lane >> 3)) * (t).ld + 4 * (lane & 7))); } while (0)
__device__ __forceinline__ void tr_process(const TrItem& t, const f32x4 (&tv)[8], LAS float* scr, int lane) {
#pragma unroll
    for (int i = 0; i < 8; ++i) { LAS float* d_ = scr + (8 * i + (lane >> 3)) * 33 + 4 * (lane & 7); d_[0] = tv[i][0]; d_[1] = tv[i][1]; d_[2] = tv[i][2]; d_[3] = tv[i][3]; }
    const int c = lane & 7;
    f32x4 g0 = {1.f, 1.f, 1.f, 1.f}, g1 = g0;
    if (t.gain) { g0 = *(const f32x4*)(t.gain + 8 * c); g1 = *(const f32x4*)(t.gain + 8 * c + 4); }
    LDS_WAIT(); asm volatile("" ::: "memory");
#pragma unroll
    for (int j = 0; j < 4; ++j) { const int n = (lane >> 3) + 8 * j; const LAS float* s = scr + (8 * c) * 33 + n;
        u32x4 o; o.x = cvtpk(s[0 * 33] * g0[0], s[1 * 33] * g0[1]); o.y = cvtpk(s[2 * 33] * g0[2], s[3 * 33] * g0[3]); o.z = cvtpk(s[4 * 33] * g1[0], s[5 * 33] * g1[1]); o.w = cvtpk(s[6 * 33] * g1[2], s[7 * 33] * g1[3]);
        *(GAS u32x4*)(t.dst + WTILED_OFF(n, 8 * c, t.K)) = o; }
    LDS_WAIT(); asm volatile("" ::: "memory");
}
#ifndef TR_STATIC
#define TR_STATIC 17
#endif
__device__ __forceinline__ void phase_transposes(LAS unsigned char* lds, KArgsP K, int G, int wave, int lane) {
    LAS float* scr = (LAS float*)(lds + wave * 16384);
    const int gw = blockIdx.x * NWAVES + wave, NGW = G * NWAVES;
    constexpr int TOTAL = 2 * (32 * 96) + 32 * 64 + 32 * 256 + 128 * 64 + 32 * 96 + 32 * 128 + 32 * 64 + 32 * 256 + 128 * 64;
    const int NSTAT = (TR_STATIC > 0 && TR_STATIC * NGW < TOTAL) ? TR_STATIC * NGW : TOTAL;
    f32x4 ta[8], tb[8];
    int it = gw;
    if (it < NSTAT) {
        TrItem j0 = tr_decode(K, it), j1; TR_LOAD(j0, ta);
        for (;;) {
            const int it1 = it + NGW; const bool h1 = it1 < NSTAT;
            if (h1) { j1 = tr_decode(K, it1); TR_LOAD(j1, tb); }
            asm volatile("" ::: "memory");
            tr_process(j0, ta, scr, lane);
            if (!h1) break;
            const int it2 = it1 + NGW; const bool h2 = it2 < NSTAT;
            if (h2) { j0 = tr_decode(K, it2); TR_LOAD(j0, ta); }
            asm volatile("" ::: "memory");
            tr_process(j1, tb, scr, lane);
            if (!h2) break;
            it = it2;
        }
    }
    if (NSTAT < TOTAL) {
        unsigned* ctr = (unsigned*)(K->ws + WS_CTL) + 12288;
        volatile LAS unsigned* qslot = (volatile LAS unsigned*)(lds + MISC_OFF) + 24;
        const int nch = (TOTAL - NSTAT + 15) / 16;
        const bool lead = wave == 0 && lane == 0;
        if (lead) qslot[0] = __hip_atomic_fetch_add(ctr, 1u, __ATOMIC_RELAXED, __HIP_MEMORY_SCOPE_AGENT);
        __syncthreads();
        int q = (int)qslot[0];
        while (q < nch) {
            unsigned qn = 0u; if (lead) qn = __hip_atomic_fetch_add(ctr, 1u, __ATOMIC_RELAXED, __HIP_MEMORY_SCOPE_AGENT);
            const int ia = NSTAT + 16 * q + 2 * wave, ib = ia + 1;
            const bool ha = ia < TOTAL, hb = ib < TOTAL;
            TrItem ja, jb;
            if (ha) { ja = tr_decode(K, ia); TR_LOAD(ja, ta); }
            if (hb) { jb = tr_decode(K, ib); TR_LOAD(jb, tb); }
            asm volatile("" ::: "memory");
            if (ha) tr_process(ja, ta, scr, lane);
            if (hb) tr_process(jb, tb, scr, lane);
            __syncthreads();
            if (lead) qslot[0] = qn;
            __syncthreads();
            q = (int)qslot[0];
        }
    }
}
__device__ __forceinline__ void phase_norm0(LAS unsigned char* lds, KArgsP K, int G, int tid, int wave, int lane) {
    unsigned char* ws = K->ws; const float* x = K->in[0]; const float* g0 = K->in[1]; const float* win = K->in[2]; const float* w2 = K->in[3]; const float* gb = K->in[4];
    bf16* xn = (bf16*)((unsigned char*)K->out + OUT_H16); float* rowss = (float*)(ws + WS_ROWSS); float* glr = (float*)(ws + WS_GLR); float* bcum = (float*)(ws + WS_BCUM);
    LAS float* WT = (LAS float*)lds;
    LAS float* glr_s = (LAS float*)(lds + 131072);
    if ((int)blockIdx.x >= MTOK / 64) return;
    for (int idx = tid; idx < 2048 * 4; idx += 512) { const int k = idx >> 2, j4 = idx & 3; const f32x4 v = *(const f32x4*)(win + (size_t)k * LD_IN0 + 3072 + 4 * j4) * g0[k];
        WT[(4 * j4 + 0) * 2048 + k] = v[0]; WT[(4 * j4 + 1) * 2048 + k] = v[1]; WT[(4 * j4 + 2) * 2048 + k] = v[2]; WT[(4 * j4 + 3) * 2048 + k] = v[3]; }
    float w2c[16];
#pragma unroll
    for (int r = 0; r < 16; ++r) w2c[r] = w2[r * 512 + tid];
    const float bc = gb[tid];
    __syncthreads();
    for (int item = blockIdx.x; item < MTOK / 64; item += G) {
        const int r0 = item * 64;
        for (int i = 0; i < 8; i += 2) {
            const int row = r0 + 8 * wave + i;
            f32x4 va[8], vb[8]; float ssa = 0.f, ssb = 0.f;
#pragma unroll
            for (int jj = 0; jj < 8; ++jj) { va[jj] = NT_LOAD4((const f32x4*)(x + (size_t)row * DM) + 64 * jj + lane); vb[jj] = NT_LOAD4((const f32x4*)(x + (size_t)(row + 1) * DM) + 64 * jj + lane); }
            asm volatile("" ::: "memory");
#pragma unroll
            for (int jj = 0; jj < 8; ++jj) { ssa += (va[jj][0] * va[jj][0] + va[jj][1] * va[jj][1]) + (va[jj][2] * va[jj][2] + va[jj][3] * va[jj][3]); ssb += (vb[jj][0] * vb[jj][0] + vb[jj][1] * vb[jj][1]) + (vb[jj][2] * vb[jj][2] + vb[jj][3] * vb[jj][3]); }
#pragma unroll
            for (int jj = 0; jj < 8; ++jj) { u32x2 pa, pb; pa.x = cvtpk(va[jj][0], va[jj][1]); pa.y = cvtpk(va[jj][2], va[jj][3]); pb.x = cvtpk(vb[jj][0], vb[jj][1]); pb.y = cvtpk(vb[jj][2], vb[jj][3]);
                *(u32x2*)(xn + TOFF(row, 256 * jj + 4 * lane)) = pa; *(u32x2*)(xn + TOFF(row + 1, 256 * jj + 4 * lane)) = pb; }
            float acca[16], accb[16];
#pragma unroll 2
            for (int j = 0; j < 16; ++j) { float a = 0.f, b = 0.f;
#pragma unroll
                for (int jj = 0; jj < 8; ++jj) { const f32x4 w = *(const LAS f32x4*)(WT + j * 2048 + 256 * jj + 4 * lane);
                    a += (va[jj][0] * w[0] + va[jj][1] * w[1]) + (va[jj][2] * w[2] + va[jj][3] * w[3]); b += (vb[jj][0] * w[0] + vb[jj][1] * w[1]) + (vb[jj][2] * w[2] + vb[jj][3] * w[3]); }
                acca[j] = a; accb[j] = b; }
#pragma unroll
            for (int st = 0; st < 4; ++st) { const int half = 8 >> st; const unsigned um = 0u - (((unsigned)lane >> st) & 1u);
#pragma unroll
                for (int q = 0; q < 8; ++q) if (q < half) {
                    const unsigned alo = __float_as_uint(acca[q]), ahi = __float_as_uint(acca[q + half]), blo = __float_as_uint(accb[q]), bhi = __float_as_uint(accb[q + half]);
                    const float sa = __uint_as_float((alo & um) | (ahi & ~um)), sb = __uint_as_float((blo & um) | (bhi & ~um));
                    const float ka = __uint_as_float((ahi & um) | (alo & ~um)), kb = __uint_as_float((bhi & um) | (blo & ~um));
                    acca[q] = ka + __shfl_xor(sa, 1 << st); accb[q] = kb + __shfl_xor(sb, 1 << st); } }
            float ta = acca[0], tb = accb[0];
            ta += __shfl_xor(ta, 16); ta += __shfl_xor(ta, 32); tb += __shfl_xor(tb, 16); tb += __shfl_xor(tb, 32);
            ssa = wave_sum(ssa); ssb = wave_sum(ssb);
            const float rsa = 1.0f / sqrtf(ssa * (1.0f / DM) + EPS), rsb = 1.0f / sqrtf(ssb * (1.0f / DM) + EPS);
            const int col = ((lane & 1) << 3) | ((lane & 2) << 1) | ((lane & 4) >> 1) | ((lane & 8) >> 3);
            if (lane < 16) { glr_s[(8 * wave + i) * 16 + col] = ta * rsa; glr[(size_t)row * 16 + col] = ta * rsa; glr_s[(8 * wave + i + 1) * 16 + col] = tb * rsb; glr[(size_t)(row + 1) * 16 + col] = tb * rsb; }
            if (lane < 32) { rowss[(size_t)row * 32 + lane] = (lane == 0) ? ssa : 0.f; rowss[(size_t)(row + 1) * 32 + lane] = (lane == 0) ? ssb : 0.f; }
        }
        __syncthreads();
        float run = 0.f;
        for (int t = 0; t < 64; ++t) { float z = bc;
#pragma unroll
            for (int q = 0; q < 4; ++q) { const f32x4 gq = *(const LAS f32x4*)(glr_s + t * 16 + 4 * q); z += (gq[0] * w2c[4 * q] + gq[1] * w2c[4 * q + 1]) + (gq[2] * w2c[4 * q + 2] + gq[3] * w2c[4 * q + 3]); }
            run += (fminf(z, 0.f) - __logf(1.0f + __expf(-fabsf(z)))) * (1.0f / 16.0f); bcum[(size_t)(r0 + t) * 512 + tid] = run; }
        __syncthreads();
    }
}
__device__ __forceinline__ void phase_final_norm(const bf16* h16, float* out, const float* g, const float* rowss, int G, int wave, int lane, float pscale = 1.f) {
    f32x4 gv[8];
#pragma unroll
    for (int jj = 0; jj < 8; ++jj) gv[jj] = ((const f32x4*)g)[64 * jj + lane];
    for (int row = blockIdx.x * NWAVES + wave; row < MTOK; row += G * NWAVES) {
        float s = lane < 32 ? rowss[(size_t)row * 32 + lane] : 0.f;
        u32x2 hv[8];
#pragma unroll
        for (int jj = 0; jj < 8; ++jj) hv[jj] = *(const u32x2*)(h16 + TOFF(row, 256 * jj + 4 * lane));
        asm volatile("" ::: "memory");
        s = wave_sum(s);
        const float rs = pscale / sqrtf(s * (1.0f / DM) + EPS);
        f32x4* orow = (f32x4*)(out + (size_t)row * DM);
#pragma unroll
        for (int jj = 0; jj < 8; ++jj) { const f32x4 v = {__uint_as_float(hv[jj].x << 16), __uint_as_float(hv[jj].x & 0xffff0000u), __uint_as_float(hv[jj].y << 16), __uint_as_float(hv[jj].y & 0xffff0000u)};
            orow[64 * jj + lane] = v * rs * gv[jj]; }
    }
}
__device__ __forceinline__ void phase_kmean(LAS unsigned char* lds, const bf16* u, float* kmean, int G, int tid) {
    LAS float* red = (LAS float*)lds;
    const int c8 = tid & 15, tg = tid >> 4;
    for (int item = blockIdx.x; item < 512; item += G) {
        const int n = item & 7, bh = item >> 3, b = bh >> 3, h = bh & 7;
        float a[8] = {0, 0, 0, 0, 0, 0, 0, 0}; bf16x8 kv[8];
#pragma unroll
        for (int i = 0; i < 8; ++i) { const int tok = b * SEQ + n * 256 + tg * 8 + i; kv[i] = *(const bf16x8*)(u + UOFF(tok, C0_MK + h * 128 + 8 * c8, NU0)); }
        asm volatile("" ::: "memory");
#pragma unroll
        for (int i = 0; i < 8; ++i)
#pragma unroll
            for (int e = 0; e < 8; ++e) a[e] += bf2f((unsigned short)kv[i][e]);
#pragma unroll
        for (int e = 0; e < 8; ++e) red[tg * 128 + 8 * c8 + e] = a[e];
        __syncthreads();
        if (tid < 128) { float s = 0.f; for (int g = 0; g < 32; ++g) s += red[g * 128 + tid]; kmean[(size_t)item * 128 + tid] = s * (1.0f / 256.0f); }
        __syncthreads();
    }
}
__device__ __forceinline__ void phase_ff(LAS unsigned char* lds, const float* win1, const float* gain, const bf16* xn, const float* rowss, float* ff, int G, int tid, int wave, int lane) {
    LAS float* WT = (LAS float*)lds;
    if ((int)blockIdx.x >= MTOK / 64) return;
    for (int idx = tid; idx < 2048 * 2; idx += 512) { const int k = idx >> 1, j4 = idx & 1; const f32x4 v = *(const f32x4*)(win1 + (size_t)k * LD_IN1 + 3072 + 4 * j4) * gain[k];
        WT[(4 * j4 + 0) * 2048 + k] = v[0]; WT[(4 * j4 + 1) * 2048 + k] = v[1]; WT[(4 * j4 + 2) * 2048 + k] = v[2]; WT[(4 * j4 + 3) * 2048 + k] = v[3]; }
    __syncthreads();
    for (int item = blockIdx.x; item < MTOK / 64; item += G) {
        for (int i = 0; i < 8; ++i) {
            const int row = item * 64 + 8 * wave + i;
            float xf[4][8]; bf16x8 xv[4];
#pragma unroll
            for (int jj = 0; jj < 4; ++jj) xv[jj] = *(const bf16x8*)(xn + TOFF(row, 512 * jj + 8 * lane));
            float s = lane < 32 ? rowss[(size_t)row * 32 + lane] : 0.f;
            asm volatile("" ::: "memory");
#pragma unroll
            for (int jj = 0; jj < 4; ++jj)
#pragma unroll
                for (int e = 0; e < 8; ++e) xf[jj][e] = bf2f((unsigned short)xv[jj][e]);
            s = wave_sum(s);
            const float rs = 1.0f / sqrtf(s * (1.0f / DM) + EPS);
            float mine = 0.f;
#pragma unroll 1
            for (int j = 0; j < 8; ++j) { float a = 0.f;
#pragma unroll
                for (int jj = 0; jj < 4; ++jj) { const f32x4 w0 = *(const LAS f32x4*)(WT + j * 2048 + 512 * jj + 8 * lane), w1 = *(const LAS f32x4*)(WT + j * 2048 + 512 * jj + 8 * lane + 4);
                    a += (xf[jj][0] * w0[0] + xf[jj][1] * w0[1]) + (xf[jj][2] * w0[2] + xf[jj][3] * w0[3]) + (xf[jj][4] * w1[0] + xf[jj][5] * w1[1]) + (xf[jj][6] * w1[2] + xf[jj][7] * w1[3]); }
                const float t = wave_sum(a) * rs; if (lane == j) mine = t; }
            if (lane < 8) ff[(size_t)row * 8 + lane] = mine;
        }
    }
    __syncthreads();
}
template <int DV>
__device__ __forceinline__ void phase_scan(const float* sloc, const float* dsc, bf16* sstart, int G, int tid) {
    constexpr int GPB = 128 * DV / 4, TOTAL = (DV == 256 ? 32 : 64) * GPB;
    for (int item = blockIdx.x * 512 + tid; item < TOTAL; item += G * 512) {
        const int p4 = item % GPB, bh = item / GPB;
        const int g = p4 & 3, ln = (p4 >> 2) & 63, dt = (p4 >> 8) & 3;
        const int d0 = 32 * dt + 8 * g + 4 * (ln >> 5);
        f32x4 s = {0.f, 0.f, 0.f, 0.f}; f32x4 ddv[7]; f32x4 lv[7];
#pragma unroll
        for (int sc = 0; sc < 7; ++sc) { const int ui = bh * 8 + sc; ddv[sc] = *(const f32x4*)(dsc + ui * 128 + d0); lv[sc] = *(const f32x4*)(sloc + (size_t)ui * 128 * DV + 4 * (size_t)p4); }
        asm volatile("" ::: "memory");
#pragma unroll
        for (int sc = 0; sc < 7; ++sc) { const int ui = bh * 8 + sc;
            s = s * ddv[sc] + lv[sc]; u32x2 p; p.x = cvtpk(s[0], s[1]); p.y = cvtpk(s[2], s[3]); *(u32x2*)(sstart + (size_t)(ui + 1) * 128 * DV + 4 * (size_t)p4) = p; }
    }
}

__device__ __forceinline__ unsigned offb(unsigned row, unsigned ch) { return 256u * row + 16u * (ch ^ (((row & 3u) << 2) | ((row >> 2) & 3u))); }
__device__ __forceinline__ unsigned tr_addr(unsigned lane, unsigned c, unsigned ks, unsigned t) {
    const unsigned h = lane >> 5, blk = (lane >> 4) & 1, q = (lane & 15) >> 2, p = lane & 3;
    return offb(16 * ks + 8 * h + 4 * t + q, 4 * c + 2 * blk + (p >> 1)) + 8 * (p & 1);
}
typedef short v4i16_t __attribute__((ext_vector_type(4)));
__device__ __forceinline__ s16x4 ds_tr(LAS const unsigned char* p) { return __builtin_bit_cast(s16x4, __builtin_amdgcn_ds_read_tr16_b64_v4i16((LAS v4i16_t*)p)); }
__device__ __forceinline__ bf16x8 ld_tr_frag(LAS const unsigned char* tile, unsigned lane, unsigned c, unsigned ks) {
    const s16x4 lo = ds_tr(tile + tr_addr(lane, c, ks, 0)), hi = ds_tr(tile + tr_addr(lane, c, ks, 1));
    return __builtin_shufflevector(lo, hi, 0, 1, 2, 3, 4, 5, 6, 7);
}
__device__ __forceinline__ bf16x8 ld_row_frag(LAS const unsigned char* tile, unsigned row, unsigned ch) { return *(const LAS bf16x8*)(tile + offb(row, ch)); }
template <int S> __device__ __forceinline__ bf16x8 pack_step(const f32x16& x) {
    u32x4 w = {cvtpk(x[8 * S], x[8 * S + 1]), cvtpk(x[8 * S + 2], x[8 * S + 3]), cvtpk(x[8 * S + 4], x[8 * S + 5]), cvtpk(x[8 * S + 6], x[8 * S + 7])};
    return __builtin_bit_cast(bf16x8, w);
}
#define LD_FENCE() asm volatile("" ::: "memory")
#define MFMA32(a, b, c) __builtin_amdgcn_mfma_f32_32x32x16_bf16((a), (b), (c), 0, 0, 0)

struct LinArgs {
    const bf16* u; int pitch; int qoff, koff, voff, goff;
    const float* bcum;
    const float* lbraw;
    const float* gain;
    float* sloc; float* dsc; const bf16* sstart; bf16* mix; int mixoff;
};
#ifdef PROBE_LIN
#define LIN_T(k) do { if (PROBE_LIN_SEL) { if (threadIdx.x == 0) { const unsigned long long t_ = __builtin_amdgcn_s_memrealtime(); if ((k) == 0) tfirst_ = t_; if ((k) == PROBE_LIN + 1) ((volatile LAS unsigned*)(lds + MISC_OFF))[20] += (unsigned)(t_ - tprev_); if (PROBE_LIN == 9 && (k) == 4) ((volatile LAS unsigned*)(lds + MISC_OFF))[20] += (unsigned)(t_ - tfirst_); tprev_ = t_; } } } while (0)
#else
#define LIN_T(k) do {} while (0)
#endif
template <int DV, int NWH, bool HGRN, bool PB>
__device__ __forceinline__ void lin_unit(LAS unsigned char* lds, const int tid, const LinArgs& A, const int b, const int hbase, const int sc) {
    constexpr int NTH = 64 * NWH, NTQ = NTH / 128, TPT = 64 / NTQ, NHEADS = HGRN ? 8 : 4;
    constexpr int VS_OFF = 32768, AS_OFF = VS_OFF + DV * 128, DS_OFF = AS_OFF + 9216, RED_OFF = DS_OFF + 512, BT_OFF = RED_OFF + 2048, GT_OFF = BT_OFF + 4096, HEAD_LDS = GT_OFF + 4 * DV;
    static_assert(HEAD_LDS * (8 / NWH) <= MISC_OFF, "LDS");
    const int wv = __builtin_amdgcn_readfirstlane(tid >> 6), wl = wv % NWH, hs = wv / NWH, head = hbase + hs;
    LAS unsigned char* hl = lds + hs * HEAD_LDS;
    LAS unsigned char* Qs = hl; LAS unsigned char* Ks = hl + 16384; LAS unsigned char* Vs = hl + VS_OFF; LAS unsigned char* As = hl + AS_OFF;
    LAS float* Ds = (LAS float*)(hl + DS_OFF); LAS float* red = (LAS float*)(hl + RED_OFF); LAS float* btot = (LAS float*)(hl + BT_OFF); LAS float* gtab = (LAS float*)(hl + GT_OFF);
    const int ui = (b * NHEADS + head) * 8 + sc;
    f32x16 Sacc[4];
#pragma unroll
    for (int dt = 0; dt < 4; ++dt)
#pragma unroll
        for (int i = 0; i < 16; ++i) Sacc[dt][i] = 0.f;
    constexpr int NP = HGRN ? 1 : 1024 / NTH;
    u32x4 rk[NP], rq[NP], vv[4]; f32x4 b0[NP], b1[NP]; u32x2 hraw[8], qraw[8];
#define LIN_LOADS_K(tokb_) do { int tl_ = tid; asm volatile("" : "+v"(tl_)); const int th_ = tl_ - hs * NTH, tokb = (tokb_); \
        if (!HGRN) { _Pragma("unroll") for (int j = 0; j < NP; ++j) { const int item = th_ + j * NTH, t = item >> 4, c8 = item & 15; \
                rk[j] = *(const u32x4*)(A.u + UOFF(tokb + t, A.koff + head * 128 + 8 * c8, A.pitch)); \
                const f32x4* bp = (const f32x4*)(A.bcum + (size_t)(tokb + t) * 512 + head * 128 + 8 * c8); b0[j] = bp[0]; b1[j] = bp[1]; } } \
        else { const int dbase_ = 4 * (th_ & 31), tq8_ = th_ >> 5; _Pragma("unroll") for (int i = 0; i < 8; ++i) { const int tk = tokb + tq8_ * 8 + i; \
                hraw[i] = *(const u32x2*)(A.u + UOFF(tk, A.koff + head * 128 + dbase_, A.pitch)); } } \
        LD_FENCE(); } while (0)
#define LIN_LOADS_V(tokb_) do { int tl_ = tid; asm volatile("" : "+v"(tl_)); const int th_ = tl_ - hs * NTH, tokb = (tokb_); \
        _Pragma("unroll") for (int j = 0; j < 4; ++j) { const int item = th_ + j * NTH, t = item / (DV / 8), c8 = item % (DV / 8); vv[j] = *(const u32x4*)(A.u + UOFF(tokb + t, A.voff + head * DV + 8 * c8, A.pitch)); } \
        LD_FENCE(); } while (0)
#define LIN_LOADS_Q(tokb_) do { if (PB) { int tl_ = tid; asm volatile("" : "+v"(tl_)); const int th_ = tl_ - hs * NTH, tokb = (tokb_); \
        if (!HGRN) { _Pragma("unroll") for (int j = 0; j < NP; ++j) { const int item = th_ + j * NTH, t = item >> 4, c8 = item & 15; rq[j] = *(const u32x4*)(A.u + UOFF(tokb + t, A.qoff + head * 128 + 8 * c8, A.pitch)); } } \
        else { const int dbase_ = 4 * (th_ & 31), tq8_ = th_ >> 5; _Pragma("unroll") for (int i = 0; i < 8; ++i) { const int tk = tokb + tq8_ * 8 + i; qraw[i] = *(const u32x2*)(A.u + UOFF(tk, A.qoff + head * 128 + dbase_, A.pitch)); } } \
        LD_FENCE(); } } while (0)
#define LIN_LOADS(tokb_) do { LIN_LOADS_K(tokb_); if (!GVDB_) LIN_LOADS_V(tokb_); LIN_LOADS_Q(tokb_); } while (0)
    constexpr bool PRE = ((LIN_PREFETCH >> ((PB ? 2 : 0) + (HGRN ? 1 : 0))) & 1) != 0;
    constexpr bool GVDB_ = LIN_GVDB != 0 && !HGRN && PRE && NWH == 8 && DV == 256;
    if (PRE && !(HGRN && PB)) LIN_LOADS(b * SEQ + sc * 256);
    constexpr bool PARK = LIN_PARK != 0 && HGRN && PB && !PRE && NWH == 4 && DV == 128;
#define LIN_DMA4(tokb_, Kd_, Qd_, Vd_, m_) do { int tp_ = tid; asm volatile("" : "+v"(tp_)); const int l_ = tp_ & 63, tokd = (tokb_); \
        _Pragma("unroll") for (int j = 0; j < 4; ++j) { const int row = 16 * wl + 4 * j + (l_ >> 4), ch = (l_ & 15) ^ ((((l_ >> 4) & 3) << 2) | j); const unsigned pofs = (unsigned)(wl * 4 + j) * 1024u; \
            if ((m_) & 1) __builtin_amdgcn_global_load_lds((const unsigned*)(A.u + UOFF(tokd + row, A.koff + head * 128 + 8 * ch, A.pitch)), (LAS unsigned*)((Kd_) + pofs), 16, 0, 0); \
            if ((m_) & 2) __builtin_amdgcn_global_load_lds((const unsigned*)(A.u + UOFF(tokd + row, A.qoff + head * 128 + 8 * ch, A.pitch)), (LAS unsigned*)((Qd_) + pofs), 16, 0, 0); \
            if ((m_) & 4) __builtin_amdgcn_global_load_lds((const unsigned*)(A.u + UOFF(tokd + row, A.voff + head * DV + 8 * ch, A.pitch)), (LAS unsigned*)((Vd_) + pofs), 16, 0, 0); } } while (0)
#define LIN_DMA(tokb_) LIN_DMA4(tokb_, Ks, Qs, Vs, PARK_MASK)
    constexpr bool PADB = LIN_PADB != 0 && HGRN && !PB && !PRE && NWH == 4 && DV == 128;
    static_assert(!PADB || (2 * HEAD_LDS + 1024 + 8192 <= MISC_OFF && AS_OFF + 16384 <= HEAD_LDS), "LDS (PADB)");
    if (PADB) { Ds = (LAS float*)(lds + 2 * HEAD_LDS + hs * 512); btot = (LAS float*)(lds + 2 * HEAD_LDS + 1024 + hs * 4096); LIN_DMA4(b * SEQ + sc * 256, Ks, Qs, Vs, 5); }
    constexpr bool GVDB = LIN_GVDB != 0 && !HGRN && PRE && NWH == 8 && DV == 256;
    static_assert(!GVDB || HEAD_LDS + 32768 <= MISC_OFF, "LDS (GVDB)");
#define LIN_DMA_V8(tokb_, Vd_) do { int tp_ = tid; asm volatile("" : "+v"(tp_)); const int l_ = tp_ & 63, tokd = (tokb_); \
        _Pragma("unroll") for (int j = 0; j < 4; ++j) { const int row = 16 * (wl & 3) + 4 * j + (l_ >> 4), ch = (l_ & 15) ^ ((((l_ >> 4) & 3) << 2) | j); const unsigned pofs = (unsigned)(wl * 4 + j) * 1024u; \
            __builtin_amdgcn_global_load_lds((const unsigned*)(A.u + UOFF(tokd + row, A.voff + head * DV + (wl >> 2) * 128 + 8 * ch, A.pitch)), (LAS unsigned*)((Vd_) + pofs), 16, 0, 0); } } while (0)
    if (GVDB) LIN_DMA_V8(b * SEQ + sc * 256, Vs);
    if (PB) { const int th_g = tid - hs * NTH; if (th_g < DV) gtab[th_g] = A.gain[th_g]; }
    if (PARK) LIN_DMA(b * SEQ + sc * 256);
    if (PB && sc > 0) {
        const bf16* sp = A.sstart + ((((size_t)ui * (DV / 32) + wl) * 4) * 64 + (tid & 63)) * 16;
        u32x4 rw[4][2];
#pragma unroll
        for (int dt = 0; dt < 4; ++dt) { rw[dt][0] = *(const u32x4*)(sp + dt * 1024); rw[dt][1] = *(const u32x4*)(sp + dt * 1024 + 8); }
        LD_FENCE();
#pragma unroll
        for (int dt = 0; dt < 4; ++dt)
#pragma unroll
            for (int h2 = 0; h2 < 2; ++h2)
#pragma unroll
                for (int q = 0; q < 4; ++q) { const unsigned w = rw[dt][h2][q]; Sacc[dt][8 * h2 + 2 * q] = __uint_as_float(w << 16); Sacc[dt][8 * h2 + 2 * q + 1] = __uint_as_float(w & 0xffff0000u); }
    }
    if (PRE && HGRN && PB) LIN_LOADS(b * SEQ + sc * 256);
    float dsum = 0.f, lb = 0.f, oml = 1.f; float dsum8[8] = {0.f, 0.f, 0.f, 0.f, 0.f, 0.f, 0.f, 0.f};
    float lb4[4] = {0.f, 0.f, 0.f, 0.f}, oml4[4] = {1.f, 1.f, 1.f, 1.f};
    if (HGRN) {
#pragma unroll
        for (int e = 0; e < 4; ++e) { int tlb_ = tid; asm volatile("" : "+v"(tlb_)); const int d0_ = 4 * ((tlb_ - hs * NTH) & 31) + e; lb4[e] = sigmoidf(A.lbraw[1024 + head * 128 + d0_] - A.lbraw[head * 128 + d0_]); oml4[e] = 1.f - lb4[e]; } }
    if (PARK || PADB || GVDB) { asm volatile("s_waitcnt vmcnt(0)" ::: "memory"); __syncthreads(); }
    for (int c = 0; c < 4; ++c) {
        const int tok0 = b * SEQ + sc * 256 + c * 64;
        int tid_c = tid; asm volatile("" : "+v"(tid_c));
#ifdef PROBE_LIN
        unsigned long long tprev_ = 0, tfirst_ = 0;
#endif
        LIN_T(0);
        const int th = tid_c - hs * NTH, lane = tid_c & 63, r = lane & 31, hb = lane >> 5;
        const int d = th & 127, tq = th >> 7;
        const unsigned wofs = 2u * (d & 7);
        if (GVDB) Vs = (c & 1) ? hl + HEAD_LDS : hl + VS_OFF;
        if (PADB) { Ks = (c & 1) ? hl : hl + 16384; Vs = (c & 1) ? hl + AS_OFF : hl + VS_OFF;
            if (c < 3) LIN_DMA4(tok0 + 64, ((c & 1) ? hl + 16384 : hl), Qs, ((c & 1) ? hl + VS_OFF : hl + AS_OFF), 5); }
        if (!PRE && !PARK && !PADB) LIN_LOADS(tok0);
        if (PARK || PADB) { const int dbase_ = 4 * (th & 31), tq8_ = th >> 5;
#pragma unroll
            for (int i = 0; i < 8; ++i) { const int t = tq8_ * 8 + i; if (PARK_MASK & 1) hraw[i] = *(const LAS u32x2*)(Ks + offb(t, dbase_ >> 3) + 2 * (dbase_ & 7)); if (PB && (PARK_MASK & 2)) qraw[i] = *(const LAS u32x2*)(Qs + offb(t, dbase_ >> 3) + 2 * (dbase_ & 7)); }
            if ((PARK_MASK & 7) != 7) { if (!(PARK_MASK & 1)) LIN_LOADS_K(tok0); if (!(PARK_MASK & 4)) LIN_LOADS_V(tok0); if (!(PARK_MASK & 2)) LIN_LOADS_Q(tok0); } }
        if (!GVDB && (!(PARK || PADB) || !(PARK_MASK & 4))) {
#pragma unroll
          for (int j = 0; j < 4; ++j) { const int item = th + j * NTH, t = item / (DV / 8), c8 = item % (DV / 8); *(LAS u32x4*)(Vs + (c8 >> 4) * 16384 + offb(t, c8 & 15)) = vv[j]; } }
        float blast;
        if (!HGRN) {
#pragma unroll
            for (int j = 0; j < NP; ++j) { const int item = th + j * NTH, t = item >> 4, c8 = item & 15;
                float bb[8] = {b0[j][0], b0[j][1], b0[j][2], b0[j][3], b1[j][0], b1[j][1], b1[j][2], b1[j][3]};
                float kf[8], qf[8];
#pragma unroll
                for (int e = 0; e < 4; ++e) { kf[2 * e] = __uint_as_float(rk[j][e] << 16); kf[2 * e + 1] = __uint_as_float(rk[j][e] & 0xffff0000u); if (PB) { qf[2 * e] = __uint_as_float(rq[j][e] << 16); qf[2 * e + 1] = __uint_as_float(rq[j][e] & 0xffff0000u); } }
                u32x4 ko, qo;
#pragma unroll
                for (int e = 0; e < 4; ++e) { ko[e] = cvtpk(kf[2 * e] * __expf(-bb[2 * e]), kf[2 * e + 1] * __expf(-bb[2 * e + 1]));
                    if (PB) qo[e] = cvtpk(qf[2 * e] * QSCALE * __expf(bb[2 * e]), qf[2 * e + 1] * QSCALE * __expf(bb[2 * e + 1])); }
                *(LAS u32x4*)(Ks + offb(t, c8)) = ko; if (PB) *(LAS u32x4*)(Qs + offb(t, c8)) = qo;
                if (t == 63) {
#pragma unroll
                    for (int e = 0; e < 8; ++e) { Ds[8 * c8 + e] = __expf(bb[e]); dsum8[e] += bb[e]; } } }
            blast = 0.f;
        } else {
            constexpr int TP = 8; const int dbase = 4 * (th & 31), tq8 = th >> 5;
            float kl[TP][4], ql[TP][4];
            f32x4 lip = {1.f, 1.f, 1.f, 1.f};
#pragma unroll
            for (int i = 0; i < TP; ++i) { const float hv[4] = {__uint_as_float(hraw[i].x << 16), __uint_as_float(hraw[i].x & 0xffff0000u), __uint_as_float(hraw[i].y << 16), __uint_as_float(hraw[i].y & 0xffff0000u)};
                const float hq[4] = {__uint_as_float(qraw[i].x << 16), __uint_as_float(qraw[i].x & 0xffff0000u), __uint_as_float(qraw[i].y << 16), __uint_as_float(qraw[i].y & 0xffff0000u)};
#pragma unroll
                for (int e = 0; e < 4; ++e) { const float eh = __expf(-hv[e]), g = __builtin_amdgcn_rcpf(1.0f + lb4[e] * eh); kl[i][e] = __builtin_fmaf(-lb4[e], eh, eh) * (g * lip[e]); lip[e] *= (1.0f + eh) * g;
                    if (PB) { const float eq = __expf(-hq[e]); ql[i][e] = hq[e] * __builtin_amdgcn_rcpf((1.0f + eq) * lip[e]); } } }
            *(LAS f32x4*)(btot + tq8 * 128 + dbase) = lip;
            __syncthreads();
            f32x4 offi = {1.f, 1.f, 1.f, 1.f}, toti = offi;
#pragma unroll
            for (int q = 0; q < 8; ++q) { const f32x4 v = *(const LAS f32x4*)(btot + q * 128 + dbase); toti *= v; if (q < tq8) offi *= v; }
            f32x4 poff = {1.f, 1.f, 1.f, 1.f};
            if (PB) {
#pragma unroll
                for (int e = 0; e < 4; ++e) poff[e] = __builtin_amdgcn_rcpf(offi[e]); }
#pragma unroll
            for (int i = 0; i < TP; ++i) { const int t = tq8 * TP + i;
                u32x2 kp; kp.x = cvtpk(kl[i][0] * offi[0], kl[i][1] * offi[1]); kp.y = cvtpk(kl[i][2] * offi[2], kl[i][3] * offi[3]); *(LAS u32x2*)(Ks + offb(t, dbase >> 3) + 2 * (dbase & 7)) = kp;
                if (PB) { u32x2 qp; qp.x = cvtpk(ql[i][0] * poff[0], ql[i][1] * poff[1]); qp.y = cvtpk(ql[i][2] * poff[2], ql[i][3] * poff[3]); *(LAS u32x2*)(Qs + offb(t, dbase >> 3) + 2 * (dbase & 7)) = qp; } }
            if (tq8 == 0) {
#pragma unroll
                for (int e = 0; e < 4; ++e) { Ds[dbase + e] = __builtin_amdgcn_rcpf(toti[e]); dsum8[e] -= __logf(toti[e]); } }
            blast = 0.f;
        }
        __syncthreads(); LIN_T(1);
        if (GVDB && c < 3) LIN_DMA_V8(tok0 + 64, ((c & 1) ? hl + VS_OFF : hl + HEAD_LDS));
        f32x16 o0, o1;
        u32x2 ggv[4][2]; float gsl[4][2][4];
        constexpr bool GE = PB && ((LIN_GATE_EARLY >> (HGRN ? 1 : 0)) & 1) != 0;
        constexpr bool SUE = PB && ((LIN_SU_EARLY >> (HGRN ? 1 : 0)) & 1) != 0;
        if (PB) {
#pragma unroll
            for (int g = 0; g < 4; ++g) { const int e0 = 32 * wl + 8 * g + 4 * hb;
#pragma unroll
                for (int tt = 0; tt < 2; ++tt) ggv[g][tt] = *(const u32x2*)(A.u + UOFF(tok0 + 32 * tt + r, A.goff + head * DV + e0, A.pitch)); }
            LD_FENCE();
        }
        if (PRE && !(LIN_QLATE && HGRN && PB) && c < 3) { LIN_LOADS_K(tok0 + 64); if (!GVDB) LIN_LOADS_V(tok0 + 64); LIN_LOADS_Q(tok0 + 64); }
        bf16x8 vf[4];
        if (PARK || SUE) {
#pragma unroll
            for (int ks = 0; ks < 4; ++ks) vf[ks] = ld_tr_frag(Vs + (wl >> 2) * 16384, lane, wl & 3, ks); }
        if (PB) {
            if (wl < 4) {
                const int tt = wl >> 1, st = wl & 1;
                f32x16 sa;
#pragma unroll
                for (int i = 0; i < 16; ++i) sa[i] = 0.f;
                if (st <= tt) {
#pragma unroll
                    for (int ks = 0; ks < 8; ++ks) { const bf16x8 af = ld_row_frag(Ks, 32 * st + r, 2 * ks + hb), bq = ld_row_frag(Qs, 32 * tt + r, 2 * ks + hb); sa = MFMA32(af, bq, sa); }
                    if (st == tt) {
#pragma unroll
                        for (int i = 0; i < 16; ++i) if (crow(i, hb) > r) sa[i] = 0.f; }
                }
#pragma unroll
                for (int g = 0; g < 4; ++g) { u32x2 p; p.x = cvtpk(sa[4 * g], sa[4 * g + 1]); p.y = cvtpk(sa[4 * g + 2], sa[4 * g + 3]);
                    *(LAS u32x2*)(As + (32 * tt + r) * 144 + (32 * st + 8 * g + 4 * hb) * 2) = p; }
            }
#pragma unroll
            for (int i = 0; i < 16; ++i) { o0[i] = 0.f; o1[i] = 0.f; }
#pragma unroll
            for (int dt = 0; dt < 4; ++dt) {
                const bf16x8 sf0 = pack_step<0>(Sacc[dt]), sf1 = pack_step<1>(Sacc[dt]);
#pragma unroll
                for (int s2 = 0; s2 < 2; ++s2) {
                    const u32x2 qa0 = *(const LAS u32x2*)(Qs + offb(r, 4 * dt + 2 * s2) + 8 * hb), qb0 = *(const LAS u32x2*)(Qs + offb(r, 4 * dt + 2 * s2 + 1) + 8 * hb);
                    const u32x2 qa1 = *(const LAS u32x2*)(Qs + offb(32 + r, 4 * dt + 2 * s2) + 8 * hb), qb1 = *(const LAS u32x2*)(Qs + offb(32 + r, 4 * dt + 2 * s2 + 1) + 8 * hb);
                    const u32x4 q0 = {qa0.x, qa0.y, qb0.x, qb0.y}, q1 = {qa1.x, qa1.y, qb1.x, qb1.y};
                    o0 = MFMA32(s2 ? sf1 : sf0, __builtin_bit_cast(bf16x8, q0), o0); o1 = MFMA32(s2 ? sf1 : sf0, __builtin_bit_cast(bf16x8, q1), o1); } }
            if (SUE) {
#pragma unroll
        for (int ks = 0; ks < 4; ++ks)
#pragma unroll
            for (int dt = 0; dt < 4; ++dt) { const bf16x8 kf = ld_tr_frag(Ks, lane, dt, ks); Sacc[dt] = MFMA32(kf, vf[ks], Sacc[dt]); }
#pragma unroll
        for (int dt = 0; dt < 4; ++dt)
#pragma unroll
            for (int g = 0; g < 4; ++g) { const f32x4 dv = *(const LAS f32x4*)(Ds + 32 * dt + 8 * g + 4 * hb);
#pragma unroll
                for (int e = 0; e < 4; ++e) Sacc[dt][4 * g + e] *= dv[e]; }
            if (GE) {
#pragma unroll
                for (int g = 0; g < 4; ++g) { const int e0 = 32 * wl + 8 * g + 4 * hb; const f32x4 gn = *(const LAS f32x4*)(gtab + e0);
#pragma unroll
                    for (int tt = 0; tt < 2; ++tt) { const u32x2 gg = ggv[g][tt];
                        const float gv[4] = {__uint_as_float(gg.x << 16), __uint_as_float(gg.x & 0xffff0000u), __uint_as_float(gg.y << 16), __uint_as_float(gg.y & 0xffff0000u)};
#pragma unroll
                        for (int e = 0; e < 4; ++e) gsl[g][tt][e] = gn[e] * (gv[e] * __builtin_amdgcn_rcpf(1.0f + __expf(-gv[e]))); } } }
            }
            __syncthreads(); LIN_T(2);
            if (PARK) {
#pragma unroll
                for (int g = 0; g < 4; ++g) { asm volatile("" :: "v"(ggv[g][0])); asm volatile("" :: "v"(ggv[g][1])); } }
            if (PARK && c < 3) LIN_DMA4(tok0 + 64, Ks, Qs, Vs, PARK_MASK & (SUE ? 7 : 4));
        }
        if (!PARK && !SUE) {
#pragma unroll
            for (int ks = 0; ks < 4; ++ks) vf[ks] = ld_tr_frag(Vs + (wl >> 2) * 16384, lane, wl & 3, ks); }
        if (PB) {
#pragma unroll
            for (int ks = 0; ks < 4; ++ks) {
                const bf16x8 a1 = *(const LAS bf16x8*)(As + (32 + r) * 144 + 32 * ks + 16 * hb); o1 = MFMA32(vf[ks], a1, o1);
                if (ks < 2) { const bf16x8 a0 = *(const LAS bf16x8*)(As + r * 144 + 32 * ks + 16 * hb); o0 = MFMA32(vf[ks], a0, o0); } }
            if (GE && !SUE) {
#pragma unroll
                for (int g = 0; g < 4; ++g) { const int e0 = 32 * wl + 8 * g + 4 * hb; const f32x4 gn = *(const LAS f32x4*)(gtab + e0);
#pragma unroll
                    for (int tt = 0; tt < 2; ++tt) { const u32x2 gg = ggv[g][tt];
                        const float gv[4] = {__uint_as_float(gg.x << 16), __uint_as_float(gg.x & 0xffff0000u), __uint_as_float(gg.y << 16), __uint_as_float(gg.y & 0xffff0000u)};
#pragma unroll
                        for (int e = 0; e < 4; ++e) gsl[g][tt][e] = gn[e] * (gv[e] * __builtin_amdgcn_rcpf(1.0f + __expf(-gv[e]))); } } }
        }
        if (!SUE) {
#pragma unroll
        for (int ks = 0; ks < 4; ++ks)
#pragma unroll
            for (int dt = 0; dt < 4; ++dt) { const bf16x8 kf = ld_tr_frag(Ks, lane, dt, ks); Sacc[dt] = MFMA32(kf, vf[ks], Sacc[dt]); }
#pragma unroll
        for (int dt = 0; dt < 4; ++dt)
#pragma unroll
            for (int g = 0; g < 4; ++g) { const f32x4 dv = *(const LAS f32x4*)(Ds + 32 * dt + 8 * g + 4 * hb);
#pragma unroll
                for (int e = 0; e < 4; ++e) Sacc[dt][4 * g + e] *= dv[e]; }
        }
        if (PRE && LIN_QLATE && HGRN && PB && c < 3) { LIN_LOADS_K(tok0 + 64); LIN_LOADS_V(tok0 + 64); LIN_LOADS_Q(tok0 + 64); }
        if (PB) {
            float s0 = 0.f, s1 = 0.f;
#pragma unroll
            for (int i = 0; i < 16; ++i) { s0 += o0[i] * o0[i]; s1 += o1[i] * o1[i]; }
            s0 += __shfl_xor(s0, 32); s1 += __shfl_xor(s1, 32);
            if (hb == 0) { red[wl * 64 + r] = s0; red[wl * 64 + 32 + r] = s1; }
            __syncthreads(); LIN_T(3);
            if (PARK && !SUE && c < 3) LIN_DMA4(tok0 + 64, Ks, Qs, Vs, PARK_MASK & 3);
#ifdef PARK_DEBUG_SYNC
            if (PARK) { asm volatile("s_waitcnt vmcnt(0)" ::: "memory"); __syncthreads(); }
#endif
            float t0 = 0.f, t1 = 0.f;
#pragma unroll
            for (int w = 0; w < NWH; ++w) { t0 += red[w * 64 + r]; t1 += red[w * 64 + 32 + r]; }
            const float rs0 = 1.0f / sqrtf(t0 * (1.0f / DV) + EPS), rs1 = 1.0f / sqrtf(t1 * (1.0f / DV) + EPS);
#pragma unroll
            for (int g = 0; g < 4; ++g) { const int e0 = 32 * wl + 8 * g + 4 * hb; const f32x4 gn = *(const LAS f32x4*)(gtab + e0);
#pragma unroll
                for (int tt = 0; tt < 2; ++tt) { const size_t tok = (size_t)(tok0 + 32 * tt + r); const u32x2 gg = ggv[g][tt];
                    const float g0 = __uint_as_float(gg.x << 16), g1 = __uint_as_float(gg.x & 0xffff0000u), g2 = __uint_as_float(gg.y << 16), g3 = __uint_as_float(gg.y & 0xffff0000u);
                    const float rs = tt ? rs1 : rs0;
                    float v0, v1, v2, v3;
                    if (GE) { v0 = (tt ? o1[4 * g] : o0[4 * g]) * rs * gsl[g][tt][0]; v1 = (tt ? o1[4 * g + 1] : o0[4 * g + 1]) * rs * gsl[g][tt][1]; v2 = (tt ? o1[4 * g + 2] : o0[4 * g + 2]) * rs * gsl[g][tt][2]; v3 = (tt ? o1[4 * g + 3] : o0[4 * g + 3]) * rs * gsl[g][tt][3]; }
                    else { v0 = (tt ? o1[4 * g] : o0[4 * g]) * rs * gn[0] * (g0 * __builtin_amdgcn_rcpf(1.0f + __expf(-g0))); v1 = (tt ? o1[4 * g + 1] : o0[4 * g + 1]) * rs * gn[1] * (g1 * __builtin_amdgcn_rcpf(1.0f + __expf(-g1)));
                        v2 = (tt ? o1[4 * g + 2] : o0[4 * g + 2]) * rs * gn[2] * (g2 * __builtin_amdgcn_rcpf(1.0f + __expf(-g2))); v3 = (tt ? o1[4 * g + 3] : o0[4 * g + 3]) * rs * gn[3] * (g3 * __builtin_amdgcn_rcpf(1.0f + __expf(-g3))); }
                    u32x2 p; p.x = cvtpk(v0, v1); p.y = cvtpk(v2, v3); *(u32x2*)(A.mix + tok * 2048 + A.mixoff + head * DV + e0) = p; } }
        }
        if (PARK || PADB || GVDB) asm volatile("s_waitcnt vmcnt(0)" ::: "memory");
        __syncthreads(); LIN_T(4);
    }
    if (!PB) {
        int tid_e = tid; asm volatile("" : "+v"(tid_e));
        const int th = tid_e - hs * NTH, d = th & 127, tq = th >> 7;
        float* sp = A.sloc + ((((size_t)ui * (DV / 32) + wl) * 4) * 64 + (tid_e & 63)) * 16;
#pragma unroll
        for (int dt = 0; dt < 4; ++dt)
#pragma unroll
            for (int g = 0; g < 4; ++g) *(f32x4*)(sp + dt * 1024 + 4 * g) = (f32x4){Sacc[dt][4 * g], Sacc[dt][4 * g + 1], Sacc[dt][4 * g + 2], Sacc[dt][4 * g + 3]};
        if (HGRN) { if ((th >> 5) == 0) {
#pragma unroll
            for (int e = 0; e < 4; ++e) A.dsc[ui * 128 + 4 * (th & 31) + e] = __expf(dsum8[e]); } }
        else if (th >= NTH - 16) {
#pragma unroll
            for (int e = 0; e < 8; ++e) A.dsc[ui * 128 + 8 * (th - (NTH - 16)) + e] = __expf(dsum8[e]); }
    }
}

namespace att {
constexpr int D = 128;
constexpr float SCALE = 0.08838834764831845f, INV_SCALE = 11.313708498984761f;
constexpr float THR = 8.f;
constexpr int NW = 8, QBLK = 32, KVBLK = 64, QB = NW * QBLK;
constexpr int SHM_V = KVBLK * D * 2, SHM_K = KVBLK * D * 2;
constexpr int LDS_CORE = 2 * SHM_V + 2 * SHM_K + NW * 64 * 4;
constexpr int OFF_BIAS = LDS_CORE, OFF_SEL = OFF_BIAS + 8192, OFF_KM = OFF_SEL + 1024, OFF_SCAN = OFF_KM + 3584, LDS_ATT = OFF_SCAN + 64;
static_assert(LDS_ATT <= MISC_OFF, "attention LDS");
#define KSWZ(row, colB) ((row) * 256 + ((colB) ^ (((row) & 7) << 4)))
#define SBAR() __builtin_amdgcn_sched_barrier(0)
__device__ __forceinline__ int v_st(int k, int c) { const int kk = (k & ~0xC) | ((k & 4) << 1) | ((k & 8) >> 1); return ((kk >> 3) * 4 + (c >> 5)) * 512 + ((kk & 7) * 32 + (c & 31)) * 2; }
__device__ __forceinline__ int v_rd_base(int lane) { return ((lane & 3) << 3) | (((lane >> 2) & 3) << 6) | (((lane >> 4) & 1) << 5) | (((lane >> 5) & 1) << 8); }
constexpr int v_rd_off(int d0, int ks, int half) { return d0 * 512 + ks * 4096 + half * 2048; }
__device__ __forceinline__ unsigned cvtpk_a(float lo, float hi) { unsigned r; asm volatile("v_cvt_pk_bf16_f32 %0, %1, %2" : "=v"(r) : "v"(lo), "v"(hi)); return r; }
__device__ __forceinline__ bf16x8 load8(const bf16* p) { return *reinterpret_cast<const bf16x8*>(p); }
__device__ __forceinline__ void mask_tile(f32x16& p0, f32x16& p1, int dq) {
    const float NEG = -__builtin_inff();
#pragma unroll
    for (int r = 0; r < 16; ++r) {
        const int c = (r & 3) + 8 * (r >> 2);
        if (dq - c < 0) p0[r] = NEG;
        if (dq - c - 32 < 0) p1[r] = NEG;
    }
}
__device__ __forceinline__ void partialSM(f32x16& p0, f32x16& p1, float& m_reg, float& mn, float& alpha, const bool keep) {
    float pmax = p0[0]; for (int r = 1; r < 16; ++r) pmax = fmaxf(pmax, p0[r]); for (int r = 0; r < 16; ++r) pmax = fmaxf(pmax, p1[r]);
    { auto rr = __builtin_amdgcn_permlane32_swap(__float_as_uint(pmax), __float_as_uint(pmax), false, false);
      pmax = fmaxf(__uint_as_float(rr[0]), __uint_as_float(rr[1])); }
    pmax = keep ? pmax : -__builtin_inff();
    constexpr float C2 = 1.4426950408889634f * SCALE;
    if (__builtin_expect(__all((pmax - m_reg) * SCALE <= THR), 1)) { mn = m_reg; alpha = 1.f; }
    else { mn = fmaxf(m_reg, pmax); alpha = __builtin_amdgcn_exp2f((m_reg - mn) * C2); m_reg = mn; }
    const float mnL = keep ? -mn * C2 : -__builtin_inff();
    for (int r = 0; r < 16; ++r) p0[r] = fmaf(p0[r], C2, mnL); for (int r = 0; r < 16; ++r) p1[r] = fmaf(p1[r], C2, mnL);
    for (int r = 0; r < 16; ++r) p0[r] = __builtin_amdgcn_exp2f(p0[r]);
}
__device__ __forceinline__ void finishSM(f32x16& p0, f32x16& p1, float alpha, float& l_reg, bf16x8& pa0, bf16x8& pa1, bf16x8& pa2, bf16x8& pa3) {
    for (int r = 0; r < 16; ++r) p1[r] = __builtin_amdgcn_exp2f(p1[r]);
    float ps = 0; for (int r = 0; r < 16; ++r) ps += p0[r]; for (int r = 0; r < 16; ++r) ps += p1[r];
    { auto rr = __builtin_amdgcn_permlane32_swap(__float_as_uint(ps), __float_as_uint(ps), false, false);
      ps = __uint_as_float(rr[0]) + __uint_as_float(rr[1]); }
    l_reg = l_reg * alpha + ps;
#define PK4(P, B_, OUT) do { unsigned a0 = cvtpk_a(P[B_+0], P[B_+1]), a1 = cvtpk_a(P[B_+2], P[B_+3]);                          \
        unsigned b0 = cvtpk_a(P[B_+4], P[B_+5]), b1 = cvtpk_a(P[B_+6], P[B_+7]);                                             \
        auto r0 = __builtin_amdgcn_permlane32_swap(a0, b0, false, false); auto r1 = __builtin_amdgcn_permlane32_swap(a1, b1, false, false); \
        u32x4 w = {r0[0], r1[0], r0[1], r1[1]}; OUT = *reinterpret_cast<bf16x8*>(&w); } while (0)
    PK4(p0, 0, pa0); PK4(p0, 8, pa1); PK4(p1, 0, pa2); PK4(p1, 8, pa3);
#undef PK4
}
template <int KB>
__device__ __forceinline__ void qkt(f32x16& p0, f32x16& p1, const char* K_lds, int r32, int hi, const bf16x8* qr, const float* bp) {
#pragma unroll
    for (int g = 0; g < 4; ++g) { const f32x4 b0 = *(const f32x4*)(bp + 8 * g), b1 = *(const f32x4*)(bp + 32 + 8 * g);
#pragma unroll
        for (int e = 0; e < 4; ++e) { p0[4 * g + e] = b0[e]; p1[4 * g + e] = b1[e]; } }
    const char* kb[4];
#pragma unroll
    for (int dd = 0; dd < 4; ++dd) kb[dd] = K_lds + KB * SHM_K + KSWZ(r32, (dd * 16 + hi * 8) * 2);
#pragma unroll
    for (int d0 = 0; d0 < 8; ++d0) { const char* a = kb[d0 & 3] + (d0 >> 2) * 128;
        bf16x8 b0 = *reinterpret_cast<const bf16x8*>(a);
        bf16x8 b1 = *reinterpret_cast<const bf16x8*>(a + 32 * 256);
        p0 = __builtin_amdgcn_mfma_f32_32x32x16_bf16(b0, qr[d0], p0, 0, 0, 0);
        p1 = __builtin_amdgcn_mfma_f32_32x32x16_bf16(b1, qr[d0], p1, 0, 0, 0); }
}
template <int VB>
__device__ __forceinline__ void pv_tile(f32x16* o, int vb0, bf16x8 pa0, bf16x8 pa1, bf16x8 pa2, bf16x8 pa3) {
#define TRRD(dst, off) asm volatile("ds_read_b64_tr_b16 %0, %1 offset:%2" : "=&v"(dst) : "v"(vb0), "i"(off) : "memory")
#define PV_D0(d0) do { s16x4 l0, l1, l2, l3, h0, h1, h2, h3; constexpr int b_ = VB * SHM_V + v_rd_off(d0, 0, 0);   \
        TRRD(l0, b_); TRRD(h0, b_ + 2048); TRRD(l1, b_ + 4096); TRRD(h1, b_ + 6144); TRRD(l2, b_ + 8192); TRRD(h2, b_ + 10240); TRRD(l3, b_ + 12288); TRRD(h3, b_ + 14336); \
        asm volatile("s_waitcnt lgkmcnt(0)" ::: "memory"); SBAR();   \
        o[d0] = __builtin_amdgcn_mfma_f32_32x32x16_bf16(pa0, (bf16x8){l0[0], l0[1], l0[2], l0[3], h0[0], h0[1], h0[2], h0[3]}, o[d0], 0, 0, 0);   \
        o[d0] = __builtin_amdgcn_mfma_f32_32x32x16_bf16(pa1, (bf16x8){l1[0], l1[1], l1[2], l1[3], h1[0], h1[1], h1[2], h1[3]}, o[d0], 0, 0, 0);   \
        o[d0] = __builtin_amdgcn_mfma_f32_32x32x16_bf16(pa2, (bf16x8){l2[0], l2[1], l2[2], l2[3], h2[0], h2[1], h2[2], h2[3]}, o[d0], 0, 0, 0);   \
        o[d0] = __builtin_amdgcn_mfma_f32_32x32x16_bf16(pa3, (bf16x8){l3[0], l3[1], l3[2], l3[3], h3[0], h3[1], h3[2], h3[3]}, o[d0], 0, 0, 0); } while (0)
    PV_D0(0); PV_D0(1); PV_D0(2); PV_D0(3);
#undef PV_D0
#undef TRRD
}
struct Blk { const bf16* u; int tokb, qcol, kcol, vcol; bf16* O; int P0; };
struct Seam { bf16x8 qr[8]; bf16x8 st_v0, st_v1, st_k0, st_k1; };
#define ROW(colbase, k0, rr) (Ub + UOFF(tokb_ + (k0) + (rr), (colbase) + sc, pitch))
#define VMW() asm volatile("s_waitcnt vmcnt(0)" ::: "memory")
#define VMWN(n) asm volatile("s_waitcnt vmcnt(%0)" :: "i"(n) : "memory")
#define SLOAD_H(Kp, Vp, k0) do { S.st_v0 = load8(ROW(Vp, k0, sr)); S.st_v1 = load8(ROW(Vp, k0, 32 + sr));              \
                         S.st_k0 = load8(ROW(Kp, k0, sr)); S.st_k1 = load8(ROW(Kp, k0, 32 + sr)); } while (0)
#define SWRITE_HK(bf) do { *(bf16x8*)(K_lds + (bf) * SHM_K + kws) = S.st_k0; *(bf16x8*)(K_lds + (bf) * SHM_K + kws + 32 * 256) = S.st_k1; } while (0)
#define SWRITE_HV(bf) do { *(bf16x8*)(V_lds + (bf) * SHM_V + vst0) = S.st_v0; *(bf16x8*)(V_lds + (bf) * SHM_V + vst1) = S.st_v1; } while (0)
#define SWRITE_H(bf) do { SWRITE_HV(bf); SWRITE_HK(bf); } while (0)
__device__ __forceinline__ void prime(const Blk& cur, char* lds, Seam& S, const int pitch) {
    const int tid = otid(), wid = __builtin_amdgcn_readfirstlane(tid >> 6), lane = tid & 63, r32 = lane & 31, hi = lane >> 5;
    const int sr = tid >> 4, sc = (tid & 15) * 8, kws = KSWZ(sr, sc * 2); char* K_lds = lds + 2 * SHM_V;
    const bf16* Ub = cur.u; const int tokb_ = cur.tokb;
    for (int d0 = 0; d0 < 8; ++d0) S.qr[d0] = load8(cur.u + UOFF(cur.tokb + cur.P0 + wid * QBLK + r32, cur.qcol + d0 * 16 + hi * 8, pitch));
    SLOAD_H(cur.kcol, cur.vcol, 0); VMW(); SWRITE_HK(0);
    __syncthreads();
}
__device__ __forceinline__ void block(const Blk& cur, const Blk& nxt, char* lds, Seam& S, const int pitch, const int opitch, const unsigned selbits, const float* biasL) {
    const int tid = otid(), wid = __builtin_amdgcn_readfirstlane(tid >> 6), lane = tid & 63, r32 = lane & 31, hi = lane >> 5;
    const int NT = cur.P0 / KVBLK + QB / KVBLK;
    const int qbn = cur.P0 >> 8;
    const int qlo = cur.P0 + wid * QBLK, qm = qlo + r32 - 4 * hi;
    char* V_lds = lds; char* K_lds = lds + 2 * SHM_V;
    float* ws = (float*)(lds + 2 * SHM_V + 2 * SHM_K) + wid * 64; float* li_l = ws, * al_l = ws + 32;
    float m_reg = -1e30f, l_reg = 0; f32x16 o[4] = {};
    const int sr = tid >> 4, sc = (tid & 15) * 8, vst0 = v_st(sr, sc), vst1 = v_st(32 + sr, sc), kws = KSWZ(sr, sc * 2);
    const int vb0 = (int)(uintptr_t)V_lds + v_rd_base(lane);
    const int Kh = cur.kcol, Vh = cur.vcol; const bf16* Ub = cur.u; const int tokb_ = cur.tokb;
#define RESC(a) do { if (__any((a) < 1.f)) { if (hi == 0) al_l[r32] = (a); asm volatile("s_waitcnt lgkmcnt(0)" ::: "memory");              \
                     for (int d_ = 0; d_ < 4; ++d_) for (int r = 0; r < 16; ++r) o[d_][r] *= al_l[crow(r, hi)]; } } while (0)
#define KBASE(t) ((t) * KVBLK)
#define MASKT(P0_, P1_, t) do { const int kb_ = KBASE(t); if ((kb_ >> 8) >= qbn && kb_ + KVBLK - 1 > qlo) mask_tile(P0_, P1_, qm - kb_); } while (0)
#define KEEPT(t) ((((t) * KVBLK) >> 8) >= qbn || ((selbits >> (((t) * KVBLK) >> 8)) & 1u))
#define BIASP(t) (biasL + KBASE(t) + 4 * hi)
    constexpr int NQL = 8;
#define SEAM_K0() do { VMWN(NQL); SWRITE_HK(0); SBAR(); } while (0)
    f32x16 pA0, pA1, pB0, pB1; float mnA, mnB, alA, alB; bf16x8 pa0, pa1, pa2, pa3;
    SWRITE_HV(0); SBAR();
    SLOAD_H(Kh, Vh, KBASE(1));
    SBAR(); qkt<0>(pA0, pA1, K_lds, r32, hi, S.qr, BIASP(0));
    MASKT(pA0, pA1, 0); partialSM(pA0, pA1, m_reg, mnA, alA, KEEPT(0));
    VMW(); SWRITE_H(1);
    __syncthreads();
#define HALF_STEP(PX0, PX1, mnX, alX, PY0, PY1, alY, t, KB, VB, SB) do {                                                      \
        SBAR(); qkt<KB>(PX0, PX1, K_lds, r32, hi, S.qr, BIASP(t));                                                           \
        finishSM(PY0, PY1, alY, l_reg, pa0, pa1, pa2, pa3); SBAR();                                                           \
        if ((t) + 1 < NT) { SLOAD_H(Kh, Vh, KBASE((t) + 1)); SBAR(); }                                                        \
        pv_tile<VB>(o, vb0, pa0, pa1, pa2, pa3); MASKT(PX0, PX1, (t)); partialSM(PX0, PX1, m_reg, mnX, alX, KEEPT(t));        \
        __syncthreads();                                                                                                      \
        if ((t) + 1 < NT) { VMW(); SWRITE_H(SB); }                                                                            \
        RESC(alX); __syncthreads(); } while (0)
    for (int t = 1; t + 1 < NT; t += 2) {
        HALF_STEP(pB0, pB1, mnB, alB, pA0, pA1, alA, t, 1, 0, 0);
        HALF_STEP(pA0, pA1, mnA, alA, pB0, pB1, alB, t + 1, 0, 1, 1);
    }
    SBAR(); qkt<1>(pB0, pB1, K_lds, r32, hi, S.qr, BIASP(NT - 1)); SBAR();
    SLOAD_H(nxt.kcol, nxt.vcol, 0); SBAR();
#pragma unroll
    for (int d0 = 0; d0 < 8; ++d0) S.qr[d0] = load8(nxt.u + UOFF(nxt.tokb + nxt.P0 + wid * QBLK + r32, nxt.qcol + d0 * 16 + hi * 8, pitch));
    SBAR();
    finishSM(pA0, pA1, alA, l_reg, pa0, pa1, pa2, pa3); SBAR();
    pv_tile<0>(o, vb0, pa0, pa1, pa2, pa3);
    MASKT(pB0, pB1, NT - 1); partialSM(pB0, pB1, m_reg, mnB, alB, true); __syncthreads(); RESC(alB);
    finishSM(pB0, pB1, alB, l_reg, pa0, pa1, pa2, pa3); SBAR(); pv_tile<1>(o, vb0, pa0, pa1, pa2, pa3);
    SBAR(); SEAM_K0();
#ifdef PROBE_ATT
    unsigned long long te_ = 0; if (threadIdx.x == 0) te_ = __builtin_amdgcn_s_memrealtime();
#endif
    if (hi == 0) li_l[r32] = l_reg; asm volatile("s_waitcnt lgkmcnt(0)" ::: "memory");
    float rli[16];
#pragma unroll
    for (int r = 0; r < 16; ++r) rli[r] = __builtin_amdgcn_rcpf(li_l[crow(r, hi)]);
    bf16* Ow = cur.O + (size_t)(wid * QBLK) * opitch;
#pragma unroll
    for (int r = 0; r < 16; ++r) { const int orow = crow(r, hi);
#pragma unroll
        for (int d0 = 0; d0 < 4; ++d0) { const float v = o[d0][r] * rli[r];
            const float vn = __shfl_xor(v, 1);
            if ((r32 & 1) == 0) *(unsigned*)(Ow + (size_t)orow * opitch + d0 * 32 + r32) = cvtpk_a(v, vn); } }
    __syncthreads();
#ifdef PROBE_ATT
    if (PROBE_ATT == 2 && threadIdx.x == 0) ((volatile unsigned*)(lds + MISC_OFF))[20] += (unsigned)(__builtin_amdgcn_s_memrealtime() - te_);
#endif
#undef RESC
#undef KBASE
#undef MASKT
#undef KEEPT
#undef BIASP
#undef SEAM_K0
#undef HALF_STEP
}
#undef ROW
#undef VMW
#undef VMWN
#undef SLOAD_H
#undef SWRITE_HK
#undef SWRITE_HV
#undef SWRITE_H

__device__ __forceinline__ void setup(char* lds, const int mode, const Blk& cur, const int pitch, const int b, const int h, const float* kmean, const float* ff, const float* fbias, const int pass) {
    const int tid = otid(), lane = tid & 63, wave = tid >> 6;
    float* biasL = (float*)(lds + OFF_BIAS); unsigned* selm = (unsigned*)(lds + OFF_SEL); float* kms = (float*)(lds + OFF_KM); float* scanw = (float*)(lds + OFF_SCAN);
    const int qb = cur.P0 >> 8;
    if (mode == 0) {
        const float slope = exp2f(-(float)(h + 1)) * INV_SCALE;
        if (qb > 3) for (int i = tid; i < qb * 128; i += 512) kms[i] = kmean[(size_t)((b * 8 + h) * 8) * 128 + i];
        for (int s = tid; s < cur.P0 + 256; s += 512) biasL[s] = slope * (float)(s - cur.P0);
        __syncthreads();
        const int row = tid >> 1, dh = tid & 1;
        unsigned bits = (1u << qb) - 1u;
        if (qb > 3) {
            float acc[7] = {0.f, 0.f, 0.f, 0.f, 0.f, 0.f, 0.f};
            bf16x8 qv8[8];
#pragma unroll
            for (int c = 0; c < 8; ++c) qv8[c] = load8(cur.u + UOFF(cur.tokb + cur.P0 + row, cur.qcol + 64 * dh + 8 * c, pitch));
            asm volatile("" ::: "memory");
#pragma unroll
            for (int c = 0; c < 8; ++c) { const bf16x8 qv = qv8[c];
#pragma unroll
                for (int e = 0; e < 8; ++e) { const float qf = bf2f((unsigned short)qv[e]);
#pragma unroll
                    for (int n = 0; n < 7; ++n) acc[n] += qf * kms[n * 128 + 64 * dh + 8 * c + e]; } }
#pragma unroll
            for (int n = 0; n < 7; ++n) acc[n] += __shfl_xor(acc[n], 1);
            bits = 0u;
#pragma unroll
            for (int pick = 0; pick < 3; ++pick) { float best = -__builtin_inff(); int bi = 0;
#pragma unroll
                for (int n = 0; n < 7; ++n) if (n < qb && !((bits >> n) & 1u) && acc[n] > best) { best = acc[n]; bi = n; }
                bits |= 1u << bi; }
        }
        if (dh == 0) selm[row] = bits;
        __syncthreads();
    } else if (pass != 0) {
        const float bref = biasL[cur.P0];
        __syncthreads();
#pragma unroll
        for (int i = 0; i < 4; ++i) biasL[4 * tid + i] -= bref;
        __syncthreads();
    } else {
        const float fb = fbias[h];
        float v[4]; float run = 0.f;
#pragma unroll
        for (int i = 0; i < 4; ++i) v[i] = ff[(size_t)(b * SEQ + 4 * tid + i) * 8 + h];
        asm volatile("" ::: "memory");
#pragma unroll
        for (int i = 0; i < 4; ++i) { run += log_sigmoid(v[i] + fb); v[i] = run; }
        float incl = run;
#pragma unroll
        for (int o = 1; o < 64; o <<= 1) { const float t = __shfl_up(incl, o); if (lane >= o) incl += t; }
        if (lane == 63) scanw[wave] = incl;
        __syncthreads();
        float off = incl - run;
        for (int w = 0; w < wave; ++w) off += scanw[w];
#pragma unroll
        for (int i = 0; i < 4; ++i) { v[i] += off; biasL[4 * tid + i] = v[i]; }
        __syncthreads();
        const float cref = biasL[cur.P0];
        __syncthreads();
#pragma unroll
        for (int i = 0; i < 4; ++i) biasL[4 * tid + i] = (cref - v[i]) * INV_SCALE;
        if (tid < 256) selm[tid] = 0xffu;
        __syncthreads();
    }
}
__device__ __forceinline__ void pair_item(char* lds, const int item, const int mode, const bf16* u, const int pitch, const int qoff, const int koff, const int voff,
                                          bf16* mix, const int mixoff, const float* kmean, const float* ff, const float* fbias) {
    const int bh = item >> 2, x = item & 3, b = bh >> 3, h = bh & 7;
    bf16* obase = mix + (size_t)(b * SEQ) * 2048 + mixoff + h * 128;
    const float* biasL = (const float*)(lds + OFF_BIAS); const unsigned* selm = (const unsigned*)(lds + OFF_SEL);
    Blk cur;
    cur.P0 = x * 256; cur.u = u; cur.tokb = b * SEQ; cur.qcol = qoff + h * 128; cur.kcol = koff + h * 128; cur.vcol = voff + h * 128; cur.O = obase + (size_t)cur.P0 * 2048;
    Seam S;
    for (int pass = 0; pass < 2; ++pass) {
#ifdef PROBE_ATT
        unsigned long long ta_ = 0; if (threadIdx.x == 0) ta_ = __builtin_amdgcn_s_memrealtime();
#endif
        setup(lds, mode, cur, pitch, b, h, kmean, ff, fbias, pass);
#ifdef PROBE_ATT
        if (threadIdx.x == 0) { const unsigned long long tb_ = __builtin_amdgcn_s_memrealtime(); if (PROBE_ATT == 0 && mode == PROBE_ATT_MODE) ((volatile unsigned*)(lds + MISC_OFF))[20] += (unsigned)(tb_ - ta_); ta_ = tb_; }
#endif
        if (pass == 0) prime(cur, lds, S, pitch);
        Blk nxt = cur;
        if (pass == 0) { nxt.P0 = (7 - x) * 256; nxt.O = obase + (size_t)nxt.P0 * 2048; }
        const int t_ = otid();
        const unsigned sel = selm[(t_ >> 6) * 32 + (t_ & 31)];
        block(cur, nxt, lds, S, pitch, 2048, sel, biasL);
#ifdef PROBE_ATT
        if (threadIdx.x == 0) { const unsigned long long tb_ = __builtin_amdgcn_s_memrealtime(); if (PROBE_ATT == 1 && mode == PROBE_ATT_MODE) ((volatile unsigned*)(lds + MISC_OFF))[20] += (unsigned)(tb_ - ta_); }
#endif
        cur = nxt;
    }
}
}

template <int DV, bool HGRN>
__device__ __forceinline__ void ref_lin(LAS unsigned char* lds, const int tid, const int G, const bf16* u, const int pitch, const int qoff, const int koff, const int voff, const int goff,
                                        const float* glr, const float* w2, const float* gb, const float* lbraw, const float* gain, bf16* mix, const int mixoff) {
    constexpr int NDP = 512 / DV, DPP = 128 / NDP, NHEADS = HGRN ? 8 : 4, TPG = 16 / NDP, NWG = DV / 64;
    LAS float* qs = (LAS float*)lds; LAS float* ks = qs + 16 * 128; LAS float* dcs = ks + 16 * 128; LAS float* ored = dcs + 16 * 128; LAS float* wred = ored + NDP * 16 * DV;
    const int e = tid % DV, dp = tid / DV, lane = tid & 63, wave = tid >> 6;
    for (int unit = blockIdx.x; unit < NB * NHEADS; unit += G) {
        const int b = unit / NHEADS, head = unit % NHEADS;
        float S[DPP];
#pragma unroll
        for (int i = 0; i < DPP; ++i) S[i] = 0.f;
        for (int t0 = 0; t0 < SEQ; t0 += 16) {
            for (int idx = tid; idx < 16 * 128; idx += 512) { const int tt = idx >> 7, d = idx & 127; const size_t tok = (size_t)(b * SEQ + t0 + tt);
                float q, k, dc;
                if (!HGRN) { float z = gb[head * 128 + d]; for (int r = 0; r < 16; ++r) z += glr[tok * 16 + r] * w2[r * 512 + head * 128 + d];
                    dc = expf(log_sigmoid(z) * (1.0f / 16.0f)); q = bf2f(u[UOFF((int)tok, qoff + head * 128 + d, pitch)]) * QSCALE; k = bf2f(u[UOFF((int)tok, koff + head * 128 + d, pitch)]); }
                else { const float lb = sigmoidf(lbraw[1024 + head * 128 + d] - lbraw[head * 128 + d]); const float f = lb + (1.f - lb) * sigmoidf(bf2f(u[UOFF((int)tok, koff + head * 128 + d, pitch)]));
                    dc = f; k = 1.f - f; const float hq = bf2f(u[UOFF((int)tok, qoff + head * 128 + d, pitch)]); q = hq * sigmoidf(hq); }
                qs[idx] = q; ks[idx] = k; dcs[idx] = dc; }
            __syncthreads();
            for (int tt = 0; tt < 16; ++tt) { const size_t tok = (size_t)(b * SEQ + t0 + tt); const float v = bf2f(u[UOFF((int)tok, voff + head * DV + e, pitch)]); float op = 0.f;
#pragma unroll
                for (int i = 0; i < DPP; ++i) { const int d = dp * DPP + i; S[i] = dcs[tt * 128 + d] * S[i] + ks[tt * 128 + d] * v; op += S[i] * qs[tt * 128 + d]; }
                ored[(dp * 16 + tt) * DV + e] = op; }
            __syncthreads();
            float ov[TPG];
#pragma unroll
            for (int j = 0; j < TPG; ++j) { const int tt = dp * TPG + j; float o = 0.f;
#pragma unroll
                for (int p = 0; p < NDP; ++p) o += ored[(p * 16 + tt) * DV + e];
                ov[j] = o; const float sq = wave_sum(o * o); if (lane == 0) wred[wave * TPG + j] = sq; }
            __syncthreads();
#pragma unroll
            for (int j = 0; j < TPG; ++j) { const int tt = dp * TPG + j; float tot = 0.f;
#pragma unroll
                for (int w = 0; w < NWG; ++w) tot += wred[(dp * NWG + w) * TPG + j];
                const float rs = 1.0f / sqrtf(tot * (1.0f / DV) + EPS); const size_t tok = (size_t)(b * SEQ + t0 + tt);
                const float g = bf2f(u[UOFF((int)tok, goff + head * DV + e, pitch)]);
                mix[tok * 2048 + mixoff + head * DV + e] = f2bf(ov[j] * rs * gain[e] * (g * sigmoidf(g))); }
            __syncthreads();
        }
    }
}
__device__ __forceinline__ void ref_cfox(const float* ff, const float* fbias, float* cfox, const int G, const int tid) {
    const int gid = blockIdx.x * 512 + tid;
    if (gid < 64) { const int b = gid >> 3, h = gid & 7; float run = 0.f;
        for (int s = 0; s < SEQ; ++s) { run += log_sigmoid(ff[(size_t)(b * SEQ + s) * 8 + h] + fbias[h]); cfox[(size_t)gid * SEQ + s] = run; } }
}
__device__ __forceinline__ void ref_att(LAS unsigned char* lds, const int tid, const int G, const int mode, const bf16* u, const int pitch, const int qoff, const int koff, const int voff,
                                        bf16* mix, const int mixoff, const float* kmean, const float* cfox) {
    const int lane = tid & 63, wave = tid >> 6;
    LAS float* qf = (LAS float*)lds + wave * 128;
    for (int rowid = blockIdx.x * NWAVES + wave; rowid < NB * 8 * SEQ; rowid += G * NWAVES) {
        const int b = rowid >> 14, h = (rowid >> 11) & 7, t = rowid & 2047, j = t >> 8;
        const unsigned qq = *(const unsigned*)(u + UOFF(b * SEQ + t, qoff + h * 128 + 2 * lane, pitch));
        const float q0 = __uint_as_float(qq << 16), q1 = __uint_as_float(qq & 0xffff0000u);
        qf[2 * lane] = q0; qf[2 * lane + 1] = q1;
        unsigned bits = 0xffu;
        if (mode == 0) {
            float gate[7];
#pragma unroll
            for (int n = 0; n < 7; ++n) { const float* km = kmean + (size_t)((b * 8 + h) * 8 + n) * 128; gate[n] = wave_sum(q0 * km[2 * lane] + q1 * km[2 * lane + 1]); }
            if (j <= 3) bits = (1u << j) - 1u;
            else { bits = 0u;
#pragma unroll
                for (int pick = 0; pick < 3; ++pick) { float best = -__builtin_inff(); int bi = 0;
#pragma unroll
                    for (int n = 0; n < 7; ++n) if (n < j && !((bits >> n) & 1u) && gate[n] > best) { best = gate[n]; bi = n; }
                    bits |= 1u << bi; } }
        }
        const float slope = exp2f(-(float)(h + 1));
        const float ct = mode ? cfox[(size_t)(b * 8 + h) * SEQ + t] : 0.f;
        float m = -1e30f, l = 0.f, o0 = 0.f, o1 = 0.f;
        for (int kb = 0; kb <= t; kb += 64) {
            const int s = kb + lane; const int sc = s <= t ? s : t;
            bool valid = s <= t;
            if (mode == 0 && valid) { const int n = s >> 8; valid = (n == j) || ((bits >> n) & 1u); }
            float dot = 0.f;
            for (int c = 0; c < 16; ++c) { const bf16x8 kv = *(const bf16x8*)(u + UOFF(b * SEQ + sc, koff + h * 128 + 8 * c, pitch));
#pragma unroll
                for (int e = 0; e < 8; ++e) dot += qf[8 * c + e] * bf2f((unsigned short)kv[e]); }
            const float bias = mode ? (ct - cfox[(size_t)(b * 8 + h) * SEQ + sc]) : -slope * (float)(t - sc);
            const float logit = valid ? dot * QSCALE + bias : -__builtin_inff();
            const float mx = wave_max(logit), mnew = fmaxf(m, mx), alpha = expf(m - mnew);
            const float p = valid ? expf(logit - mnew) : 0.f;
            l = l * alpha + wave_sum(p); o0 *= alpha; o1 *= alpha; m = mnew;
            const int nk = (t - kb + 1) < 64 ? (t - kb + 1) : 64;
            for (int jj = 0; jj < nk; ++jj) { const float pj = __shfl(p, jj); const unsigned vv = *(const unsigned*)(u + UOFF(b * SEQ + kb + jj, voff + h * 128 + 2 * lane, pitch));
                o0 += pj * __uint_as_float(vv << 16); o1 += pj * __uint_as_float(vv & 0xffff0000u); }
        }
        const float inv = 1.0f / l;
        *(unsigned*)(mix + (size_t)(b * SEQ + t) * 2048 + mixoff + h * 128 + 2 * lane) = cvtpk(o0 * inv, o1 * inv);
    }
}

#ifndef ONE_LAUNCH
#define ONE_LAUNCH 1
#endif
#ifndef REF_LIN0
#define REF_LIN0 0
#endif
#ifndef REF_LIN1
#define REF_LIN1 0
#endif
#ifndef REF_ATT0
#define REF_ATT0 0
#endif
#ifndef REF_ATT1
#define REF_ATT1 0
#endif
#ifndef PROBES
#define PROBES 0
#endif
#if PROBES
#define KV(x) (K->variant & (x))
#else
#define KV(x) 0
#endif
#ifndef PG_SP2
#define PG_SP2 true
#endif
#ifndef PG_ALIGN
#define PG_ALIGN true
#endif
#ifndef STAGGER_STEPS
#define STAGGER_STEPS 0
#endif
#define STAGGER() do { if (STAGGER_STEPS > 0) { const int n_ = (int)((blockIdx.x >> 3) & 15u); for (int i_ = 0; i_ < n_; ++i_) __builtin_amdgcn_s_sleep(STAGGER_STEPS); } } while (0)
constexpr int N_PHASES = 20;
__global__ void __launch_bounds__(NWAVES * 64, 2) fwd(Args a_unused) {
    extern __shared__ __attribute__((aligned(16))) unsigned char lds_raw[];
    LAS unsigned char* lds = (LAS unsigned char*)lds_raw;
    volatile LAS unsigned* MISC = (volatile LAS unsigned*)(lds + MISC_OFF);
    const int G = gridDim.x;
    if (threadIdx.x < 64) MISC[threadIdx.x] = 0u;
    __syncthreads();
    int lo, hi;
    XcdBarrier bar;
    { KArgsP K = kargs(); lo = K->ph_lo; hi = K->ph_hi; unsigned char* ws = K->ws;
      bar.bar = (unsigned*)(ws + WS_CTL) + CW_BAR; bar.x = 0; bar.st = nullptr;
      if (hi - lo > 1) bar = xcd_barrier_post((unsigned*)(ws + WS_CTL) + CW_BAR, MISC + 8); }
#define PH(k) (lo <= (k) && (k) < hi)
#ifndef SEAM_REPS
#define SEAM_REPS 1
#endif
#ifndef PROBE_WAIT_MASK
#define PROBE_WAIT_MASK 0xffffffffu
#endif
#ifdef PROBE_WAIT
#define SEAM(k) do { if (PH(k) && PH((k) + 1)) { unsigned long long t0_ = 0; if (threadIdx.x == 0) t0_ = __builtin_amdgcn_s_memrealtime(); xcd_barrier(bar); \
        if (threadIdx.x == 0 && ((PROBE_WAIT_MASK >> (k)) & 1u)) MISC[20] += (unsigned)(__builtin_amdgcn_s_memrealtime() - t0_); } } while (0)
#else
#define SEAM(k) do { if (PH(k) && PH((k) + 1)) { for (int r_ = 0; r_ < SEAM_REPS; ++r_) xcd_barrier(bar); } } while (0)
#endif
#define WSP(T, off) ((T*)(ws + (off)))

    if (PH(0)) { KArgsP K = kargs(); const int tid = otid(), lane = tid & 63, wave = __builtin_amdgcn_readfirstlane(tid >> 6); (void)lane; (void)wave; if (!KV(32)) phase_transposes(lds, K, G, wave, lane); __syncthreads(); if (!KV(64)) phase_norm0(lds, K, G, tid, wave, lane); __syncthreads(); }
    SEAM(0);
    for (int layer = 0; layer < 2; ++layer) {
        const int pb = 1 + 9 * layer;
        if (PH(pb + 0)) {
            KArgsP K = kargs(); const int tid = otid(), lane = tid & 63, wave = __builtin_amdgcn_readfirstlane(tid >> 6); (void)lane; (void)wave; unsigned char* ws = K->ws; const int NU = layer ? NU1 : NU0;
            const bf16* h16 = (const bf16*)((unsigned char*)K->out + OUT_H16);
            if (layer == 1) phase_ff(lds, K->in[11], K->in[10], h16, WSP(float, WS_ROWSS2), WSP(float, WS_FF), G, tid, wave, lane);
            pg8::Gemm g{h16, WSP(bf16, layer ? WS_WIN1 : WS_WIN0), MTOK, NU, DM, KV(4), 1, WTILED}; pg8::StaticOrder S; S.init(MTOK, NU, G, (int)blockIdx.x);
            int pm0 = -1; { pg8::Unit u0; if (S.next(0, u0)) pm0 = u0.pm; }
            LAS float* rtab = (LAS float*)(lds + 131072);
            if (pm0 >= 0 && tid < 256) { const f32x4* pp = (const f32x4*)(WSP(float, layer ? WS_ROWSS2 : WS_ROWSS) + (size_t)(pm0 * 256 + tid) * 32); float sq = 0.f;
#pragma unroll
                for (int q = 0; q < 8; ++q) { const f32x4 t = pp[q]; sq += (t[0] + t[1]) + (t[2] + t[3]); }
                rtab[tid] = __builtin_amdgcn_rsqf(sq * (1.0f / 2048.0f) + EPS); }
            __syncthreads();
            pg8::EpiScale<0, UTILED != 0> E{WSP(bf16, WS_U), NU, WSP(float, layer ? WS_ROWSS2 : WS_ROWSS), 0, rtab, pm0};
            STAGGER();
            pg8::gemm_phase<pg8::EpiScale<0, UTILED != 0>, pg8::StaticOrder, PG_ALIGN, PG_SP2>(lds, g, S, E);
        }
        SEAM(pb + 0);
        if (PH(pb + 1)) {
            KArgsP K = kargs(); const int tid = otid(), lane = tid & 63, wave = __builtin_amdgcn_readfirstlane(tid >> 6); (void)lane; (void)wave; unsigned char* ws = K->ws;
            if (layer == 0) {
#ifdef PROBE_KMEAN
                unsigned long long tk_ = 0; if (threadIdx.x == 0) tk_ = __builtin_amdgcn_s_memrealtime();
#endif
                phase_kmean(lds, WSP(bf16, WS_U), WSP(float, WS_KMEAN), G, tid);
#ifdef PROBE_KMEAN
                __syncthreads(); if (threadIdx.x == 0) MISC[20] += (unsigned)(__builtin_amdgcn_s_memrealtime() - tk_);
#endif
#if !REF_LIN0
                LinArgs L{WSP(bf16, WS_U), NU0, C0_GQ, C0_GK, C0_GV, C0_GG, WSP(float, WS_BCUM), nullptr, K->in[5], WSP(float, WS_P), WSP(float, WS_DSC), WSP(bf16, WS_S), WSP(bf16, WS_P), 0};
                for (int unit = blockIdx.x; unit < 256; unit += G) { const int sc = unit & 7; if (sc < 7) lin_unit<256, 8, false, false>(lds, tid, L, unit >> 5, (unit >> 3) & 3, sc); }
#endif
            } else {
#if !REF_LIN1
                LinArgs L{WSP(bf16, WS_U), NU1, C1_HQ, C1_HF, C1_HI, C1_HG, nullptr, K->in[18], K->in[13], WSP(float, WS_P), WSP(float, WS_DSC), WSP(bf16, WS_S), WSP(bf16, WS_P), 1024};
                for (int unit = blockIdx.x; unit < 256; unit += G) { const int sc = unit & 7; if (sc < 7) lin_unit<128, 4, true, false>(lds, tid, L, unit >> 5, 2 * ((unit >> 3) & 3), sc); }
#endif
            }
        }
        SEAM(pb + 1);
        if (PH(pb + 2)) {
            KArgsP K = kargs(); const int tid = otid(), lane = tid & 63, wave = __builtin_amdgcn_readfirstlane(tid >> 6); (void)lane; (void)wave; unsigned char* ws = K->ws; (void)ws;
#ifdef PROBE_BURN
            if (KV(16)) {
                const bf16x8 a0 = *(const bf16x8*)(WSP(bf16, WS_U) + (size_t)tid * 64), b0 = *(const bf16x8*)(WSP(bf16, WS_U) + (size_t)tid * 64 + 8);
                const bf16x8 a1 = *(const bf16x8*)(WSP(bf16, WS_U) + (size_t)tid * 64 + 16), b1 = *(const bf16x8*)(WSP(bf16, WS_U) + (size_t)tid * 64 + 24);
                f32x4 acc[16];
#pragma unroll
                for (int i = 0; i < 16; ++i) acc[i] = (f32x4){0.f, 0.f, 0.f, 0.f};
                for (int it = 0; it < 32768 / 16; ++it) {
#pragma unroll
                    for (int i = 0; i < 16; ++i) acc[i] = __builtin_amdgcn_mfma_f32_16x16x32_bf16((i & 1) ? a1 : a0, (i & 2) ? b1 : b0, acc[i], 0, 0, 0);
                }
                float sum = 0.f;
#pragma unroll
                for (int i = 0; i < 16; ++i) sum += acc[i][0] + acc[i][1] + acc[i][2] + acc[i][3];
                if (sum == 1.2345f) WSP(float, WS_CFOX)[tid] = sum;
            } else
#endif
            if (layer == 0) {
#if !REF_LIN0
                phase_scan<256>(WSP(float, WS_P), WSP(float, WS_DSC), WSP(bf16, WS_S), G, tid);
#endif
            } else {
#if !REF_LIN1
                phase_scan<128>(WSP(float, WS_P), WSP(float, WS_DSC), WSP(bf16, WS_S), G, tid);
#endif
#if REF_ATT1
                ref_cfox(WSP(float, WS_FF), K->in[12], WSP(float, WS_CFOX), G, tid);
#endif
            }
        }
        SEAM(pb + 2);
        if (PH(pb + 3)) {
            KArgsP K = kargs(); const int tid = otid(), lane = tid & 63, wave = __builtin_amdgcn_readfirstlane(tid >> 6); (void)lane; (void)wave; unsigned char* ws = K->ws;
            const int variant = KV(0xff);
            if (variant & 1) {} else
            if (layer == 0) {
#if REF_LIN0
                ref_lin<256, false>(lds, tid, G, WSP(bf16, WS_U), NU0, C0_GQ, C0_GK, C0_GV, C0_GG, WSP(float, WS_GLR), K->in[3], K->in[4], nullptr, K->in[5], WSP(bf16, WS_P), 0);
#else
                { LinArgs L{WSP(bf16, WS_U), NU0, C0_GQ, C0_GK, C0_GV, C0_GG, WSP(float, WS_BCUM), nullptr, K->in[5], WSP(float, WS_P), WSP(float, WS_DSC), WSP(bf16, WS_S), WSP(bf16, WS_P), 0};
#ifdef PROBE_LINB
                  unsigned long long tl_ = 0; if (PROBE_LINB == 0 && threadIdx.x == 0) tl_ = __builtin_amdgcn_s_memrealtime();
#endif
                  for (int unit = blockIdx.x; unit < 256; unit += G) lin_unit<256, 8, false, true>(lds, tid, L, unit >> 5, (unit >> 3) & 3, unit & 7);
#ifdef PROBE_LINB
                if (PROBE_LINB == 0 && threadIdx.x == 0) MISC[20] += (unsigned)(__builtin_amdgcn_s_memrealtime() - tl_);
#endif
                }
#endif
#if REF_ATT0
                ref_att(lds, tid, G, 0, WSP(bf16, WS_U), NU0, C0_MQ, C0_MK, C0_MV, WSP(bf16, WS_P), 1024, WSP(float, WS_KMEAN), nullptr);
#endif
            } else {
#if REF_LIN1
                ref_lin<128, true>(lds, tid, G, WSP(bf16, WS_U), NU1, C1_HQ, C1_HF, C1_HI, C1_HG, nullptr, nullptr, nullptr, K->in[18], K->in[13], WSP(bf16, WS_P), 1024);
#else
                { LinArgs L{WSP(bf16, WS_U), NU1, C1_HQ, C1_HF, C1_HI, C1_HG, nullptr, K->in[18], K->in[13], WSP(float, WS_P), WSP(float, WS_DSC), WSP(bf16, WS_S), WSP(bf16, WS_P), 1024};
#ifdef PROBE_LINB
                  unsigned long long tl_ = 0; if (PROBE_LINB == 1 && threadIdx.x == 0) tl_ = __builtin_amdgcn_s_memrealtime();
#endif
                  for (int unit = blockIdx.x; unit < 256; unit += G) lin_unit<128, 4, true, true>(lds, tid, L, unit >> 5, 2 * ((unit >> 3) & 3), unit & 7);
#ifdef PROBE_LINB
                if (PROBE_LINB == 1 && threadIdx.x == 0) MISC[20] += (unsigned)(__builtin_amdgcn_s_memrealtime() - tl_);
#endif
                }
#endif
#if REF_ATT1
                ref_att(lds, tid, G, 1, WSP(bf16, WS_U), NU1, C1_FQ, C1_FK, C1_FV, WSP(bf16, WS_P), 0, nullptr, WSP(float, WS_CFOX));
#endif
            }
            if (!(variant & 2) && ((layer == 0 && !REF_ATT0) || (layer == 1 && !REF_ATT1))) {
                const int pitch = layer ? NU1 : NU0, qoff = layer ? C1_FQ : C0_MQ, koff = layer ? C1_FK : C0_MK, voff = layer ? C1_FV : C0_MV, mixoff = layer ? 0 : 1024;
                for (int item = blockIdx.x; item < 256; item += G) att::pair_item((char*)lds_raw, item, layer, WSP(bf16, WS_U), pitch, qoff, koff, voff, WSP(bf16, WS_P), mixoff, WSP(float, WS_KMEAN), WSP(float, WS_FF), K->in[12]);
            }
        }
        SEAM(pb + 3);
        if (PH(pb + 4)) {
            KArgsP K = kargs(); const int tid = otid(), lane = tid & 63, wave = __builtin_amdgcn_readfirstlane(tid >> 6); (void)lane; (void)wave; unsigned char* ws = K->ws;
            pg8::Gemm g{WSP(bf16, WS_P), WSP(bf16, layer ? WS_WOUT1 : WS_WOUT0), MTOK, DM, DM, 0, 0, WTILED}; pg8::StaticOrder S; S.init(MTOK, DM, G, (int)blockIdx.x);
            bf16* h16 = (bf16*)((unsigned char*)K->out + OUT_H16);
            if (layer == 0) { pg8::EpiResid<true, false> E{K->in[0], h16, WSP(float, WS_ROWSS), 0, nullptr}; pg8::gemm_phase<pg8::EpiResid<true, false>, pg8::StaticOrder, PG_ALIGN, PG_SP2>(lds, g, S, E); }
            else { pg8::EpiResid<false, false> E{h16, h16, WSP(float, WS_ROWSS), 0, nullptr}; pg8::gemm_phase<pg8::EpiResid<false, false>, pg8::StaticOrder, PG_ALIGN, PG_SP2>(lds, g, S, E); }
        }
        SEAM(pb + 4);
        for (int half = 0; half < MLP_SPLIT; ++half) {
            if (PH(pb + 5 + 2 * half)) {
                KArgsP K = kargs(); const int tid = otid(), lane = tid & 63, wave = __builtin_amdgcn_readfirstlane(tid >> 6); (void)lane; (void)wave; unsigned char* ws = K->ws;
                pg8::Gemm g{(const bf16*)((unsigned char*)K->out + OUT_H16) + (size_t)half * MHALF * DM, WSP(bf16, layer ? WS_WUP1 : WS_WUP0), MHALF, DFF, DM, KV(4), 1, WTILED}; pg8::StaticOrder S; S.init(MHALF, DFF, G, (int)blockIdx.x);
                pg8::EpiSqRelu E{WSP(bf16, WS_HID + (size_t)half * HID_STRIDE), DFF};
                STAGGER();
#ifdef PROBE_EPINULL
                if (KV(8)) { pg8::EpiSqReluNS E0{WSP(bf16, WS_HID), DFF}; pg8::gemm_phase<pg8::EpiSqReluNS, pg8::StaticOrder, PG_ALIGN, PG_SP2>(lds, g, S, E0); } else
#endif
                pg8::gemm_phase<pg8::EpiSqRelu, pg8::StaticOrder, PG_ALIGN, PG_SP2>(lds, g, S, E);
            }
            SEAM(pb + 5 + 2 * half);
            if (PH(pb + 6 + 2 * half)) {
                KArgsP K = kargs(); const int tid = otid(), lane = tid & 63, wave = __builtin_amdgcn_readfirstlane(tid >> 6); (void)lane; (void)wave; unsigned char* ws = K->ws;
                pg8::Gemm g{WSP(bf16, WS_HID + (size_t)half * HID_STRIDE), WSP(bf16, layer ? WS_WDN1 : WS_WDN0), MHALF, DM, DFF, 0, 1, WTILED}; pg8::StaticOrder S; S.init(MHALF, DM, G, (int)blockIdx.x);
                bf16* h16 = (bf16*)((unsigned char*)K->out + OUT_H16);
                pg8::EpiResid<false, true> E{h16, layer ? WSP(bf16, WS_HFIN) : h16, WSP(float, WS_ROWSS2), half * MHALF, WSP(float, WS_ROWSS)};
                pg8::gemm_phase<pg8::EpiResid<false, true>, pg8::StaticOrder, PG_ALIGN, PG_SP2>(lds, g, S, E);
            }
            if (!HID_DB || half == MLP_SPLIT - 1) SEAM(pb + 6 + 2 * half);
        }
    }
#ifdef PROBE_WAIT
    float probe_scale = 1.f;
    if (PH(19)) { KArgsP K = kargs(); unsigned* acc = (unsigned*)(K->ws + WS_CTL) + 64;
        if (threadIdx.x == 0) atomicAdd(acc, MISC[20]);
        xcd_barrier(bar);
        const unsigned tot = __hip_atomic_load(acc, __ATOMIC_RELAXED, __HIP_MEMORY_SCOPE_AGENT);
        const float avg_us = (float)tot * 0.01f / (float)G;
        probe_scale = 1.f + sqrtf(avg_us * PROBE_WAIT_UNIT); }
#endif
    if (PH(19)) { KArgsP K = kargs(); const int tid = otid(), lane = tid & 63, wave = __builtin_amdgcn_readfirstlane(tid >> 6); (void)lane; (void)wave; unsigned char* ws = K->ws; phase_final_norm(WSP(bf16, WS_HFIN), K->out, K->in[19], WSP(float, WS_ROWSS2), G, wave, lane
#ifdef PROBE_WAIT
        , probe_scale
#endif
        ); }
#undef PH
#undef SEAM
#undef WSP
}

extern "C" void kernel_launch(void* const* d_in, const int* in_sizes, int n_in, void* d_out, int out_size, void* d_ws, size_t ws_size, hipStream_t stream) {
    static int grid = 0;
    if (grid == 0) {
        if (n_in != 20 || in_sizes[0] != MTOK * DM || out_size != MTOK * DM || ws_size < WS_END) {
            fprintf(stderr, "kernel_launch: unexpected problem (n_in %d, in0 %d, out %d, ws %zu; need ws >= %zu); nothing launched\n", n_in, n_in > 0 ? in_sizes[0] : -1, out_size, ws_size, (size_t)WS_END); grid = -1; return; }
        int dev = 0, cus = 0, per_cu = 0;
        if (hipGetDevice(&dev) != hipSuccess || hipDeviceGetAttribute(&cus, hipDeviceAttributeMultiprocessorCount, dev) != hipSuccess) { fprintf(stderr, "kernel_launch: device query failed\n"); grid = -1; return; }
        if (hipFuncSetAttribute((const void*)fwd, hipFuncAttributeMaxDynamicSharedMemorySize, LDS_BYTES) != hipSuccess) { fprintf(stderr, "kernel_launch: hipFuncSetAttribute failed\n"); grid = -1; return; }
        if (hipOccupancyMaxActiveBlocksPerMultiprocessor(&per_cu, (const void*)fwd, NWAVES * 64, LDS_BYTES) != hipSuccess || per_cu < 1)
            fprintf(stderr, "kernel_launch: note: occupancy query reports %d workgroups per CU\n", per_cu);
        (void)hipGetLastError();
        grid = cus;
    }
    if (grid < 0) return;
    if (hipMemsetAsync((char*)d_ws + WS_CTL, 0, CTL_ZERO_BYTES, stream) != hipSuccess) { fprintf(stderr, "kernel_launch: memset failed\n"); return; }
    Args a{};
    for (int i = 0; i < 20; ++i) a.in[i] = (const float*)d_in[i];
    a.out = (float*)d_out; a.ws = (unsigned char*)d_ws;
#if ONE_LAUNCH
    a.ph_lo = 0; a.ph_hi = N_PHASES;
    hipLaunchKernelGGL(fwd, dim3(grid), dim3(NWAVES * 64), LDS_BYTES, stream, a);
#else
#ifndef REPEAT_MASK
#define REPEAT_MASK 0u
#endif
#ifndef REPEAT_VARIANT
#define REPEAT_VARIANT 0
#endif
    for (int p = 0; p < N_PHASES; ++p) { a.ph_lo = p; a.ph_hi = p + 1;
        if ((REPEAT_MASK >> p) & 1u) { a.variant = REPEAT_VARIANT; hipLaunchKernelGGL(fwd, dim3(grid), dim3(NWAVES * 64), LDS_BYTES, stream, a); a.variant = 0; }
        hipLaunchKernelGGL(fwd, dim3(grid), dim3(NWAVES * 64), LDS_BYTES, stream, a); }
#endif
    const hipError_t le = hipPeekAtLastError();
    if (le != hipSuccess) fprintf(stderr, "kernel_launch: launch failed: %s\n", hipGetErrorName(le));
}
```

```cpp
#include <hip/hip_runtime.h>
#include <cstdio>
#include <cstdint>
#include <cmath>
__device__ __forceinline__ int otid() { int t = threadIdx.x; asm volatile("" : "+v"(t)); return t; }
#define ONE_LAUNCH 1
namespace pg8 {
#define PG8_LAS __attribute__((address_space(3)))
typedef unsigned short bf16_t;
typedef short bf16x8 __attribute__((ext_vector_type(8)));
typedef float f32x4 __attribute__((ext_vector_type(4)));
typedef unsigned u32x4 __attribute__((ext_vector_type(4)));
constexpr int BM = 256, BK = 64, HALF = 128, HTB = HALF * BK * 2  , STAGE_BYTES = 8 * HTB, NXCD = 8, WGM = 8;

__host__ __device__ __forceinline__ int lds_byte(int r, int c) { const int st = (r >> 4) * 2 + (c >> 5), rr = r & 15, cc = c & 31, ob = rr * 64 + cc * 2; return st * 1024 + (ob ^ (((ob >> 9) & 1) << 5)); }
__host__ __device__ __forceinline__ void stage_rc(int b, int& R, int& C) { const int st = b / 1024, sb = b % 1024, swz = sb ^ (((sb >> 9) & 1) << 5); R = (st >> 1) * 16 + swz / 64; C = (st & 1) * 32 + (swz % 64) / 2; }
__host__ __device__ __forceinline__ int perm32(int rho) { const int n = rho >> 4, i = rho & 15; return 8 * (i >> 2) + 4 * n + (i & 3); }

struct Unit { int pm, pn; };
struct Gemm { const bf16_t* A; const bf16_t* Bt; int M, N, K; int sp; int atile; int btile; };

struct StaticOrder {
    int nM, nN, nwg, G, c;
    __host__ __device__ void init(int M, int N, int G_, int c_) { nM = M / BM; nN = N / BM; nwg = nM * nN; G = G_; c = c_; }
    __host__ __device__ __forceinline__ bool next(int i, Unit& u) const {
        const long L = (long)i * G + c; if (L >= nwg) return false;
        int wgid = (int)L; { const int q = nwg / NXCD, r = nwg % NXCD, xcd = wgid % NXCD, off = wgid / NXCD; wgid = (xcd < r ? xcd * (q + 1) : r * (q + 1) + (xcd - r) * q) + off; }
        const int nig = WGM * nN, gid = wgid / nig, fm = gid * WGM, gsz = (nM - fm) < WGM ? (nM - fm) : WGM;
        u.pm = fm + ((wgid % nig) % gsz); u.pn = (wgid % nig) / gsz; return true;
    }
    __device__ __forceinline__ void a_ready(const Unit&) const {}
    __device__ __forceinline__ void done(const Unit&) const {}
};
__device__ __forceinline__ unsigned cvt_pk_bf16(float lo, float hi) { unsigned r; asm volatile("v_cvt_pk_bf16_f32 %0, %1, %2" : "=v"(r) : "v"(lo), "v"(hi)); return r; }
#ifndef PG_EPIWAIT
#define PG_EPIWAIT 0
#endif
#define EPI_FENCE() asm volatile("" ::: "memory")
__host__ __device__ __forceinline__ unsigned atile_off(int R, int C) { return (unsigned)(((((R >> 6) * 2 + (C >> 5)) * 4 + ((R >> 4) & 3)) * 1024) + (((R & 15) * 4 + ((C >> 3) & 3)) * 16) + (C & 7) * 2); }
constexpr float RMS_EPS = 1e-6f;
template <int ACT, bool TILED> struct EpiScale {
    static constexpr bool PERM = true, AFTER_DRAIN = false; static constexpr int NVM = 16;
    bf16_t* O; int ldc; const float* rowss; int row_base;
    const PG8_LAS float* tab; int tab_pm;
    __device__ __forceinline__ void operator()(const f32x4 (&acc)[2][2][4][2], const Unit& u, int wr, int wc, int fr, int fq) const {
        const int lrow0 = u.pm * BM + wr * 64 + fr; const int col0 = u.pn * BM + wc * 32 + 8 * fq;
        float rsv[2][4];
        if (u.pm == tab_pm) {
#pragma unroll
            for (int ai = 0; ai < 2; ++ai)
#pragma unroll
                for (int m = 0; m < 4; ++m) rsv[ai][m] = tab[wr * 64 + fr + ai * HALF + m * 16];
        } else {
#pragma unroll
            for (int ai = 0; ai < 2; ++ai)
#pragma unroll
                for (int m = 0; m < 4; ++m) { const f32x4* pp = (const f32x4*)(rowss + (size_t)(row_base + lrow0 + ai * HALF + m * 16) * 32 + 8 * fq); const f32x4 t0 = pp[0], t1 = pp[1];
                    float s = ((t0[0] + t0[1]) + (t0[2] + t0[3])) + ((t1[0] + t1[1]) + (t1[2] + t1[3]));
                    s += __shfl_xor(s, 16); s += __shfl_xor(s, 32); rsv[ai][m] = __builtin_amdgcn_rsqf(s * (1.0f / 2048.0f) + RMS_EPS); EPI_FENCE(); }
        }
#pragma unroll
        for (int ai = 0; ai < 2; ++ai)
#pragma unroll
            for (int m = 0; m < 4; ++m) { const int lrow = lrow0 + ai * HALF + m * 16;
                const float rs = rsv[ai][m];
                bf16_t* rowp = O + (size_t)lrow * ldc + col0;
#pragma unroll
                for (int bj = 0; bj < 2; ++bj) { f32x4 v0 = acc[ai][bj][m][0] * rs, v1 = acc[ai][bj][m][1] * rs;
                    if (ACT == 1) {
#pragma unroll
                        for (int e = 0; e < 4; ++e) { const float a = fmaxf(v0[e], 0.f), b = fmaxf(v1[e], 0.f); v0[e] = a * a; v1[e] = b * b; } }
                    u32x4 w; w.x = cvt_pk_bf16(v0[0], v0[1]); w.y = cvt_pk_bf16(v0[2], v0[3]); w.z = cvt_pk_bf16(v1[0], v1[1]); w.w = cvt_pk_bf16(v1[2], v1[3]);
                    if (TILED) *(u32x4*)((unsigned char*)O + ((size_t)(u.pm * 2 + ai) * (ldc >> 6) + (u.pn * 4 + bj * 2 + (wc >> 1))) * 16384 + ((wr * 2 + (wc & 1)) * 4 + m) * 1024 + (fr * 4 + fq) * 16) = w;
                    else *(u32x4*)(rowp + bj * HALF) = w; } }
    }
};
struct EpiSqRelu {
    static constexpr bool PERM = true, AFTER_DRAIN = false; static constexpr int NVM = 16;
    bf16_t* O; int ldc;
    __device__ __forceinline__ void operator()(const f32x4 (&acc)[2][2][4][2], const Unit& u, int wr, int wc, int fr, int fq) const {
        const int ktn = ldc >> 6;
#pragma unroll
        for (int ai = 0; ai < 2; ++ai)
#pragma unroll
            for (int bj = 0; bj < 2; ++bj) { unsigned char* tile = (unsigned char*)O + ((size_t)(u.pm * 2 + ai) * ktn + (u.pn * 4 + bj * 2 + (wc >> 1))) * 16384 + ((wr * 2 + (wc & 1)) * 4) * 1024 + (fr * 4 + fq) * 16;
#pragma unroll
                for (int m = 0; m < 4; ++m) { f32x4 v0 = acc[ai][bj][m][0], v1 = acc[ai][bj][m][1];
#pragma unroll
                    for (int e = 0; e < 4; ++e) { float a, b; asm("v_max_f32_e32 %0, 0, %1" : "=v"(a) : "v"(v0[e])); asm("v_max_f32_e32 %0, 0, %1" : "=v"(b) : "v"(v1[e])); v0[e] = a * a; v1[e] = b * b; }
                    u32x4 w; w.x = cvt_pk_bf16(v0[0], v0[1]); w.y = cvt_pk_bf16(v0[2], v0[3]); w.z = cvt_pk_bf16(v1[0], v1[1]); w.w = cvt_pk_bf16(v1[2], v1[3]);
                    *(u32x4*)(tile + m * 1024) = w; } }
    }
};
struct EpiSqReluNS {
    static constexpr bool PERM = true, AFTER_DRAIN = false; static constexpr int NVM = 0;
    bf16_t* O; int ldc;
    __device__ __forceinline__ void operator()(const f32x4 (&acc)[2][2][4][2], const Unit& u, int wr, int wc, int fr, int fq) const {
        const int lrow0 = u.pm * BM + wr * 64 + fr; const int col0 = u.pn * BM + wc * 32 + 8 * fq;
#pragma unroll
        for (int ai = 0; ai < 2; ++ai)
#pragma unroll
            for (int m = 0; m < 4; ++m) { bf16_t* rowp = O + (size_t)(lrow0 + ai * HALF + m * 16) * ldc + col0;
#pragma unroll
                for (int bj = 0; bj < 2; ++bj) { f32x4 v0 = acc[ai][bj][m][0], v1 = acc[ai][bj][m][1];
#pragma unroll
                    for (int e = 0; e < 4; ++e) { float a, b; asm("v_max_f32_e32 %0, 0, %1" : "=v"(a) : "v"(v0[e])); asm("v_max_f32_e32 %0, 0, %1" : "=v"(b) : "v"(v1[e])); v0[e] = a * a; v1[e] = b * b; }
                    u32x4 w; w.x = cvt_pk_bf16(v0[0], v0[1]); w.y = cvt_pk_bf16(v0[2], v0[3]); w.z = cvt_pk_bf16(v1[0], v1[1]); w.w = cvt_pk_bf16(v1[2], v1[3]);
                    *(u32x4*)(O + (((size_t)(u.pm * 32 + u.pn) * 8 + (wr * 4 + wc)) * 16 + (ai * 8 + m * 2 + bj)) * 512 + (fq * 16 + fr) * 8) = w;     } }
    }
};
template <bool F32IN, bool RS2> struct EpiResid {
    static constexpr bool PERM = true, AFTER_DRAIN = false; static constexpr int NVM = 16;
    const void* hin; bf16_t* hout; float* rowss; int row_base; const float* rowss_in;
    __device__ __forceinline__ void operator()(const f32x4 (&acc)[2][2][4][2], const Unit& u, int wr, int wc, int fr, int fq) const {
        const int row0 = row_base + u.pm * BM + wr * 64 + fr; const int col0 = u.pn * BM + wc * 32 + 8 * fq;
        const size_t tb0 = ((size_t)((row_base >> 7) + u.pm * 2) * 32 + (u.pn * 4 + (wc >> 1))) * 16384 + ((wr * 2 + (wc & 1)) * 4) * 1024 + (fr * 4 + fq) * 16;
#define EPI_TOFF(ai_, m_, bj_) (tb0 + ((size_t)(ai_) * 32 + (bj_) * 2) * 16384 + (m_) * 1024)
        float rs2[2][4];
        if (RS2) { f32x4 pr[2][4][2];
#pragma unroll
            for (int ai = 0; ai < 2; ++ai)
#pragma unroll
                for (int m = 0; m < 4; ++m) { const f32x4* pp = (const f32x4*)(rowss_in + (size_t)(row0 + ai * HALF + m * 16) * 32 + 8 * fq); pr[ai][m][0] = pp[0]; pr[ai][m][1] = pp[1]; }
            EPI_FENCE();
#pragma unroll
            for (int ai = 0; ai < 2; ++ai)
#pragma unroll
                for (int m = 0; m < 4; ++m) { const f32x4 t0 = pr[ai][m][0], t1 = pr[ai][m][1]; float sq = ((t0[0] + t0[1]) + (t0[2] + t0[3])) + ((t1[0] + t1[1]) + (t1[2] + t1[3]));
                    sq += __shfl_xor(sq, 16); sq += __shfl_xor(sq, 32); rs2[ai][m] = __builtin_amdgcn_rcpf(sq * (1.0f / 2048.0f) + RMS_EPS); }
        }
        f32x4 hb[2][2][2][2];
#define EPI_LOAD(buf, k) do { _Pragma("unroll") for (int q_ = 0; q_ < 2; ++q_) { const int ai_ = (k) >> 1, m_ = 2 * ((k) & 1) + q_;                                                                          \
            _Pragma("unroll") for (int bj = 0; bj < 2; ++bj) {                                                                                                                                                  \
                if (F32IN) { const float* p_ = (const float*)hin + (size_t)(row0 + ai_ * HALF + m_ * 16) * 2048 + col0 + bj * HALF; hb[buf][q_][bj][0] = *(const f32x4*)p_; hb[buf][q_][bj][1] = *(const f32x4*)(p_ + 4); } \
                else { const u32x4 t_ = *(const u32x4*)((const unsigned char*)hin + EPI_TOFF(ai_, m_, bj));                                                                                                   \
                       hb[buf][q_][bj][0] = (f32x4){__uint_as_float(t_.x << 16), __uint_as_float(t_.x & 0xffff0000u), __uint_as_float(t_.y << 16), __uint_as_float(t_.y & 0xffff0000u)};                         \
                       hb[buf][q_][bj][1] = (f32x4){__uint_as_float(t_.z << 16), __uint_as_float(t_.z & 0xffff0000u), __uint_as_float(t_.w << 16), __uint_as_float(t_.w & 0xffff0000u)}; } } } } while (0)
        EPI_LOAD(0, 0); EPI_FENCE();
#pragma unroll
        for (int k = 0; k < 4; ++k) {
            if (k < 3) { if (k & 1) EPI_LOAD(0, k + 1); else EPI_LOAD(1, k + 1); }
            EPI_FENCE();
#pragma unroll
            for (int q = 0; q < 2; ++q) { const int ai = k >> 1, m = 2 * (k & 1) + q; const int row = row0 + ai * HALF + m * 16; float ss = 0.f;
#pragma unroll
                for (int bj = 0; bj < 2; ++bj) {
                    const f32x4 v0 = (RS2 ? acc[ai][bj][m][0] * rs2[ai][m] : acc[ai][bj][m][0]) + hb[k & 1][q][bj][0], v1 = (RS2 ? acc[ai][bj][m][1] * rs2[ai][m] : acc[ai][bj][m][1]) + hb[k & 1][q][bj][1];
                    u32x4 p; p.x = cvt_pk_bf16(v0[0], v0[1]); p.y = cvt_pk_bf16(v0[2], v0[3]); p.z = cvt_pk_bf16(v1[0], v1[1]); p.w = cvt_pk_bf16(v1[2], v1[3]);
                    *(u32x4*)((unsigned char*)hout + EPI_TOFF(ai, m, bj)) = p;
                    const float r0 = __uint_as_float(p.x << 16), r1 = __uint_as_float(p.x & 0xffff0000u), r2 = __uint_as_float(p.y << 16), r3 = __uint_as_float(p.y & 0xffff0000u);
                    const float r4 = __uint_as_float(p.z << 16), r5 = __uint_as_float(p.z & 0xffff0000u), r6 = __uint_as_float(p.w << 16), r7 = __uint_as_float(p.w & 0xffff0000u);
                    ss += ((r0 * r0 + r1 * r1) + (r2 * r2 + r3 * r3)) + ((r4 * r4 + r5 * r5) + (r6 * r6 + r7 * r7)); }
                ss += __shfl_xor(ss, 16); ss += __shfl_xor(ss, 32);
                if (fq == 0) rowss[(size_t)row * 32 + u.pn * 4 + wc] = ss; }
            EPI_FENCE();
        }
#undef EPI_LOAD
#undef EPI_TOFF
    }
};
struct EpiNull {
    static constexpr bool PERM = true, AFTER_DRAIN = false; static constexpr int NVM = 0;
    __device__ __forceinline__ void operator()(const f32x4 (&acc)[2][2][4][2], const Unit&, int, int, int, int) const {
#pragma unroll
        for (int ai = 0; ai < 2; ++ai)
#pragma unroll
            for (int bj = 0; bj < 2; ++bj)
#pragma unroll
                for (int m = 0; m < 4; ++m)
#pragma unroll
                    for (int n = 0; n < 2; ++n) asm volatile("" :: "v"(acc[ai][bj][m][n]));
    }
};
template <class Epi, class Sched, bool ALIGN_EPI = false, bool SP2 = false>
__device__ __forceinline__ void gemm_phase(PG8_LAS unsigned char* lds, const Gemm g, const Sched& S, const Epi& E) {
    const int tid = otid(), wid = __builtin_amdgcn_readfirstlane(tid >> 6), lane = tid & 63, wr = wid >> 2, wc = wid & 3, fr = lane & 15, fq = lane >> 4;
    const int K = g.K, nt = K / BK;
    unsigned voffA[2], voffB[2];
#pragma unroll
    for (int i = 0; i < 2; ++i) { int R, C; stage_rc(tid * 16 + i * 8192, R, C); const int Rb = Epi::PERM ? ((R & ~31) + perm32(R & 31)) : R;
        voffA[i] = g.atile ? atile_off(R, C) : (unsigned)(R * K + C) * 2u; voffB[i] = g.btile ? atile_off(Rb, C) : (unsigned)(Rb * K + C) * 2u; }
    const size_t kstepB = g.btile ? (size_t)16384 : (size_t)(BK * 2), kstepA = g.atile ? (size_t)16384 : (size_t)(BK * 2);
    const size_t hstepB = (size_t)HALF * K * 2, hstepA = hstepB;
    const size_t tstepB = 2 * hstepB, tstepA = 2 * hstepA;
    const unsigned ldsw = (unsigned)wid * 1024u;
    const int aoff = lds_byte(wr * 64 + fr, fq * 8), boff = lds_byte(wc * 32 + fr, fq * 8);
#define PG8_SA(b, h) (((b) * 2 + (h)) * HTB)
#define PG8_SB(b, h) ((4 + (b) * 2 + (h)) * HTB)
#define PG8_STAGE(bufoff, gbase, voff) do { _Pragma("unroll") for (int _i = 0; _i < 2; ++_i) \
        __builtin_amdgcn_global_load_lds((const unsigned*)((const char*)(gbase) + (voff)[_i]), (PG8_LAS unsigned*)(lds + (bufoff) + ldsw + _i * 8192), 16, 0, 0); } while (0)
#define PG8_LDA(dst, b, h) do { _Pragma("unroll") for (int m = 0; m < 4; ++m) _Pragma("unroll") for (int k = 0; k < 2; ++k) dst[m][k] = *(const PG8_LAS bf16x8*)(lds + PG8_SA(b, h) + aoff + m * 2048 + k * 1024); } while (0)
#define PG8_LDB(dst, b, h) do { _Pragma("unroll") for (int n = 0; n < 2; ++n) _Pragma("unroll") for (int k = 0; k < 2; ++k) dst[n][k] = *(const PG8_LAS bf16x8*)(lds + PG8_SB(b, h) + boff + n * 2048 + k * 1024); } while (0)
#define PG8_MMA(ai, bj, At, Bt) do { __builtin_amdgcn_s_setprio(1); _Pragma("unroll") for (int m = 0; m < 4; ++m) _Pragma("unroll") for (int n = 0; n < 2; ++n) _Pragma("unroll") for (int k = 0; k < 2; ++k) \
        acc[ai][bj][m][n] = __builtin_amdgcn_mfma_f32_16x16x32_bf16(Bt[n][k], At[m][k], acc[ai][bj][m][n], 0, 0, 0); __builtin_amdgcn_s_setprio(0); } while (0)
#define PG8_WAIT_V(n) asm volatile("s_waitcnt vmcnt(" #n ")" ::: "memory")
#define PG8_WAIT_VE do { if (PG_EPIWAIT && Epi::NVM >= 16) asm volatile("s_cmp_eq_u32 %0, 0\n\ts_cbranch_scc1 .LPG8A%=\n\ts_waitcnt vmcnt(24)\n\ts_branch .LPG8B%=\n.LPG8A%=:\n\ts_waitcnt vmcnt(8)\n.LPG8B%=:" :: "s"(epi_first) : "memory", "scc"); else PG8_WAIT_V(8); } while (0)
#define PG8_WAIT_L(n) asm volatile("s_waitcnt lgkmcnt(" #n ")" ::: "memory")
#define PG8_BAR __builtin_amdgcn_s_barrier()
#define PG8_SCHED __builtin_amdgcn_sched_barrier(0)
    Unit cur, nxt; int ui = 0;
    if (!S.next(0, cur)) return;
    f32x4 acc[2][2][4][2];
#pragma unroll
    for (int a = 0; a < 2; ++a)
#pragma unroll
        for (int b = 0; b < 2; ++b)
#pragma unroll
            for (int m = 0; m < 4; ++m)
#pragma unroll
                for (int n = 0; n < 2; ++n) acc[a][b][m][n] = (f32x4){0.f, 0.f, 0.f, 0.f};
    bf16x8 At[4][2], B0[2][2], B1[2][2];
    const char* cA = (const char*)g.A + (size_t)(g.sp ? 0 : cur.pm) * tstepA; const char* cB = (const char*)g.Bt + (size_t)(g.sp ? 0 : cur.pn) * tstepB;
    S.a_ready(cur);
    if constexpr (SP2) {
        PG8_STAGE(PG8_SB(0, 0), cB, voffB); PG8_STAGE(PG8_SB(0, 1), cB + hstepB, voffB); PG8_STAGE(PG8_SA(0, 0), cA, voffA); PG8_STAGE(PG8_SA(0, 1), cA + hstepA, voffA);
        if (wr == 1) PG8_BAR;
        PG8_WAIT_V(2); PG8_BAR;
        PG8_STAGE(PG8_SB(1, 0), cB + kstepB, voffB); PG8_STAGE(PG8_SA(1, 0), cA + kstepA, voffA); PG8_STAGE(PG8_SB(1, 1), cB + hstepB + kstepB, voffB);
        PG8_WAIT_V(6); PG8_BAR;
    } else {
        PG8_STAGE(PG8_SB(0, 0), cB, voffB); PG8_STAGE(PG8_SA(0, 0), cA, voffA); PG8_STAGE(PG8_SB(0, 1), cB + hstepB, voffB); PG8_STAGE(PG8_SA(0, 1), cA + hstepA, voffA);
        if (wr == 1) PG8_BAR;
        PG8_WAIT_V(4); PG8_BAR;
        PG8_STAGE(PG8_SB(1, 0), cB + kstepB, voffB); PG8_STAGE(PG8_SA(1, 0), cA + kstepA, voffA); PG8_STAGE(PG8_SB(1, 1), cB + hstepB + kstepB, voffB);
        PG8_WAIT_V(6); PG8_BAR;
    }
    for (;;) {
        const bool has_next = S.next(ui + 1, nxt);
        const char* nA = has_next ? (const char*)g.A + (size_t)(g.sp ? 0 : nxt.pm) * tstepA : cA; const char* nB = has_next ? (const char*)g.Bt + (size_t)(g.sp ? 0 : nxt.pn) * tstepB : cB;
        for (int t = 0; t < nt; t += 2) {
            const bool last = (t == nt - 2);
            const int epi_first = __builtin_amdgcn_readfirstlane((t == 0 && ui > 0) ? 1 : 0);
            const char* a1 = cA + (size_t)(t + 1) * kstepA;
            const char* a2 = last ? nA : cA + (size_t)(t + 2) * kstepA; const char* b2 = last ? nB : cB + (size_t)(t + 2) * kstepB;
            const char* a3 = a2 + kstepA; const char* b3 = b2 + kstepB;
            if (last && has_next) S.a_ready(nxt);
            if constexpr (SP2) {
            PG8_LDB(B0, 0, 0); PG8_LDB(B1, 0, 1); PG8_SCHED; PG8_LDA(At, 0, 0); PG8_STAGE(PG8_SA(1, 1), a1 + hstepA, voffA);
            PG8_WAIT_VE; PG8_WAIT_L(0); PG8_BAR; PG8_MMA(0, 0, At, B0); PG8_MMA(0, 1, At, B1); PG8_BAR; PG8_SCHED;
            PG8_LDA(At, 0, 1); PG8_STAGE(PG8_SB(0, 0), b2, voffB); PG8_STAGE(PG8_SB(0, 1), b2 + hstepB, voffB); PG8_STAGE(PG8_SA(0, 0), a2, voffA);
            PG8_WAIT_VE; PG8_WAIT_L(0); PG8_BAR; PG8_MMA(1, 0, At, B0); PG8_MMA(1, 1, At, B1); PG8_BAR; PG8_SCHED;
            PG8_LDB(B0, 1, 0); PG8_LDB(B1, 1, 1); PG8_SCHED; PG8_LDA(At, 1, 0); PG8_STAGE(PG8_SA(0, 1), a2 + hstepA, voffA);
            PG8_WAIT_V(8); PG8_WAIT_L(0); PG8_BAR; PG8_MMA(0, 0, At, B0); PG8_MMA(0, 1, At, B1); PG8_BAR; PG8_SCHED;
            PG8_LDA(At, 1, 1); PG8_STAGE(PG8_SB(1, 0), b3, voffB); PG8_STAGE(PG8_SB(1, 1), b3 + hstepB, voffB); PG8_STAGE(PG8_SA(1, 0), a3, voffA);
            PG8_WAIT_V(8); PG8_WAIT_L(0); PG8_BAR; PG8_MMA(1, 0, At, B0); PG8_MMA(1, 1, At, B1); PG8_BAR; PG8_SCHED;
            } else {
            PG8_LDB(B0, 0, 0); PG8_SCHED; PG8_LDA(At, 0, 0); PG8_STAGE(PG8_SA(1, 1), a1 + hstepA, voffA);
            PG8_WAIT_L(8); PG8_BAR; PG8_WAIT_L(0); PG8_MMA(0, 0, At, B0); PG8_BAR; PG8_SCHED;
            PG8_LDB(B1, 0, 1); PG8_STAGE(PG8_SB(0, 0), b2, voffB);
            PG8_BAR; PG8_WAIT_L(0); PG8_MMA(0, 1, At, B1); PG8_BAR;
            PG8_LDA(At, 0, 1); PG8_STAGE(PG8_SA(0, 0), a2, voffA);
            PG8_BAR; PG8_WAIT_L(0); PG8_MMA(1, 0, At, B0); PG8_BAR; PG8_SCHED;
            PG8_STAGE(PG8_SB(0, 1), b2 + hstepB, voffB);
            PG8_WAIT_V(6); PG8_BAR; PG8_MMA(1, 1, At, B1); PG8_BAR;
            PG8_LDB(B0, 1, 0); PG8_SCHED; PG8_LDA(At, 1, 0); PG8_STAGE(PG8_SA(0, 1), a2 + hstepA, voffA);
            PG8_WAIT_L(8); PG8_BAR; PG8_WAIT_L(0); PG8_MMA(0, 0, At, B0); PG8_BAR; PG8_SCHED;
            PG8_LDB(B1, 1, 1); PG8_STAGE(PG8_SB(1, 0), b3, voffB);
            PG8_BAR; PG8_WAIT_L(0); PG8_MMA(0, 1, At, B1); PG8_BAR;
            PG8_LDA(At, 1, 1); PG8_STAGE(PG8_SA(1, 0), a3, voffA);
            PG8_BAR; PG8_WAIT_L(0); PG8_MMA(1, 0, At, B0); PG8_BAR; PG8_SCHED;
            PG8_STAGE(PG8_SB(1, 1), b3 + hstepB, voffB);
            PG8_WAIT_V(6); PG8_BAR; PG8_MMA(1, 1, At, B1); PG8_BAR;
            }
        }
        if constexpr (ALIGN_EPI) { if (wr == 0) PG8_BAR; }
        if constexpr (!Epi::AFTER_DRAIN) { E(acc, cur, wr, wc, fr, fq); S.done(cur); }
        if (!has_next) break;
#pragma unroll
        for (int a = 0; a < 2; ++a)
#pragma unroll
            for (int b = 0; b < 2; ++b)
#pragma unroll
                for (int m = 0; m < 4; ++m)
#pragma unroll
                    for (int n = 0; n < 2; ++n) acc[a][b][m][n] = (f32x4){0.f, 0.f, 0.f, 0.f};
        cur = nxt; cA = nA; cB = nB; ++ui;
        if constexpr (ALIGN_EPI) { if (wr == 1) PG8_BAR; }
    }
    PG8_WAIT_V(0);
    if constexpr (!ALIGN_EPI) { if (wr == 0) PG8_BAR; }
    PG8_BAR;
    if constexpr (Epi::AFTER_DRAIN) { E.fused(acc, cur, wr, wc, fr, fq, lds, wid, lane); S.done(cur); }
#undef PG8_SA
#undef PG8_SB
#undef PG8_STAGE
#undef PG8_LDA
#undef PG8_LDB
#undef PG8_MMA
#undef PG8_WAIT_V
#undef PG8_WAIT_L
#undef PG8_BAR
#undef PG8_SCHED
}
}

#ifndef MLP_SPLIT
#define MLP_SPLIT 2
#endif
constexpr int NB = 8, SEQ = 2048, DM = 2048, MTOK = NB * SEQ, DFF = 8192, MHALF = MTOK / MLP_SPLIT;
constexpr int NU0 = 6144, NU1 = 7168;
constexpr int LD_IN0 = 6160, LD_IN1 = 7176;
constexpr int C0_GQ = 0, C0_GK = 512, C0_GV = 1024, C0_GG = 2048, C0_MQ = 3072, C0_MK = 4096, C0_MV = 5120;
constexpr int C1_FQ = 0, C1_FK = 1024, C1_FV = 2048, C1_HQ = 3072, C1_HF = 4096, C1_HI = 5120, C1_HG = 6144;
constexpr float EPS = 1e-6f;
constexpr float QSCALE = 0.08838834764831845f;
constexpr size_t MiB = 1u << 20;
constexpr size_t WS_CTL = 0, CTL_ZERO_BYTES = 65536;
constexpr size_t WS_ROWSS = 1 * MiB;
constexpr size_t WS_GLR = 3 * MiB;
constexpr size_t WS_FF = 4 * MiB;
constexpr size_t WS_KMEAN = 4 * MiB + 512 * 1024;
constexpr size_t WS_DSC = 4 * MiB + 768 * 1024;
constexpr size_t WS_CFOX = 5 * MiB;
constexpr size_t WS_WIN0 = 6 * MiB, WS_WOUT0 = 30 * MiB, WS_WUP0 = 38 * MiB, WS_WDN0 = 70 * MiB;
constexpr size_t WS_WIN1 = 102 * MiB, WS_WOUT1 = 130 * MiB, WS_WUP1 = 138 * MiB, WS_WDN1 = 170 * MiB;
constexpr size_t WS_U = 202 * MiB;
constexpr size_t WS_BCUM = WS_U + 192 * MiB;
constexpr size_t WS_HFIN = WS_WIN0, WS_HID = WS_U;
constexpr size_t OUT_H16 = 64 * MiB;
#ifndef LIN_PREFETCH
#define LIN_PREFETCH 5
#endif
#ifndef LIN_PARK
#define LIN_PARK 1
#endif
#ifndef PARK_MASK
#define PARK_MASK 7
#endif
#ifndef LIN_PADB
#define LIN_PADB 1
#endif
#ifndef LIN_GATE_EARLY
#define LIN_GATE_EARLY 2
#endif
#ifndef LIN_SU_EARLY
#define LIN_SU_EARLY 2
#endif
#ifndef LIN_GVDB
#define LIN_GVDB 0
#endif
#ifndef LIN_TOUCHON
#define LIN_TOUCHON 0
#endif
#ifndef CONV_WGS
#define CONV_WGS 0
#endif
#ifndef TR_P0
#define TR_P0 TR_WIN0
#endif
#ifndef CONV_STATIC
#define CONV_STATIC (1 << 16)
#endif
#ifndef XCD_AFFINE
#define XCD_AFFINE 1
#endif
#ifndef RESID0_F32
#define RESID0_F32 0
#endif
#ifndef FOX_CSUM_EARLY
#define FOX_CSUM_EARLY 1
#endif
#ifndef ATT_REV
#define ATT_REV 1
#endif
#ifndef LIN_QLATE
#define LIN_QLATE 1
#endif
#ifndef HID_DB
#define HID_DB 1
#endif
constexpr size_t HID_STRIDE = (HID_DB && MLP_SPLIT == 2) ? 128 * MiB : 0;
constexpr size_t WS_P = 426 * MiB;
constexpr size_t WS_S = 490 * MiB;
constexpr size_t WS_ROWSS2 = 506 * MiB;
constexpr size_t WS_END = 508 * MiB;
constexpr int CW_BAR = 4096;
constexpr int LDS_BYTES = 147456, MISC_OFF = LDS_BYTES - 256;
constexpr int NWAVES = 8;

#define GAS __attribute__((address_space(1)))
#define LAS __attribute__((address_space(3)))
typedef unsigned short bf16;
typedef unsigned u32x4 __attribute__((ext_vector_type(4)));
typedef unsigned u32x2 __attribute__((ext_vector_type(2)));
typedef float f32x4 __attribute__((ext_vector_type(4)));
typedef float f32x2 __attribute__((ext_vector_type(2)));
typedef float f32x16 __attribute__((ext_vector_type(16)));
typedef short bf16x8 __attribute__((ext_vector_type(8)));
typedef short s16x4 __attribute__((ext_vector_type(4)));
typedef __bf16 bf16x2_t __attribute__((ext_vector_type(2)));
#define LDS_WAIT() asm volatile("s_waitcnt lgkmcnt(0)" ::: "memory")
__device__ __forceinline__ float bf2f(unsigned short b) { return __uint_as_float((unsigned)b << 16); }
__device__ __forceinline__ unsigned cvtpk(float lo, float hi) { f32x2 v = {lo, hi}; bf16x2_t b = __builtin_convertvector(v, bf16x2_t); return __builtin_bit_cast(unsigned, b); }
__device__ __forceinline__ unsigned short f2bf(float f) { return (unsigned short)(cvtpk(f, 0.f) & 0xffffu); }
__device__ __forceinline__ float wave_sum(float v) {
#pragma unroll
    for (int o = 1; o < 64; o <<= 1) v += __shfl_xor(v, o);
    return v;
}
__device__ __forceinline__ float wave_max(float v) {
#pragma unroll
    for (int o = 1; o < 64; o <<= 1) v = fmaxf(v, __shfl_xor(v, o));
    return v;
}
__device__ __forceinline__ float log_sigmoid(float z) { return fminf(z, 0.f) - log1pf(expf(-fabsf(z))); }
__device__ __forceinline__ float sigmoidf(float z) { return 1.0f / (1.0f + expf(-z)); }
__device__ __forceinline__ int crow(int r, int hi) { return (r & 3) + 8 * (r >> 2) + 4 * hi; }
#ifndef UTILED
#define UTILED 1
#endif
__device__ __forceinline__ size_t UOFF(int tok, int col, int pitch) {
#if UTILED
    return ((size_t)((tok >> 7) * (pitch >> 6) + (col >> 6)) << 13) + (pg8::atile_off(tok & 127, col & 63) >> 1);
#else
    return (size_t)tok * pitch + col;
#endif
}
__device__ __forceinline__ size_t TOFF(int row, int col) { return ((size_t)((row >> 7) * 32 + (col >> 6)) << 13) + (pg8::atile_off(row & 127, col & 63) >> 1); }
struct Args { const float* in[20]; float* out; unsigned char* ws; int ph_lo, ph_hi, variant, pad; };
typedef const __attribute__((address_space(4))) Args* KArgsP;
__device__ __forceinline__ KArgsP kargs() { KArgsP p = (KArgsP)__builtin_amdgcn_kernarg_segment_ptr(); asm volatile("" : "+s"(p)); return p; }
#define XB_TMO      128
#define XB_XCNT(j)  (256  + 64 * (j))
#define XB_XSUB(j)  (1280 + 64 * (j))
#define XB_XGEN(j)  (2304 + 64 * (j))
#define XB_TOP      3328
#define XB_TOPGEN   3392
#define XCD_BAR_WORDS 3456
#define XB_SPIN_CAP (1u << 18)

__device__ __forceinline__ unsigned xb_ld(unsigned* p)              { return __hip_atomic_load(p, __ATOMIC_RELAXED, __HIP_MEMORY_SCOPE_AGENT); }
__device__ __forceinline__ unsigned xb_add(unsigned* p, unsigned v) { return __hip_atomic_fetch_add(p, v, __ATOMIC_RELAXED, __HIP_MEMORY_SCOPE_AGENT); }
__device__ __forceinline__ unsigned xb_xcc_id() { return (unsigned)__builtin_amdgcn_s_getreg((3 << 11) | 20) & 0xFu; }
#define XB_SPIN(cond, bar) do { unsigned _sp = 0; while (cond) { __builtin_amdgcn_s_sleep(1); \
    if ((++_sp & 255u) == 0u) { if (xb_ld(&(bar)[XB_TMO])) break; if (_sp > XB_SPIN_CAP) { atomicAdd(&(bar)[XB_TMO], 1u); break; } } } } while (0)

struct XcdBarrier {
    unsigned* bar; unsigned x;
    volatile LAS unsigned* st;
};

__device__ __forceinline__ XcdBarrier xcd_barrier_post(unsigned* bar, volatile LAS unsigned* st) {
    XcdBarrier b; b.bar = bar; b.x = xb_xcc_id(); b.st = st;
    if (threadIdx.x == 0) (void)xb_add(&bar[XB_XCNT(b.x)], 1u);
    return b;
}
__device__ __forceinline__ void xcd_barrier_complete(unsigned* bar, unsigned x, unsigned& nloc, unsigned& nx) {
    const unsigned G = gridDim.x * gridDim.y * gridDim.z;
    unsigned sum, cnt, mine, sp = 0u;
    for (;;) {
        sum = 0u; cnt = 0u; mine = 0u;
#pragma unroll
        for (unsigned j = 0; j < 16; ++j) { const unsigned c = xb_ld(&bar[XB_XCNT(j)]); sum += c; cnt += (c > 0u) ? 1u : 0u; mine = (j == x) ? c : mine; }
        if (sum == G) break;
        __builtin_amdgcn_s_sleep(1);
        if ((++sp & 255u) == 0u) { if (xb_ld(&bar[XB_TMO])) break; if (sp > XB_SPIN_CAP) { atomicAdd(&bar[XB_TMO], 1u); break; } }
    }
    nloc = mine > 0u ? mine : 1u; nx = cnt > 0u ? cnt : 1u;
}

__device__ __forceinline__ void xcd_barrier(const XcdBarrier& b) {
    asm volatile("s_waitcnt vmcnt(0)" ::: "memory");
    __syncthreads();
    if (threadIdx.x == 0) {
        unsigned* bar = b.bar;
        __builtin_amdgcn_s_waitcnt(0);
        unsigned nloc = b.st[0], nx = b.st[1];
        if (nloc == 0u) { xcd_barrier_complete(bar, b.x, nloc, nx); b.st[0] = nloc; b.st[1] = nx; }
        const unsigned old = xb_add(&bar[XB_XSUB(b.x)], 1u);
        const unsigned gen = old / nloc;
        if (old + 1u == (gen + 1u) * nloc) {
            __builtin_amdgcn_fence(__ATOMIC_RELEASE, "agent");
            asm volatile("s_waitcnt vmcnt(0)" ::: "memory");
            const unsigned og = xb_add(&bar[XB_TOP], 1u);
            const unsigned tg = og / nx;
            if (og + 1u == (tg + 1u) * nx) xb_add(&bar[XB_TOPGEN], 1u);
            else XB_SPIN(xb_ld(&bar[XB_TOPGEN]) == tg, bar);
            __builtin_amdgcn_fence(__ATOMIC_ACQUIRE, "agent");
            xb_add(&bar[XB_XGEN(b.x)], 1u);
            asm volatile("s_waitcnt vmcnt(0)" ::: "memory");
        } else {
            XB_SPIN(xb_ld(&bar[XB_XGEN(b.x)]) == gen, bar);
            __builtin_amdgcn_fence(__ATOMIC_ACQUIRE, "agent");
            asm volatile("s_waitcnt vmcnt(0)" ::: "memory");
        }
    }
    __syncthreads();
}

#ifndef PROLOGUE_NT
#define PROLOGUE_NT 0
#endif
#if PROLOGUE_NT
#define NT_LOAD4(p) __builtin_nontemporal_load(p)
#else
#define NT_LOAD4(p) (*(p))
#endif

#ifndef WTILED
#define WTILED 1
#endif
#if WTILED
#define WTILED_BASE(n0_, k0_, K_) ((((size_t)((n0_) >> 7) * ((K_) >> 6) + ((k0_) >> 6)) << 13) + (pg8::atile_off((n0_) & 127, 0) >> 1))
#define WTILED_OFF(n_, c_, K_) ((pg8::atile_off(((n_) & 31), (c_)) >> 1))
#else
#define WTILED_BASE(n0_, k0_, K_) ((size_t)(n0_) * (K_) + (k0_))
#define WTILED_OFF(n_, c_, K_) ((size_t)(n_) * (K_) + (c_))
#endif
struct TrItem { const float* src; const float* gain; bf16* dst; int ld, K; };
__device__ __forceinline__ TrItem tr_decode(KArgsP K, int r) {
    unsigned char* ws = K->ws; TrItem t;
#define TJ(idx, gidx, ld_, co_, nc_, K_, off_, ro_) { const int items_ = ((K_) / 64) * ((nc_) / 32); if (r < items_) { const int nblk = (nc_) / 32, kb = r / nblk, nb = r % nblk, k0 = 64 * kb, n0 = 32 * nb; \
        t.src = K->in[idx] + (size_t)k0 * (ld_) + (co_) + n0; t.gain = (gidx) >= 0 ? K->in[(gidx) >= 0 ? (gidx) : 0] + k0 : nullptr; t.dst = (bf16*)(ws + (off_)) + WTILED_BASE((ro_) + n0, k0, K_); t.ld = (ld_); t.K = (K_); return t; } r -= items_; }
    TJ(2, 1, LD_IN0, 0, 3072, 2048, WS_WIN0, 0)
    TJ(2, 1, LD_IN0, 3088, 3072, 2048, WS_WIN0, 3072)
    TJ(6, -1, 2048, 0, 2048, 2048, WS_WOUT0, 0)
    TJ(8, 7, 8192, 0, 8192, 2048, WS_WUP0, 0)
    TJ(9, -1, 2048, 0, 2048, 8192, WS_WDN0, 0)
    TJ(11, 10, LD_IN1, 0, 3072, 2048, WS_WIN1, 0)
    TJ(11, 10, LD_IN1, 3080, 4096, 2048, WS_WIN1, 3072)
    TJ(14, -1, 2048, 0, 2048, 2048, WS_WOUT1, 0)
    TJ(16, 15, 8192, 0, 8192, 2048, WS_WUP1, 0)
    TJ(17, -1, 2048, 0, 2048, 8192, WS_WDN1, 0)
#undef TJ
    t.src = nullptr; t.gain = nullptr; t.dst = nullptr; t.ld = 0; t.K = 0; return t;
}
#define TR_LOAD(t, tv) do { _Pragma("unroll") for (int i = 0; i < 8; ++i) tv[i] = NT_LOAD4((const f32x4*)((t).src + (size_t)(8 * i + (lane >> 3)) * (t).ld + 4 * (lane & 7))); } while (0)
__device__ __forceinline__ void tr_process(const TrItem& t, const f32x4 (&tv)[8], LAS float* scr, int lane) {
#pragma unroll
    for (int i = 0; i < 8; ++i) { LAS float* d_ = scr + (8 * i + (lane >> 3)) * 33 + 4 * (lane & 7); d_[0] = tv[i][0]; d_[1] = tv[i][1]; d_[2] = tv[i][2]; d_[3] = tv[i][3]; }
    const int c = lane & 7;
    f32x4 g0 = {1.f, 1.f, 1.f, 1.f}, g1 = g0;
    if (t.gain) { g0 = *(const f32x4*)(t.gain + 8 * c); g1 = *(const f32x4*)(t.gain + 8 * c + 4); }
    LDS_WAIT(); asm volatile("" ::: "memory");
#pragma unroll
    for (int j = 0; j < 4; ++j) { const int n = (lane >> 3) + 8 * j; const LAS float* s = scr + (8 * c) * 33 + n;
        u32x4 o; o.x = cvtpk(s[0 * 33] * g0[0], s[1 * 33] * g0[1]); o.y = cvtpk(s[2 * 33] * g0[2], s[3 * 33] * g0[3]); o.z = cvtpk(s[4 * 33] * g1[0], s[5 * 33] * g1[1]); o.w = cvtpk(s[6 * 33] * g1[2], s[7 * 33] * g1[3]);
        *(GAS u32x4*)(t.dst + WTILED_OFF(n, 8 * c, t.K)) = o; }
    LDS_WAIT(); asm volatile("" ::: "memory");
}
#ifndef TR_STATIC
#define TR_STATIC 17
#endif
__device__ __forceinline__ void phase_transposes(LAS unsigned char* lds, KArgsP K, const int nwg, const int wgi, int wave, int lane, const int lo, const int hi, const int ctr_word, const int nstat_per_wave) {
    LAS float* scr = (LAS float*)(lds + wave * 16384);
    const int gw = wgi * NWAVES + wave, NGW = nwg * NWAVES;
    const int NSTAT = (nstat_per_wave > 0 && (long)lo + (long)nstat_per_wave * NGW < (long)hi) ? lo + nstat_per_wave * NGW : hi;
    f32x4 ta[8], tb[8];
    int it = lo + gw;
    if (it < NSTAT) {
        TrItem j0 = tr_decode(K, it), j1; TR_LOAD(j0, ta);
        for (;;) {
            const int it1 = it + NGW; const bool h1 = it1 < NSTAT;
            if (h1) { j1 = tr_decode(K, it1); TR_LOAD(j1, tb); }
            asm volatile("" ::: "memory");
            tr_process(j0, ta, scr, lane);
            if (!h1) break;
            const int it2 = it1 + NGW; const bool h2 = it2 < NSTAT;
            if (h2) { j0 = tr_decode(K, it2); TR_LOAD(j0, ta); }
            asm volatile("" ::: "memory");
            tr_process(j1, tb, scr, lane);
            if (!h2) break;
            it = it2;
        }
    }
    if (NSTAT < hi) {
        unsigned* ctr = (unsigned*)(K->ws + WS_CTL) + ctr_word;
        volatile LAS unsigned* qslot = (volatile LAS unsigned*)(lds + MISC_OFF) + 24;
        const int nch = (hi - NSTAT + 15) / 16;
        const bool lead = wave == 0 && lane == 0;
        if (lead) qslot[0] = __hip_atomic_fetch_add(ctr, 1u, __ATOMIC_RELAXED, __HIP_MEMORY_SCOPE_AGENT);
        __syncthreads();
        int q = (int)qslot[0];
        while (q < nch) {
            unsigned qn = 0u; if (lead) qn = __hip_atomic_fetch_add(ctr, 1u, __ATOMIC_RELAXED, __HIP_MEMORY_SCOPE_AGENT);
            const int ia = NSTAT + 16 * q + 2 * wave, ib = ia + 1;
            const bool ha = ia < hi, hb = ib < hi;
            TrItem ja, jb;
            if (ha) { ja = tr_decode(K, ia); TR_LOAD(ja, ta); }
            if (hb) { jb = tr_decode(K, ib); TR_LOAD(jb, tb); }
            asm volatile("" ::: "memory");
            if (ha) tr_process(ja, ta, scr, lane);
            if (hb) tr_process(jb, tb, scr, lane);
            __syncthreads();
            if (lead) qslot[0] = qn;
            __syncthreads();
            q = (int)qslot[0];
        }
    }
}
__device__ __forceinline__ void phase_transposes_deep(LAS unsigned char* lds, KArgsP K, const int nwg, const int wgi, int wave, int lane, const int lo, const int hi) {
    LAS float* scr = (LAS float*)(lds + wave * 16384);
    const int NGW = nwg * NWAVES;
    int it = lo + wgi * NWAVES + wave;
    f32x4 t0[8], t1[8], t2[8], t3[8];
    TrItem j0, j1, j2, j3;
    bool h0 = it < hi, h1 = it + NGW < hi, h2 = it + 2 * NGW < hi, h3 = it + 3 * NGW < hi;
    if (h0) { j0 = tr_decode(K, it); TR_LOAD(j0, t0); }
    if (h1) { j1 = tr_decode(K, it + NGW); TR_LOAD(j1, t1); }
    if (h2) { j2 = tr_decode(K, it + 2 * NGW); TR_LOAD(j2, t2); }
    if (h3) { j3 = tr_decode(K, it + 3 * NGW); TR_LOAD(j3, t3); }
    asm volatile("" ::: "memory");
    while (h0) {
        it += 4 * NGW;
        tr_process(j0, t0, scr, lane); h0 = it < hi;               if (h0) { j0 = tr_decode(K, it); TR_LOAD(j0, t0); } asm volatile("" ::: "memory");
        if (!h1) break;
        tr_process(j1, t1, scr, lane); h1 = it + NGW < hi;         if (h1) { j1 = tr_decode(K, it + NGW); TR_LOAD(j1, t1); } asm volatile("" ::: "memory");
        if (!h2) break;
        tr_process(j2, t2, scr, lane); h2 = it + 2 * NGW < hi;     if (h2) { j2 = tr_decode(K, it + 2 * NGW); TR_LOAD(j2, t2); } asm volatile("" ::: "memory");
        if (!h3) break;
        tr_process(j3, t3, scr, lane); h3 = it + 3 * NGW < hi;     if (h3) { j3 = tr_decode(K, it + 3 * NGW); TR_LOAD(j3, t3); } asm volatile("" ::: "memory");
    }
}
constexpr int TR_TOTAL = 2 * (32 * 96) + 32 * 64 + 32 * 256 + 128 * 64 + 32 * 96 + 32 * 128 + 32 * 64 + 32 * 256 + 128 * 64, TR_WIN0 = 2 * (32 * 96);
__device__ __forceinline__ void phase_norm0(LAS unsigned char* lds, KArgsP K, int G, int tid, int wave, int lane) {
    unsigned char* ws = K->ws; const float* x = K->in[0]; const float* g0 = K->in[1]; const float* win = K->in[2]; const float* w2 = K->in[3]; const float* gb = K->in[4];
    bf16* xn = (bf16*)((unsigned char*)K->out + OUT_H16); float* rowss = (float*)(ws + WS_ROWSS); float* glr = (float*)(ws + WS_GLR); float* bcum = (float*)(ws + WS_BCUM);
    LAS float* WT = (LAS float*)lds;
    LAS float* glr_s = (LAS float*)(lds + 131072);
    if ((int)blockIdx.x >= MTOK / 64) return;
    float w2c[16];
    { f32x4 wv[16]; float gv[16];
#pragma unroll
      for (int i = 0; i < 16; ++i) { const int idx = tid + 512 * i, k = idx >> 2, j4 = idx & 3; wv[i] = *(const f32x4*)(win + (size_t)k * LD_IN0 + 3072 + 4 * j4); gv[i] = g0[k]; }
#pragma unroll
      for (int r = 0; r < 16; ++r) w2c[r] = w2[r * 512 + tid];
      asm volatile("" ::: "memory");
#pragma unroll
      for (int i = 0; i < 16; ++i) { const int idx = tid + 512 * i, k = idx >> 2, j4 = idx & 3; const f32x4 v = wv[i] * gv[i];
          WT[(4 * j4 + 0) * 2048 + k] = v[0]; WT[(4 * j4 + 1) * 2048 + k] = v[1]; WT[(4 * j4 + 2) * 2048 + k] = v[2]; WT[(4 * j4 + 3) * 2048 + k] = v[3]; } }
    const float bc = gb[tid];
    __syncthreads();
    for (int item = blockIdx.x; item < MTOK / 64; item += G) {
        const int r0 = item * 64;
        for (int i = 0; i < 8; i += 2) {
            const int row = r0 + 8 * wave + i;
            f32x4 va[8], vb[8]; float ssa = 0.f, ssb = 0.f;
#pragma unroll
            for (int jj = 0; jj < 8; ++jj) { va[jj] = NT_LOAD4((const f32x4*)(x + (size_t)row * DM) + 64 * jj + lane); vb[jj] = NT_LOAD4((const f32x4*)(x + (size_t)(row + 1) * DM) + 64 * jj + lane); }
            asm volatile("" ::: "memory");
#pragma unroll
            for (int jj = 0; jj < 8; ++jj) { ssa += (va[jj][0] * va[jj][0] + va[jj][1] * va[jj][1]) + (va[jj][2] * va[jj][2] + va[jj][3] * va[jj][3]); ssb += (vb[jj][0] * vb[jj][0] + vb[jj][1] * vb[jj][1]) + (vb[jj][2] * vb[jj][2] + vb[jj][3] * vb[jj][3]); }
#pragma unroll
            for (int jj = 0; jj < 8; ++jj) { u32x2 pa, pb; pa.x = cvtpk(va[jj][0], va[jj][1]); pa.y = cvtpk(va[jj][2], va[jj][3]); pb.x = cvtpk(vb[jj][0], vb[jj][1]); pb.y = cvtpk(vb[jj][2], vb[jj][3]);
                *(u32x2*)(xn + TOFF(row, 256 * jj + 4 * lane)) = pa; *(u32x2*)(xn + TOFF(row + 1, 256 * jj + 4 * lane)) = pb; }
            float acca[16], accb[16];
#pragma unroll 2
            for (int j = 0; j < 16; ++j) { f32x2 ab0 = {0.f, 0.f}, ab1 = {0.f, 0.f};
#pragma unroll
                for (int jj = 0; jj < 8; ++jj) { const f32x4 w = *(const LAS f32x4*)(WT + j * 2048 + 256 * jj + 4 * lane);
                    ab0 = __builtin_elementwise_fma((f32x2){va[jj][0], vb[jj][0]}, (f32x2){w[0], w[0]}, ab0); ab1 = __builtin_elementwise_fma((f32x2){va[jj][1], vb[jj][1]}, (f32x2){w[1], w[1]}, ab1);
                    ab0 = __builtin_elementwise_fma((f32x2){va[jj][2], vb[jj][2]}, (f32x2){w[2], w[2]}, ab0); ab1 = __builtin_elementwise_fma((f32x2){va[jj][3], vb[jj][3]}, (f32x2){w[3], w[3]}, ab1); }
                acca[j] = ab0[0] + ab1[0]; accb[j] = ab0[1] + ab1[1]; }
#pragma unroll
            for (int st = 0; st < 4; ++st) { const int half = 8 >> st; const unsigned um = 0u - (((unsigned)lane >> st) & 1u);
#pragma unroll
                for (int q = 0; q < 8; ++q) if (q < half) {
                    const unsigned alo = __float_as_uint(acca[q]), ahi = __float_as_uint(acca[q + half]), blo = __float_as_uint(accb[q]), bhi = __float_as_uint(accb[q + half]);
                    const float sa = __uint_as_float((alo & um) | (ahi & ~um)), sb = __uint_as_float((blo & um) | (bhi & ~um));
                    const float ka = __uint_as_float((ahi & um) | (alo & ~um)), kb = __uint_as_float((bhi & um) | (blo & ~um));
                    acca[q] = ka + __shfl_xor(sa, 1 << st); accb[q] = kb + __shfl_xor(sb, 1 << st); } }
            float ta = acca[0], tb = accb[0];
            ta += __shfl_xor(ta, 16); ta += __shfl_xor(ta, 32); tb += __shfl_xor(tb, 16); tb += __shfl_xor(tb, 32);
            ssa = wave_sum(ssa); ssb = wave_sum(ssb);
            const float rsa = 1.0f / sqrtf(ssa * (1.0f / DM) + EPS), rsb = 1.0f / sqrtf(ssb * (1.0f / DM) + EPS);
            const int col = ((lane & 1) << 3) | ((lane & 2) << 1) | ((lane & 4) >> 1) | ((lane & 8) >> 3);
            if (lane < 16) { glr_s[(8 * wave + i) * 16 + col] = ta * rsa; glr[(size_t)row * 16 + col] = ta * rsa; glr_s[(8 * wave + i + 1) * 16 + col] = tb * rsb; glr[(size_t)(row + 1) * 16 + col] = tb * rsb; }
            if (lane < 32) { rowss[(size_t)row * 32 + lane] = (lane == 0) ? ssa : 0.f; rowss[(size_t)(row + 1) * 32 + lane] = (lane == 0) ? ssb : 0.f; }
        }
        __syncthreads();
        float run = 0.f;
        for (int t = 0; t < 64; ++t) { float z = bc;
#pragma unroll
            for (int q = 0; q < 4; ++q) { const f32x4 gq = *(const LAS f32x4*)(glr_s + t * 16 + 4 * q); z += (gq[0] * w2c[4 * q] + gq[1] * w2c[4 * q + 1]) + (gq[2] * w2c[4 * q + 2] + gq[3] * w2c[4 * q + 3]); }
            run += (fminf(z, 0.f) - __logf(1.0f + __expf(-fabsf(z)))) * (1.0f / 16.0f); bcum[(size_t)(r0 + t) * 512 + tid] = run; }
        __syncthreads();
    }
}
__device__ __forceinline__ void phase_final_norm(const bf16* h16, float* out, const float* g, const float* rowss, int G, int wave, int lane, float pscale = 1.f) {
    f32x4 gv[8];
#pragma unroll
    for (int jj = 0; jj < 8; ++jj) gv[jj] = ((const f32x4*)g)[64 * jj + lane];
    for (int row = blockIdx.x * NWAVES + wave; row < MTOK; row += G * NWAVES) {
        float s = lane < 32 ? rowss[(size_t)row * 32 + lane] : 0.f;
        u32x2 hv[8];
#pragma unroll
        for (int jj = 0; jj < 8; ++jj) hv[jj] = *(const u32x2*)(h16 + TOFF(row, 256 * jj + 4 * lane));
        asm volatile("" ::: "memory");
        s = wave_sum(s);
        const float rs = pscale / sqrtf(s * (1.0f / DM) + EPS);
        f32x4* orow = (f32x4*)(out + (size_t)row * DM);
#pragma unroll
        for (int jj = 0; jj < 8; ++jj) { const f32x4 v = {__uint_as_float(hv[jj].x << 16), __uint_as_float(hv[jj].x & 0xffff0000u), __uint_as_float(hv[jj].y << 16), __uint_as_float(hv[jj].y & 0xffff0000u)};
            orow[64 * jj + lane] = v * rs * gv[jj]; }
    }
}
__device__ __forceinline__ void phase_kmean(LAS unsigned char* lds, const bf16* u, float* kmean, int G, int tid) {
    LAS float* red = (LAS float*)lds;
    const int c8 = tid & 15, tg = tid >> 4;
    for (int item = blockIdx.x; item < 512; item += 2 * G) {
        const int item2 = item + G; const bool has2 = item2 < 512;
        bf16x8 kv[8], kw[8];
        { const int n = item & 7, bh = item >> 3, b = bh >> 3, h = bh & 7;
#pragma unroll
          for (int i = 0; i < 8; ++i) { const int tok = b * SEQ + n * 256 + tg * 8 + i; kv[i] = *(const bf16x8*)(u + UOFF(tok, C0_MK + h * 128 + 8 * c8, NU0)); } }
        if (has2) { const int n = item2 & 7, bh = item2 >> 3, b = bh >> 3, h = bh & 7;
#pragma unroll
          for (int i = 0; i < 8; ++i) { const int tok = b * SEQ + n * 256 + tg * 8 + i; kw[i] = *(const bf16x8*)(u + UOFF(tok, C0_MK + h * 128 + 8 * c8, NU0)); } }
        asm volatile("" ::: "memory");
        float a[8] = {0, 0, 0, 0, 0, 0, 0, 0}, a2[8] = {0, 0, 0, 0, 0, 0, 0, 0};
#pragma unroll
        for (int i = 0; i < 8; ++i)
#pragma unroll
            for (int e = 0; e < 8; ++e) { a[e] += bf2f((unsigned short)kv[i][e]); if (has2) a2[e] += bf2f((unsigned short)kw[i][e]); }
#pragma unroll
        for (int e = 0; e < 8; ++e) { red[tg * 128 + 8 * c8 + e] = a[e]; if (has2) red[4096 + tg * 128 + 8 * c8 + e] = a2[e]; }
        __syncthreads();
        if (tid < 256 && (tid < 128 || has2)) { const int t = tid & 127, o = (tid >> 7) * 4096; float s = 0.f; for (int g = 0; g < 32; ++g) s += red[o + g * 128 + t]; kmean[(size_t)(tid < 128 ? item : item2) * 128 + t] = s * (1.0f / 256.0f); }
        __syncthreads();
    }
}
__device__ __forceinline__ void phase_ff(LAS unsigned char* lds, const float* win1, const float* gain, const bf16* xn, const float* rowss, float* ff, int G, int tid, int wave, int lane) {
    constexpr int WST = 2056;
    LAS unsigned short* WH = (LAS unsigned short*)lds; LAS unsigned short* WL = WH + 8 * WST;
    LAS float* part = (LAS float*)(lds + 66048);
    LAS float* rsl = (LAS float*)(lds + 66048 + 16384);
    if ((int)blockIdx.x >= MTOK / 64) return;
    const int r32 = lane & 31, hb = lane >> 5; bool first = true;
    for (int item = blockIdx.x; item < MTOK / 64; item += G) {
        const int row0 = item * 64;
        bf16x8 x0[16], x1[16];
#pragma unroll
        for (int s = 0; s < 16; ++s) { const int k0 = wave * 256 + 16 * s + 8 * hb;
            x0[s] = *(const bf16x8*)(xn + TOFF(row0 + r32, k0)); x1[s] = *(const bf16x8*)(xn + TOFF(row0 + 32 + r32, k0)); }
        asm volatile("" ::: "memory");
        f32x4 rt[8];
        if (tid < 64) { const f32x4* pp = (const f32x4*)(rowss + (size_t)(row0 + tid) * 32);
#pragma unroll
            for (int q = 0; q < 8; ++q) rt[q] = pp[q]; }
        asm volatile("" ::: "memory");
        if (first) { first = false;
            const int kg = tid >> 1, j4 = tid & 1, k0 = 8 * kg; f32x4 wv[8]; f32x4 g0, g1;
#pragma unroll
            for (int i = 0; i < 8; ++i) wv[i] = *(const f32x4*)(win1 + (size_t)(k0 + i) * LD_IN1 + 3072 + 4 * j4);
            g0 = *(const f32x4*)(gain + k0); g1 = *(const f32x4*)(gain + k0 + 4);
            asm volatile("" ::: "memory");
            const float gk[8] = {g0[0], g0[1], g0[2], g0[3], g1[0], g1[1], g1[2], g1[3]};
#pragma unroll
            for (int e = 0; e < 4; ++e) { u32x4 hi, lo;
#pragma unroll
                for (int p2 = 0; p2 < 4; ++p2) { const float va = wv[2 * p2][e] * gk[2 * p2], vb = wv[2 * p2 + 1][e] * gk[2 * p2 + 1];
                    const unsigned h = cvtpk(va, vb); hi[p2] = h; lo[p2] = cvtpk(va - __uint_as_float(h << 16), vb - __uint_as_float(h & 0xffff0000u)); }
                *(LAS u32x4*)(WH + (4 * j4 + e) * WST + k0) = hi; *(LAS u32x4*)(WL + (4 * j4 + e) * WST + k0) = lo; } }
        if (tid < 64) { float sq = 0.f;
#pragma unroll
            for (int q = 0; q < 8; ++q) sq += (rt[q][0] + rt[q][1]) + (rt[q][2] + rt[q][3]);
            rsl[tid] = 1.0f / sqrtf(sq * (1.0f / DM) + EPS); }
        __syncthreads();
        f32x16 acc0, acc1;
#pragma unroll
        for (int i = 0; i < 16; ++i) { acc0[i] = 0.f; acc1[i] = 0.f; }
        {
#pragma unroll
            for (int s = 0; s < 16; ++s) { const int k0 = wave * 256 + 16 * s + 8 * hb;
                bf16x8 ah = {0, 0, 0, 0, 0, 0, 0, 0}, al = ah;
                if (r32 < 8) { ah = *(const LAS bf16x8*)(WH + r32 * WST + k0); al = *(const LAS bf16x8*)(WL + r32 * WST + k0); }
                acc0 = __builtin_amdgcn_mfma_f32_32x32x16_bf16(ah, x0[s], acc0, 0, 0, 0); acc0 = __builtin_amdgcn_mfma_f32_32x32x16_bf16(al, x0[s], acc0, 0, 0, 0);
                acc1 = __builtin_amdgcn_mfma_f32_32x32x16_bf16(ah, x1[s], acc1, 0, 0, 0); acc1 = __builtin_amdgcn_mfma_f32_32x32x16_bf16(al, x1[s], acc1, 0, 0, 0); } }
        *(LAS f32x4*)(part + ((wave * 2 + 0) * 64 + lane) * 4) = (f32x4){acc0[0], acc0[1], acc0[2], acc0[3]};
        *(LAS f32x4*)(part + ((wave * 2 + 1) * 64 + lane) * 4) = (f32x4){acc1[0], acc1[1], acc1[2], acc1[3]};
        __syncthreads();
        { const int row = tid >> 3, j = tid & 7, tile = row >> 5, ln = (row & 31) + 32 * (j >> 2); float sum = 0.f;
#pragma unroll
          for (int w = 0; w < 8; ++w) sum += part[((w * 2 + tile) * 64 + ln) * 4 + (j & 3)];
          ff[(size_t)(row0 + row) * 8 + j] = sum * rsl[row]; }
        __syncthreads();
    }
}
template <int DV>
__device__ __forceinline__ void phase_scan(const float* sloc, const float* dsc, bf16* sstart, int G, int tid) {
    constexpr int GPB = 128 * DV / 4, TOTAL = (DV == 256 ? 32 : 64) * GPB;
    for (int item = blockIdx.x * 512 + tid; item < TOTAL; item += G * 512) {
        const int p4 = item % GPB, bh = item / GPB;
        const int g = p4 & 3, ln = (p4 >> 2) & 63, dt = (p4 >> 8) & 3;
        const int d0 = 32 * dt + 8 * g + 4 * (ln >> 5);
        f32x4 s = {0.f, 0.f, 0.f, 0.f}; f32x4 ddv[7]; f32x4 lv[7];
#pragma unroll
        for (int sc = 0; sc < 7; ++sc) { const int ui = bh * 8 + sc; ddv[sc] = *(const f32x4*)(dsc + ui * 128 + d0); lv[sc] = *(const f32x4*)(sloc + (size_t)ui * 128 * DV + 4 * (size_t)p4); }
        asm volatile("" ::: "memory");
#pragma unroll
        for (int sc = 0; sc < 7; ++sc) { const int ui = bh * 8 + sc;
            s = s * ddv[sc] + lv[sc]; u32x2 p; p.x = cvtpk(s[0], s[1]); p.y = cvtpk(s[2], s[3]); *(u32x2*)(sstart + (size_t)(ui + 1) * 128 * DV + 4 * (size_t)p4) = p; }
    }
}

__device__ __forceinline__ unsigned offb(unsigned row, unsigned ch) { return 256u * row + 16u * (ch ^ (((row & 3u) << 2) | ((row >> 2) & 3u))); }
__device__ __forceinline__ unsigned tr_addr(unsigned lane, unsigned c, unsigned ks, unsigned t) {
    const unsigned h = lane >> 5, blk = (lane >> 4) & 1, q = (lane & 15) >> 2, p = lane & 3;
    return offb(16 * ks + 8 * h + 4 * t + q, 4 * c + 2 * blk + (p >> 1)) + 8 * (p & 1);
}
typedef short v4i16_t __attribute__((ext_vector_type(4)));
__device__ __forceinline__ s16x4 ds_tr(LAS const unsigned char* p) { return __builtin_bit_cast(s16x4, __builtin_amdgcn_ds_read_tr16_b64_v4i16((LAS v4i16_t*)p)); }
__device__ __forceinline__ bf16x8 ld_tr_frag(LAS const unsigned char* tile, unsigned lane, unsigned c, unsigned ks) {
    const s16x4 lo = ds_tr(tile + tr_addr(lane, c, ks, 0)), hi = ds_tr(tile + tr_addr(lane, c, ks, 1));
    return __builtin_shufflevector(lo, hi, 0, 1, 2, 3, 4, 5, 6, 7);
}
__device__ __forceinline__ bf16x8 ld_row_frag(LAS const unsigned char* tile, unsigned row, unsigned ch) { return *(const LAS bf16x8*)(tile + offb(row, ch)); }
template <int S> __device__ __forceinline__ bf16x8 pack_step(const f32x16& x) {
    u32x4 w = {cvtpk(x[8 * S], x[8 * S + 1]), cvtpk(x[8 * S + 2], x[8 * S + 3]), cvtpk(x[8 * S + 4], x[8 * S + 5]), cvtpk(x[8 * S + 6], x[8 * S + 7])};
    return __builtin_bit_cast(bf16x8, w);
}
#define LD_FENCE() asm volatile("" ::: "memory")
#define MFMA32(a, b, c) __builtin_amdgcn_mfma_f32_32x32x16_bf16((a), (b), (c), 0, 0, 0)

struct LinArgs {
    const bf16* u; int pitch; int qoff, koff, voff, goff;
    const float* bcum;
    const float* lbraw;
    const float* gain;
    float* sloc; float* dsc; const bf16* sstart; bf16* mix; int mixoff;
};
#ifdef PROBE_LIN
#define LIN_T(k) do { if (PROBE_LIN_SEL) { if (threadIdx.x == 0) { const unsigned long long t_ = __builtin_amdgcn_s_memrealtime(); if ((k) == 0) tfirst_ = t_; if ((k) == PROBE_LIN + 1) ((volatile LAS unsigned*)(lds + MISC_OFF))[20] += (unsigned)(t_ - tprev_); if (PROBE_LIN == 9 && (k) == 4) ((volatile LAS unsigned*)(lds + MISC_OFF))[20] += (unsigned)(t_ - tfirst_); tprev_ = t_; } } } while (0)
#else
#define LIN_T(k) do {} while (0)
#endif
template <int DV, int NWH, bool HGRN, bool PB>
__device__ __forceinline__ void lin_unit(LAS unsigned char* lds, const int tid, const LinArgs& A, const int b, const int hbase, const int sc) {
    constexpr int NTH = 64 * NWH, NTQ = NTH / 128, TPT = 64 / NTQ, NHEADS = HGRN ? 8 : 4;
    constexpr int VS_OFF = 32768, AS_OFF = VS_OFF + DV * 128, DS_OFF = AS_OFF + 9216, RED_OFF = DS_OFF + 512, BT_OFF = RED_OFF + 2048, GT_OFF = BT_OFF + 4096, HEAD_LDS = GT_OFF + 4 * DV;
    static_assert(HEAD_LDS * (8 / NWH) <= MISC_OFF, "LDS");
    const int wv = __builtin_amdgcn_readfirstlane(tid >> 6), wl = wv % NWH, hs = wv / NWH, head = hbase + hs;
    LAS unsigned char* hl = lds + hs * HEAD_LDS;
    LAS unsigned char* Qs = hl; LAS unsigned char* Ks = hl + 16384; LAS unsigned char* Vs = hl + VS_OFF; LAS unsigned char* As = hl + AS_OFF;
    LAS float* Ds = (LAS float*)(hl + DS_OFF); LAS float* red = (LAS float*)(hl + RED_OFF); LAS float* btot = (LAS float*)(hl + BT_OFF); LAS float* gtab = (LAS float*)(hl + GT_OFF);
    const int ui = (b * NHEADS + head) * 8 + sc;
    f32x16 Sacc[4];
#pragma unroll
    for (int dt = 0; dt < 4; ++dt)
#pragma unroll
        for (int i = 0; i < 16; ++i) Sacc[dt][i] = 0.f;
    constexpr int NP = HGRN ? 1 : 1024 / NTH;
    u32x4 rk[NP], rq[NP], vv[4]; f32x4 b0[NP], b1[NP]; u32x2 hraw[8], qraw[8];
#define LIN_LOADS_K(tokb_) do { int tl_ = tid; asm volatile("" : "+v"(tl_)); const int th_ = tl_ - hs * NTH, tokb = (tokb_); \
        if (!HGRN) { _Pragma("unroll") for (int j = 0; j < NP; ++j) { const int item = th_ + j * NTH, t = item >> 4, c8 = item & 15; \
                rk[j] = *(const u32x4*)(A.u + UOFF(tokb + t, A.koff + head * 128 + 8 * c8, A.pitch)); \
                const f32x4* bp = (const f32x4*)(A.bcum + (size_t)(tokb + t) * 512 + head * 128 + 8 * c8); b0[j] = bp[0]; b1[j] = bp[1]; } } \
        else { const int dbase_ = 4 * (th_ & 31), tq8_ = th_ >> 5; _Pragma("unroll") for (int i = 0; i < 8; ++i) { const int tk = tokb + tq8_ * 8 + i; \
                hraw[i] = *(const u32x2*)(A.u + UOFF(tk, A.koff + head * 128 + dbase_, A.pitch)); } } \
        LD_FENCE(); } while (0)
#define LIN_LOADS_V(tokb_) do { int tl_ = tid; asm volatile("" : "+v"(tl_)); const int th_ = tl_ - hs * NTH, tokb = (tokb_); \
        _Pragma("unroll") for (int j = 0; j < 4; ++j) { const int item = th_ + j * NTH, t = item / (DV / 8), c8 = item % (DV / 8); vv[j] = *(const u32x4*)(A.u + UOFF(tokb + t, A.voff + head * DV + 8 * c8, A.pitch)); } \
        LD_FENCE(); } while (0)
#define LIN_LOADS_Q(tokb_) do { if (PB) { int tl_ = tid; asm volatile("" : "+v"(tl_)); const int th_ = tl_ - hs * NTH, tokb = (tokb_); \
        if (!HGRN) { _Pragma("unroll") for (int j = 0; j < NP; ++j) { const int item = th_ + j * NTH, t = item >> 4, c8 = item & 15; rq[j] = *(const u32x4*)(A.u + UOFF(tokb + t, A.qoff + head * 128 + 8 * c8, A.pitch)); } } \
        else { const int dbase_ = 4 * (th_ & 31), tq8_ = th_ >> 5; _Pragma("unroll") for (int i = 0; i < 8; ++i) { const int tk = tokb + tq8_ * 8 + i; qraw[i] = *(const u32x2*)(A.u + UOFF(tk, A.qoff + head * 128 + dbase_, A.pitch)); } } \
        LD_FENCE(); } } while (0)
#define LIN_LOADS(tokb_) do { LIN_LOADS_K(tokb_); if (!GVDB_) LIN_LOADS_V(tokb_); LIN_LOADS_Q(tokb_); } while (0)
    constexpr bool PRE = ((LIN_PREFETCH >> ((PB ? 2 : 0) + (HGRN ? 1 : 0))) & 1) != 0;
    constexpr bool GVDB_ = LIN_GVDB != 0 && !HGRN && PRE && NWH == 8 && DV == 256;
    if (PRE && !(HGRN && PB)) LIN_LOADS(b * SEQ + sc * 256);
    constexpr bool PARK = LIN_PARK != 0 && HGRN && PB && !PRE && NWH == 4 && DV == 128;
#define LIN_DMA4(tokb_, Kd_, Qd_, Vd_, m_) do { int tp_ = tid; asm volatile("" : "+v"(tp_)); const int l_ = tp_ & 63, tokd = (tokb_); \
        _Pragma("unroll") for (int j = 0; j < 4; ++j) { const int row = 16 * wl + 4 * j + (l_ >> 4), ch = (l_ & 15) ^ ((((l_ >> 4) & 3) << 2) | j); const unsigned pofs = (unsigned)(wl * 4 + j) * 1024u; \
            if ((m_) & 1) __builtin_amdgcn_global_load_lds((const unsigned*)(A.u + UOFF(tokd + row, A.koff + head * 128 + 8 * ch, A.pitch)), (LAS unsigned*)((Kd_) + pofs), 16, 0, 0); \
            if ((m_) & 2) __builtin_amdgcn_global_load_lds((const unsigned*)(A.u + UOFF(tokd + row, A.qoff + head * 128 + 8 * ch, A.pitch)), (LAS unsigned*)((Qd_) + pofs), 16, 0, 0); \
            if ((m_) & 4) __builtin_amdgcn_global_load_lds((const unsigned*)(A.u + UOFF(tokd + row, A.voff + head * DV + 8 * ch, A.pitch)), (LAS unsigned*)((Vd_) + pofs), 16, 0, 0); } } while (0)
#define LIN_DMA(tokb_) LIN_DMA4(tokb_, Ks, Qs, Vs, PARK_MASK)
#define LIN_TOUCH(tokb_) do { int tp_ = tid; asm volatile("" : "+v"(tp_)); const int l_ = tp_ & 63, tokd = (tokb_); LAS unsigned char* dum_ = lds + 2 * HEAD_LDS + wv * 1024; \
        _Pragma("unroll") for (int j = 0; j < 4; ++j) { const int row = 16 * wl + 4 * j + (l_ >> 4), ch = (l_ & 15) ^ ((((l_ >> 4) & 3) << 2) | j); \
            __builtin_amdgcn_global_load_lds((const unsigned*)(A.u + UOFF(tokd + row, A.koff + head * 128 + 8 * ch, A.pitch)), (LAS unsigned*)dum_, 16, 0, 0); \
            __builtin_amdgcn_global_load_lds((const unsigned*)(A.u + UOFF(tokd + row, A.qoff + head * 128 + 8 * ch, A.pitch)), (LAS unsigned*)dum_, 16, 0, 0); \
            __builtin_amdgcn_global_load_lds((const unsigned*)(A.u + UOFF(tokd + row, A.voff + head * DV + 8 * ch, A.pitch)), (LAS unsigned*)dum_, 16, 0, 0); } } while (0)
    constexpr bool PADB = LIN_PADB != 0 && HGRN && !PB && !PRE && NWH == 4 && DV == 128;
    static_assert(!PADB || (2 * HEAD_LDS + 1024 + 8192 <= MISC_OFF && AS_OFF + 16384 <= HEAD_LDS), "LDS (PADB)");
    if (PADB) { Ds = (LAS float*)(lds + 2 * HEAD_LDS + hs * 512); btot = (LAS float*)(lds + 2 * HEAD_LDS + 1024 + hs * 4096); LIN_DMA4(b * SEQ + sc * 256, Ks, Qs, Vs, 5); }
    constexpr bool GVDB = LIN_GVDB != 0 && !HGRN && PRE && NWH == 8 && DV == 256;
    static_assert(!GVDB || HEAD_LDS + 32768 <= MISC_OFF, "LDS (GVDB)");
#define LIN_DMA_V8(tokb_, Vd_) do { int tp_ = tid; asm volatile("" : "+v"(tp_)); const int l_ = tp_ & 63, tokd = (tokb_); \
        _Pragma("unroll") for (int j = 0; j < 4; ++j) { const int row = 16 * (wl & 3) + 4 * j + (l_ >> 4), ch = (l_ & 15) ^ ((((l_ >> 4) & 3) << 2) | j); const unsigned pofs = (unsigned)(wl * 4 + j) * 1024u; \
            __builtin_amdgcn_global_load_lds((const unsigned*)(A.u + UOFF(tokd + row, A.voff + head * DV + (wl >> 2) * 128 + 8 * ch, A.pitch)), (LAS unsigned*)((Vd_) + pofs), 16, 0, 0); } } while (0)
    if (GVDB) LIN_DMA_V8(b * SEQ + sc * 256, Vs);
    if (PB) { const int th_g = tid - hs * NTH; if (th_g < DV) gtab[th_g] = A.gain[th_g]; }
    if (PARK) LIN_DMA(b * SEQ + sc * 256);
    static_assert(!(LIN_TOUCHON && PARK) || 2 * HEAD_LDS + 8192 <= MISC_OFF, "LDS (touch)");
    if (PB && sc > 0) {
        const bf16* sp = A.sstart + ((((size_t)ui * (DV / 32) + wl) * 4) * 64 + (tid & 63)) * 16;
        u32x4 rw[4][2];
#pragma unroll
        for (int dt = 0; dt < 4; ++dt) { rw[dt][0] = *(const u32x4*)(sp + dt * 1024); rw[dt][1] = *(const u32x4*)(sp + dt * 1024 + 8); }
        LD_FENCE();
#pragma unroll
        for (int dt = 0; dt < 4; ++dt)
#pragma unroll
            for (int h2 = 0; h2 < 2; ++h2)
#pragma unroll
                for (int q = 0; q < 4; ++q) { const unsigned w = rw[dt][h2][q]; Sacc[dt][8 * h2 + 2 * q] = __uint_as_float(w << 16); Sacc[dt][8 * h2 + 2 * q + 1] = __uint_as_float(w & 0xffff0000u); }
    }
    if (PRE && HGRN && PB) LIN_LOADS(b * SEQ + sc * 256);
    float dsum = 0.f, lb = 0.f, oml = 1.f; float dsum8[8] = {0.f, 0.f, 0.f, 0.f, 0.f, 0.f, 0.f, 0.f};
    float lb4[4] = {0.f, 0.f, 0.f, 0.f}, oml4[4] = {1.f, 1.f, 1.f, 1.f};
    if (HGRN) {
#pragma unroll
        for (int e = 0; e < 4; ++e) { int tlb_ = tid; asm volatile("" : "+v"(tlb_)); const int d0_ = 4 * ((tlb_ - hs * NTH) & 31) + e; lb4[e] = sigmoidf(A.lbraw[1024 + head * 128 + d0_] - A.lbraw[head * 128 + d0_]); oml4[e] = 1.f - lb4[e]; } }
    if (PARK || PADB || GVDB) { asm volatile("s_waitcnt vmcnt(0)" ::: "memory"); __syncthreads(); }
    for (int c = 0; c < 4; ++c) {
        const int tok0 = b * SEQ + sc * 256 + c * 64;
        int tid_c = tid; asm volatile("" : "+v"(tid_c));
#ifdef PROBE_LIN
        unsigned long long tprev_ = 0, tfirst_ = 0;
#endif
        LIN_T(0);
        const int th = tid_c - hs * NTH, lane = tid_c & 63, r = lane & 31, hb = lane >> 5;
        const int d = th & 127, tq = th >> 7;
        const unsigned wofs = 2u * (d & 7);
        if (GVDB) Vs = (c & 1) ? hl + HEAD_LDS : hl + VS_OFF;
        if (PADB) { Ks = (c & 1) ? hl : hl + 16384; Vs = (c & 1) ? hl + AS_OFF : hl + VS_OFF;
            if (c < 3) LIN_DMA4(tok0 + 64, ((c & 1) ? hl + 16384 : hl), Qs, ((c & 1) ? hl + VS_OFF : hl + AS_OFF), 5); }
        if (!PRE && !PARK && !PADB) LIN_LOADS(tok0);
        if (LIN_TOUCHON && PARK && c < 3) LIN_TOUCH(tok0 + 64);
        if (PARK || PADB) { const int dbase_ = 4 * (th & 31), tq8_ = th >> 5;
#pragma unroll
            for (int i = 0; i < 8; ++i) { const int t = tq8_ * 8 + i; if (PARK_MASK & 1) hraw[i] = *(const LAS u32x2*)(Ks + offb(t, dbase_ >> 3) + 2 * (dbase_ & 7)); if (PB && (PARK_MASK & 2)) qraw[i] = *(const LAS u32x2*)(Qs + offb(t, dbase_ >> 3) + 2 * (dbase_ & 7)); }
            if ((PARK_MASK & 7) != 7) { if (!(PARK_MASK & 1)) LIN_LOADS_K(tok0); if (!(PARK_MASK & 4)) LIN_LOADS_V(tok0); if (!(PARK_MASK & 2)) LIN_LOADS_Q(tok0); } }
        if (!GVDB && (!(PARK || PADB) || !(PARK_MASK & 4))) {
#pragma unroll
          for (int j = 0; j < 4; ++j) { const int item = th + j * NTH, t = item / (DV / 8), c8 = item % (DV / 8); *(LAS u32x4*)(Vs + (c8 >> 4) * 16384 + offb(t, c8 & 15)) = vv[j]; } }
        float blast;
        if (!HGRN) {
#pragma unroll
            for (int j = 0; j < NP; ++j) { const int item = th + j * NTH, t = item >> 4, c8 = item & 15;
                float bb[8] = {b0[j][0], b0[j][1], b0[j][2], b0[j][3], b1[j][0], b1[j][1], b1[j][2], b1[j][3]};
                float kf[8], qf[8];
#pragma unroll
                for (int e = 0; e < 4; ++e) { kf[2 * e] = __uint_as_float(rk[j][e] << 16); kf[2 * e + 1] = __uint_as_float(rk[j][e] & 0xffff0000u); if (PB) { qf[2 * e] = __uint_as_float(rq[j][e] << 16); qf[2 * e + 1] = __uint_as_float(rq[j][e] & 0xffff0000u); } }
                u32x4 ko, qo;
#pragma unroll
                for (int e = 0; e < 4; ++e) { ko[e] = cvtpk(kf[2 * e] * __expf(-bb[2 * e]), kf[2 * e + 1] * __expf(-bb[2 * e + 1]));
                    if (PB) qo[e] = cvtpk(qf[2 * e] * QSCALE * __expf(bb[2 * e]), qf[2 * e + 1] * QSCALE * __expf(bb[2 * e + 1])); }
                *(LAS u32x4*)(Ks + offb(t, c8)) = ko; if (PB) *(LAS u32x4*)(Qs + offb(t, c8)) = qo;
                if (t == 63) {
#pragma unroll
                    for (int e = 0; e < 8; ++e) { Ds[8 * c8 + e] = __expf(bb[e]); dsum8[e] += bb[e]; } } }
            blast = 0.f;
        } else {
            constexpr int TP = 8; const int dbase = 4 * (th & 31), tq8 = th >> 5;
            float kl[TP][4], ql[TP][4];
            f32x4 lip = {1.f, 1.f, 1.f, 1.f};
#pragma unroll
            for (int i = 0; i < TP; ++i) { const float hv[4] = {__uint_as_float(hraw[i].x << 16), __uint_as_float(hraw[i].x & 0xffff0000u), __uint_as_float(hraw[i].y << 16), __uint_as_float(hraw[i].y & 0xffff0000u)};
                const float hq[4] = {__uint_as_float(qraw[i].x << 16), __uint_as_float(qraw[i].x & 0xffff0000u), __uint_as_float(qraw[i].y << 16), __uint_as_float(qraw[i].y & 0xffff0000u)};
#pragma unroll
                for (int e = 0; e < 4; ++e) { const float eh = __expf(-hv[e]), g = __builtin_amdgcn_rcpf(1.0f + lb4[e] * eh); kl[i][e] = __builtin_fmaf(-lb4[e], eh, eh) * (g * lip[e]); lip[e] *= (1.0f + eh) * g;
                    if (PB) { const float eq = __expf(-hq[e]); ql[i][e] = hq[e] * __builtin_amdgcn_rcpf((1.0f + eq) * lip[e]); } } }
            *(LAS f32x4*)(btot + tq8 * 128 + dbase) = lip;
            __syncthreads();
            f32x4 offi = {1.f, 1.f, 1.f, 1.f}, toti = offi;
#pragma unroll
            for (int q = 0; q < 8; ++q) { const f32x4 v = *(const LAS f32x4*)(btot + q * 128 + dbase); toti *= v; if (q < tq8) offi *= v; }
            f32x4 poff = {1.f, 1.f, 1.f, 1.f};
            if (PB) {
#pragma unroll
                for (int e = 0; e < 4; ++e) poff[e] = __builtin_amdgcn_rcpf(offi[e]); }
#pragma unroll
            for (int i = 0; i < TP; ++i) { const int t = tq8 * TP + i;
                u32x2 kp; kp.x = cvtpk(kl[i][0] * offi[0], kl[i][1] * offi[1]); kp.y = cvtpk(kl[i][2] * offi[2], kl[i][3] * offi[3]); *(LAS u32x2*)(Ks + offb(t, dbase >> 3) + 2 * (dbase & 7)) = kp;
                if (PB) { u32x2 qp; qp.x = cvtpk(ql[i][0] * poff[0], ql[i][1] * poff[1]); qp.y = cvtpk(ql[i][2] * poff[2], ql[i][3] * poff[3]); *(LAS u32x2*)(Qs + offb(t, dbase >> 3) + 2 * (dbase & 7)) = qp; } }
            if (tq8 == 0) {
#pragma unroll
                for (int e = 0; e < 4; ++e) { Ds[dbase + e] = __builtin_amdgcn_rcpf(toti[e]); dsum8[e] -= __logf(toti[e]); } }
            blast = 0.f;
        }
        __syncthreads(); LIN_T(1);
        if (GVDB && c < 3) LIN_DMA_V8(tok0 + 64, ((c & 1) ? hl + VS_OFF : hl + HEAD_LDS));
        f32x16 o0, o1;
        u32x2 ggv[4][2]; float gsl[4][2][4];
        constexpr bool GE = PB && ((LIN_GATE_EARLY >> (HGRN ? 1 : 0)) & 1) != 0;
        constexpr bool SUE = PB && ((LIN_SU_EARLY >> (HGRN ? 1 : 0)) & 1) != 0;
        if (PB) {
#pragma unroll
            for (int g = 0; g < 4; ++g) { const int e0 = 32 * wl + 8 * g + 4 * hb;
#pragma unroll
                for (int tt = 0; tt < 2; ++tt) ggv[g][tt] = *(const u32x2*)(A.u + UOFF(tok0 + 32 * tt + r, A.goff + head * DV + e0, A.pitch)); }
            LD_FENCE();
        }
        if (PRE && !(LIN_QLATE && HGRN && PB) && c < 3) { LIN_LOADS_K(tok0 + 64); if (!GVDB) LIN_LOADS_V(tok0 + 64); LIN_LOADS_Q(tok0 + 64); }
        bf16x8 vf[4];
        if (PARK || SUE) {
#pragma unroll
            for (int ks = 0; ks < 4; ++ks) vf[ks] = ld_tr_frag(Vs + (wl >> 2) * 16384, lane, wl & 3, ks); }
        if (PB) {
            if (wl < 4) {
                const int tt = wl >> 1, st = wl & 1;
                f32x16 sa;
#pragma unroll
                for (int i = 0; i < 16; ++i) sa[i] = 0.f;
                if (st <= tt) {
#pragma unroll
                    for (int ks = 0; ks < 8; ++ks) { const bf16x8 af = ld_row_frag(Ks, 32 * st + r, 2 * ks + hb), bq = ld_row_frag(Qs, 32 * tt + r, 2 * ks + hb); sa = MFMA32(af, bq, sa); }
                    if (st == tt) {
#pragma unroll
                        for (int i = 0; i < 16; ++i) if (crow(i, hb) > r) sa[i] = 0.f; }
                }
#pragma unroll
                for (int g = 0; g < 4; ++g) { u32x2 p; p.x = cvtpk(sa[4 * g], sa[4 * g + 1]); p.y = cvtpk(sa[4 * g + 2], sa[4 * g + 3]);
                    *(LAS u32x2*)(As + (32 * tt + r) * 144 + (32 * st + 8 * g + 4 * hb) * 2) = p; }
            }
#pragma unroll
            for (int i = 0; i < 16; ++i) { o0[i] = 0.f; o1[i] = 0.f; }
#pragma unroll
            for (int dt = 0; dt < 4; ++dt) {
                const bf16x8 sf0 = pack_step<0>(Sacc[dt]), sf1 = pack_step<1>(Sacc[dt]);
#pragma unroll
                for (int s2 = 0; s2 < 2; ++s2) {
                    const u32x2 qa0 = *(const LAS u32x2*)(Qs + offb(r, 4 * dt + 2 * s2) + 8 * hb), qb0 = *(const LAS u32x2*)(Qs + offb(r, 4 * dt + 2 * s2 + 1) + 8 * hb);
                    const u32x2 qa1 = *(const LAS u32x2*)(Qs + offb(32 + r, 4 * dt + 2 * s2) + 8 * hb), qb1 = *(const LAS u32x2*)(Qs + offb(32 + r, 4 * dt + 2 * s2 + 1) + 8 * hb);
                    const u32x4 q0 = {qa0.x, qa0.y, qb0.x, qb0.y}, q1 = {qa1.x, qa1.y, qb1.x, qb1.y};
                    o0 = MFMA32(s2 ? sf1 : sf0, __builtin_bit_cast(bf16x8, q0), o0); o1 = MFMA32(s2 ? sf1 : sf0, __builtin_bit_cast(bf16x8, q1), o1); } }
            if (SUE) {
#pragma unroll
        for (int ks = 0; ks < 4; ++ks)
#pragma unroll
            for (int dt = 0; dt < 4; ++dt) { const bf16x8 kf = ld_tr_frag(Ks, lane, dt, ks); Sacc[dt] = MFMA32(kf, vf[ks], Sacc[dt]); }
#pragma unroll
        for (int dt = 0; dt < 4; ++dt)
#pragma unroll
            for (int g = 0; g < 4; ++g) { const f32x4 dv = *(const LAS f32x4*)(Ds + 32 * dt + 8 * g + 4 * hb);
#pragma unroll
                for (int e = 0; e < 4; ++e) Sacc[dt][4 * g + e] *= dv[e]; }
            if (GE) {
#pragma unroll
                for (int g = 0; g < 4; ++g) { const int e0 = 32 * wl + 8 * g + 4 * hb; const f32x4 gn = *(const LAS f32x4*)(gtab + e0);
#pragma unroll
                    for (int tt = 0; tt < 2; ++tt) { const u32x2 gg = ggv[g][tt];
                        const float gv[4] = {__uint_as_float(gg.x << 16), __uint_as_float(gg.x & 0xffff0000u), __uint_as_float(gg.y << 16), __uint_as_float(gg.y & 0xffff0000u)};
#pragma unroll
                        for (int e = 0; e < 4; ++e) gsl[g][tt][e] = gn[e] * (gv[e] * __builtin_amdgcn_rcpf(1.0f + __expf(-gv[e]))); } } }
            }
            __syncthreads(); LIN_T(2);
            if (PARK) {
#pragma unroll
                for (int g = 0; g < 4; ++g) { asm volatile("" :: "v"(ggv[g][0])); asm volatile("" :: "v"(ggv[g][1])); } }
            if (PARK && c < 3) LIN_DMA4(tok0 + 64, Ks, Qs, Vs, PARK_MASK & (SUE ? 7 : 4));
        }
        if (!PARK && !SUE) {
#pragma unroll
            for (int ks = 0; ks < 4; ++ks) vf[ks] = ld_tr_frag(Vs + (wl >> 2) * 16384, lane, wl & 3, ks); }
        if (PB) {
#pragma unroll
            for (int ks = 0; ks < 4; ++ks) {
                const bf16x8 a1 = *(const LAS bf16x8*)(As + (32 + r) * 144 + 32 * ks + 16 * hb); o1 = MFMA32(vf[ks], a1, o1);
                if (ks < 2) { const bf16x8 a0 = *(const LAS bf16x8*)(As + r * 144 + 32 * ks + 16 * hb); o0 = MFMA32(vf[ks], a0, o0); } }
            if (GE && !SUE) {
#pragma unroll
                for (int g = 0; g < 4; ++g) { const int e0 = 32 * wl + 8 * g + 4 * hb; const f32x4 gn = *(const LAS f32x4*)(gtab + e0);
#pragma unroll
                    for (int tt = 0; tt < 2; ++tt) { const u32x2 gg = ggv[g][tt];
                        const float gv[4] = {__uint_as_float(gg.x << 16), __uint_as_float(gg.x & 0xffff0000u), __uint_as_float(gg.y << 16), __uint_as_float(gg.y & 0xffff0000u)};
#pragma unroll
                        for (int e = 0; e < 4; ++e) gsl[g][tt][e] = gn[e] * (gv[e] * __builtin_amdgcn_rcpf(1.0f + __expf(-gv[e]))); } } }
        }
        if (!SUE) {
#pragma unroll
        for (int ks = 0; ks < 4; ++ks)
#pragma unroll
            for (int dt = 0; dt < 4; ++dt) { const bf16x8 kf = ld_tr_frag(Ks, lane, dt, ks); Sacc[dt] = MFMA32(kf, vf[ks], Sacc[dt]); }
#pragma unroll
        for (int dt = 0; dt < 4; ++dt)
#pragma unroll
            for (int g = 0; g < 4; ++g) { const f32x4 dv = *(const LAS f32x4*)(Ds + 32 * dt + 8 * g + 4 * hb);
#pragma unroll
                for (int e = 0; e < 4; ++e) Sacc[dt][4 * g + e] *= dv[e]; }
        }
        if (PRE && LIN_QLATE && HGRN && PB && c < 3) { LIN_LOADS_K(tok0 + 64); LIN_LOADS_V(tok0 + 64); LIN_LOADS_Q(tok0 + 64); }
        if (PB) {
            float s0 = 0.f, s1 = 0.f;
#pragma unroll
            for (int i = 0; i < 16; ++i) { s0 += o0[i] * o0[i]; s1 += o1[i] * o1[i]; }
            s0 += __shfl_xor(s0, 32); s1 += __shfl_xor(s1, 32);
            if (hb == 0) { red[wl * 64 + r] = s0; red[wl * 64 + 32 + r] = s1; }
            __syncthreads(); LIN_T(3);
            if (PARK && !SUE && c < 3) LIN_DMA4(tok0 + 64, Ks, Qs, Vs, PARK_MASK & 3);
#ifdef PARK_DEBUG_SYNC
            if (PARK) { asm volatile("s_waitcnt vmcnt(0)" ::: "memory"); __syncthreads(); }
#endif
            float t0 = 0.f, t1 = 0.f;
#pragma unroll
            for (int w = 0; w < NWH; ++w) { t0 += red[w * 64 + r]; t1 += red[w * 64 + 32 + r]; }
            const float rs0 = 1.0f / sqrtf(t0 * (1.0f / DV) + EPS), rs1 = 1.0f / sqrtf(t1 * (1.0f / DV) + EPS);
#pragma unroll
            for (int g = 0; g < 4; ++g) { const int e0 = 32 * wl + 8 * g + 4 * hb; const f32x4 gn = *(const LAS f32x4*)(gtab + e0);
#pragma unroll
                for (int tt = 0; tt < 2; ++tt) { const size_t tok = (size_t)(tok0 + 32 * tt + r); const u32x2 gg = ggv[g][tt];
                    const float g0 = __uint_as_float(gg.x << 16), g1 = __uint_as_float(gg.x & 0xffff0000u), g2 = __uint_as_float(gg.y << 16), g3 = __uint_as_float(gg.y & 0xffff0000u);
                    const float rs = tt ? rs1 : rs0;
                    float v0, v1, v2, v3;
                    if (GE) { v0 = (tt ? o1[4 * g] : o0[4 * g]) * rs * gsl[g][tt][0]; v1 = (tt ? o1[4 * g + 1] : o0[4 * g + 1]) * rs * gsl[g][tt][1]; v2 = (tt ? o1[4 * g + 2] : o0[4 * g + 2]) * rs * gsl[g][tt][2]; v3 = (tt ? o1[4 * g + 3] : o0[4 * g + 3]) * rs * gsl[g][tt][3]; }
                    else { v0 = (tt ? o1[4 * g] : o0[4 * g]) * rs * gn[0] * (g0 * __builtin_amdgcn_rcpf(1.0f + __expf(-g0))); v1 = (tt ? o1[4 * g + 1] : o0[4 * g + 1]) * rs * gn[1] * (g1 * __builtin_amdgcn_rcpf(1.0f + __expf(-g1)));
                        v2 = (tt ? o1[4 * g + 2] : o0[4 * g + 2]) * rs * gn[2] * (g2 * __builtin_amdgcn_rcpf(1.0f + __expf(-g2))); v3 = (tt ? o1[4 * g + 3] : o0[4 * g + 3]) * rs * gn[3] * (g3 * __builtin_amdgcn_rcpf(1.0f + __expf(-g3))); }
                    u32x2 p; p.x = cvtpk(v0, v1); p.y = cvtpk(v2, v3); *(u32x2*)(A.mix + tok * 2048 + A.mixoff + head * DV + e0) = p; } }
        }
        if (PARK || PADB || GVDB) asm volatile("s_waitcnt vmcnt(0)" ::: "memory");
        __syncthreads(); LIN_T(4);
    }
    if (!PB) {
        int tid_e = tid; asm volatile("" : "+v"(tid_e));
        const int th = tid_e - hs * NTH, d = th & 127, tq = th >> 7;
        float* sp = A.sloc + ((((size_t)ui * (DV / 32) + wl) * 4) * 64 + (tid_e & 63)) * 16;
#pragma unroll
        for (int dt = 0; dt < 4; ++dt)
#pragma unroll
            for (int g = 0; g < 4; ++g) *(f32x4*)(sp + dt * 1024 + 4 * g) = (f32x4){Sacc[dt][4 * g], Sacc[dt][4 * g + 1], Sacc[dt][4 * g + 2], Sacc[dt][4 * g + 3]};
        if (HGRN) { if ((th >> 5) == 0) {
#pragma unroll
            for (int e = 0; e < 4; ++e) A.dsc[ui * 128 + 4 * (th & 31) + e] = __expf(dsum8[e]); } }
        else if (th >= NTH - 16) {
#pragma unroll
            for (int e = 0; e < 8; ++e) A.dsc[ui * 128 + 8 * (th - (NTH - 16)) + e] = __expf(dsum8[e]); }
    }
}

namespace att {
constexpr int D = 128;
constexpr float SCALE = 0.08838834764831845f, INV_SCALE = 11.313708498984761f;
constexpr float THR = 8.f;
constexpr int NW = 8, QBLK = 32, KVBLK = 64, QB = NW * QBLK;
constexpr int SHM_V = KVBLK * D * 2, SHM_K = KVBLK * D * 2;
constexpr int LDS_CORE = 2 * SHM_V + 2 * SHM_K + NW * 64 * 4;
constexpr int OFF_BIAS = LDS_CORE, OFF_SEL = OFF_BIAS + 8192, OFF_KM = OFF_SEL + 1024, OFF_SCAN = OFF_KM + 3584, LDS_ATT = OFF_SCAN + 64;
static_assert(LDS_ATT <= MISC_OFF, "attention LDS");
#define KSWZ(row, colB) ((row) * 256 + ((colB) ^ (((row) & 7) << 4)))
#define SBAR() __builtin_amdgcn_sched_barrier(0)
__device__ __forceinline__ int v_st(int k, int c) { const int kk = (k & ~0xC) | ((k & 4) << 1) | ((k & 8) >> 1); return ((kk >> 3) * 4 + (c >> 5)) * 512 + ((kk & 7) * 32 + (c & 31)) * 2; }
__device__ __forceinline__ int v_rd_base(int lane) { return ((lane & 3) << 3) | (((lane >> 2) & 3) << 6) | (((lane >> 4) & 1) << 5) | (((lane >> 5) & 1) << 8); }
constexpr int v_rd_off(int d0, int ks, int half) { return d0 * 512 + ks * 4096 + half * 2048; }
__device__ __forceinline__ unsigned cvtpk_a(float lo, float hi) { unsigned r; asm volatile("v_cvt_pk_bf16_f32 %0, %1, %2" : "=v"(r) : "v"(lo), "v"(hi)); return r; }
__device__ __forceinline__ bf16x8 load8(const bf16* p) { return *reinterpret_cast<const bf16x8*>(p); }
__device__ __forceinline__ void mask_tile(f32x16& p0, f32x16& p1, int dq) {
    const float NEG = -__builtin_inff();
#pragma unroll
    for (int r = 0; r < 16; ++r) {
        const int c = (r & 3) + 8 * (r >> 2);
        if (dq - c < 0) p0[r] = NEG;
        if (dq - c - 32 < 0) p1[r] = NEG;
    }
}
__device__ __forceinline__ void partialSM(f32x16& p0, f32x16& p1, float& m_reg, float& mn, float& alpha, const bool keep) {
    float pmax = p0[0]; for (int r = 1; r < 16; ++r) pmax = fmaxf(pmax, p0[r]); for (int r = 0; r < 16; ++r) pmax = fmaxf(pmax, p1[r]);
    { auto rr = __builtin_amdgcn_permlane32_swap(__float_as_uint(pmax), __float_as_uint(pmax), false, false);
      pmax = fmaxf(__uint_as_float(rr[0]), __uint_as_float(rr[1])); }
    pmax = keep ? pmax : -__builtin_inff();
    constexpr float C2 = 1.4426950408889634f * SCALE;
    if (__builtin_expect(__all((pmax - m_reg) * SCALE <= THR), 1)) { mn = m_reg; alpha = 1.f; }
    else { mn = fmaxf(m_reg, pmax); alpha = __builtin_amdgcn_exp2f((m_reg - mn) * C2); m_reg = mn; }
    const float mnL = keep ? -mn * C2 : -__builtin_inff();
    for (int r = 0; r < 16; ++r) p0[r] = fmaf(p0[r], C2, mnL); for (int r = 0; r < 16; ++r) p1[r] = fmaf(p1[r], C2, mnL);
    for (int r = 0; r < 16; ++r) p0[r] = __builtin_amdgcn_exp2f(p0[r]);
}
__device__ __forceinline__ void finishSM(f32x16& p0, f32x16& p1, float alpha, float& l_reg, bf16x8& pa0, bf16x8& pa1, bf16x8& pa2, bf16x8& pa3) {
    for (int r = 0; r < 16; ++r) p1[r] = __builtin_amdgcn_exp2f(p1[r]);
    float ps = 0; for (int r = 0; r < 16; ++r) ps += p0[r]; for (int r = 0; r < 16; ++r) ps += p1[r];
    { auto rr = __builtin_amdgcn_permlane32_swap(__float_as_uint(ps), __float_as_uint(ps), false, false);
      ps = __uint_as_float(rr[0]) + __uint_as_float(rr[1]); }
    l_reg = l_reg * alpha + ps;
#define PK4(P, B_, OUT) do { unsigned a0 = cvtpk_a(P[B_+0], P[B_+1]), a1 = cvtpk_a(P[B_+2], P[B_+3]);                          \
        unsigned b0 = cvtpk_a(P[B_+4], P[B_+5]), b1 = cvtpk_a(P[B_+6], P[B_+7]);                                             \
        auto r0 = __builtin_amdgcn_permlane32_swap(a0, b0, false, false); auto r1 = __builtin_amdgcn_permlane32_swap(a1, b1, false, false); \
        u32x4 w = {r0[0], r1[0], r0[1], r1[1]}; OUT = *reinterpret_cast<bf16x8*>(&w); } while (0)
    PK4(p0, 0, pa0); PK4(p0, 8, pa1); PK4(p1, 0, pa2); PK4(p1, 8, pa3);
#undef PK4
}
template <int KB>
__device__ __forceinline__ void qkt(f32x16& p0, f32x16& p1, const char* K_lds, int r32, int hi, const bf16x8* qr, const float* bp) {
#pragma unroll
    for (int g = 0; g < 4; ++g) { const f32x4 b0 = *(const f32x4*)(bp + 8 * g), b1 = *(const f32x4*)(bp + 32 + 8 * g);
#pragma unroll
        for (int e = 0; e < 4; ++e) { p0[4 * g + e] = b0[e]; p1[4 * g + e] = b1[e]; } }
    const char* kb[4];
#pragma unroll
    for (int dd = 0; dd < 4; ++dd) kb[dd] = K_lds + KB * SHM_K + KSWZ(r32, (dd * 16 + hi * 8) * 2);
#pragma unroll
    for (int d0 = 0; d0 < 8; ++d0) { const char* a = kb[d0 & 3] + (d0 >> 2) * 128;
        bf16x8 b0 = *reinterpret_cast<const bf16x8*>(a);
        bf16x8 b1 = *reinterpret_cast<const bf16x8*>(a + 32 * 256);
        p0 = __builtin_amdgcn_mfma_f32_32x32x16_bf16(b0, qr[d0], p0, 0, 0, 0);
        p1 = __builtin_amdgcn_mfma_f32_32x32x16_bf16(b1, qr[d0], p1, 0, 0, 0); }
}
template <int VB>
__device__ __forceinline__ void pv_tile(f32x16* o, int vb0, bf16x8 pa0, bf16x8 pa1, bf16x8 pa2, bf16x8 pa3) {
#define TRRD(dst, off) asm volatile("ds_read_b64_tr_b16 %0, %1 offset:%2" : "=&v"(dst) : "v"(vb0), "i"(off) : "memory")
#define PV_D0(d0) do { s16x4 l0, l1, l2, l3, h0, h1, h2, h3; constexpr int b_ = VB * SHM_V + v_rd_off(d0, 0, 0);   \
        TRRD(l0, b_); TRRD(h0, b_ + 2048); TRRD(l1, b_ + 4096); TRRD(h1, b_ + 6144); TRRD(l2, b_ + 8192); TRRD(h2, b_ + 10240); TRRD(l3, b_ + 12288); TRRD(h3, b_ + 14336); \
        asm volatile("s_waitcnt lgkmcnt(0)" ::: "memory"); SBAR();   \
        o[d0] = __builtin_amdgcn_mfma_f32_32x32x16_bf16(pa0, (bf16x8){l0[0], l0[1], l0[2], l0[3], h0[0], h0[1], h0[2], h0[3]}, o[d0], 0, 0, 0);   \
        o[d0] = __builtin_amdgcn_mfma_f32_32x32x16_bf16(pa1, (bf16x8){l1[0], l1[1], l1[2], l1[3], h1[0], h1[1], h1[2], h1[3]}, o[d0], 0, 0, 0);   \
        o[d0] = __builtin_amdgcn_mfma_f32_32x32x16_bf16(pa2, (bf16x8){l2[0], l2[1], l2[2], l2[3], h2[0], h2[1], h2[2], h2[3]}, o[d0], 0, 0, 0);   \
        o[d0] = __builtin_amdgcn_mfma_f32_32x32x16_bf16(pa3, (bf16x8){l3[0], l3[1], l3[2], l3[3], h3[0], h3[1], h3[2], h3[3]}, o[d0], 0, 0, 0); } while (0)
    PV_D0(0); PV_D0(1); PV_D0(2); PV_D0(3);
#undef PV_D0
#undef TRRD
}
struct Blk { const bf16* u; int tokb, qcol, kcol, vcol; bf16* O; int P0; };
struct Seam { bf16x8 qr[8]; bf16x8 st_v0, st_v1, st_k0, st_k1; };
#define ROW(colbase, k0, rr) (Ub + UOFF(tokb_ + (k0) + (rr), (colbase) + sc, pitch))
#define VMW() asm volatile("s_waitcnt vmcnt(0)" ::: "memory")
#define VMWN(n) asm volatile("s_waitcnt vmcnt(%0)" :: "i"(n) : "memory")
#define SLOAD_H(Kp, Vp, k0) do { S.st_v0 = load8(ROW(Vp, k0, sr)); S.st_v1 = load8(ROW(Vp, k0, 32 + sr));              \
                         S.st_k0 = load8(ROW(Kp, k0, sr)); S.st_k1 = load8(ROW(Kp, k0, 32 + sr)); } while (0)
#define SWRITE_HK(bf) do { *(bf16x8*)(K_lds + (bf) * SHM_K + kws) = S.st_k0; *(bf16x8*)(K_lds + (bf) * SHM_K + kws + 32 * 256) = S.st_k1; } while (0)
#define SWRITE_HV(bf) do { *(bf16x8*)(V_lds + (bf) * SHM_V + vst0) = S.st_v0; *(bf16x8*)(V_lds + (bf) * SHM_V + vst1) = S.st_v1; } while (0)
#define SWRITE_H(bf) do { SWRITE_HV(bf); SWRITE_HK(bf); } while (0)
__device__ __forceinline__ void prime(const Blk& cur, char* lds, Seam& S, const int pitch) {
    const int tid = otid(), wid = __builtin_amdgcn_readfirstlane(tid >> 6), lane = tid & 63, r32 = lane & 31, hi = lane >> 5;
    const int sr = tid >> 4, sc = (tid & 15) * 8, kws = KSWZ(sr, sc * 2); char* K_lds = lds + 2 * SHM_V;
    const bf16* Ub = cur.u; const int tokb_ = cur.tokb;
    for (int d0 = 0; d0 < 8; ++d0) S.qr[d0] = load8(cur.u + UOFF(cur.tokb + cur.P0 + wid * QBLK + r32, cur.qcol + d0 * 16 + hi * 8, pitch));
    SLOAD_H(cur.kcol, cur.vcol, ATT_REV ? cur.P0 + QB - KVBLK : 0); VMW(); SWRITE_HK(0);
    __syncthreads();
}
__device__ __forceinline__ void block(const Blk& cur, const Blk& nxt, char* lds, Seam& S, const int pitch, const int opitch, const unsigned selbits, const float* biasL) {
    const int tid = otid(), wid = __builtin_amdgcn_readfirstlane(tid >> 6), lane = tid & 63, r32 = lane & 31, hi = lane >> 5;
    const int NT = cur.P0 / KVBLK + QB / KVBLK;
    const int qbn = cur.P0 >> 8;
    const int qlo = cur.P0 + wid * QBLK, qm = qlo + r32 - 4 * hi;
    char* V_lds = lds; char* K_lds = lds + 2 * SHM_V;
    float* ws = (float*)(lds + 2 * SHM_V + 2 * SHM_K) + wid * 64; float* li_l = ws, * al_l = ws + 32;
    float m_reg = -1e30f, l_reg = 0; f32x16 o[4] = {};
    const int sr = tid >> 4, sc = (tid & 15) * 8, vst0 = v_st(sr, sc), vst1 = v_st(32 + sr, sc), kws = KSWZ(sr, sc * 2);
    const int vb0 = (int)(uintptr_t)V_lds + v_rd_base(lane);
    const int Kh = cur.kcol, Vh = cur.vcol; const bf16* Ub = cur.u; const int tokb_ = cur.tokb;
#define RESC(a) do { if (__any((a) < 1.f)) { if (hi == 0) al_l[r32] = (a); asm volatile("s_waitcnt lgkmcnt(0)" ::: "memory");              \
                     for (int d_ = 0; d_ < 4; ++d_) for (int r = 0; r < 16; ++r) o[d_][r] *= al_l[crow(r, hi)]; } } while (0)
#define KBASE(t) ((ATT_REV ? NT - 1 - (t) : (t)) * KVBLK)
#define MASKT(P0_, P1_, t) do { const int kb_ = KBASE(t); if ((kb_ >> 8) >= qbn && kb_ + KVBLK - 1 > qlo) mask_tile(P0_, P1_, qm - kb_); } while (0)
#define KEEPT(t) ((KBASE(t) >> 8) >= qbn || ((selbits >> (KBASE(t) >> 8)) & 1u))
#define BIASP(t) (biasL + KBASE(t) + 4 * hi)
    constexpr int NQL = 8;
#define SEAM_K0() do { VMWN(NQL); SWRITE_HK(0); SBAR(); } while (0)
    f32x16 pA0, pA1, pB0, pB1; float mnA, mnB, alA, alB; bf16x8 pa0, pa1, pa2, pa3;
    SWRITE_HV(0); SBAR();
    SLOAD_H(Kh, Vh, KBASE(1));
    SBAR(); qkt<0>(pA0, pA1, K_lds, r32, hi, S.qr, BIASP(0));
    MASKT(pA0, pA1, 0); partialSM(pA0, pA1, m_reg, mnA, alA, KEEPT(0));
    VMW(); SWRITE_H(1);
    __syncthreads();
#define HALF_STEP(PX0, PX1, mnX, alX, PY0, PY1, alY, t, KB, VB, SB) do {                                                      \
        SBAR(); qkt<KB>(PX0, PX1, K_lds, r32, hi, S.qr, BIASP(t));                                                           \
        finishSM(PY0, PY1, alY, l_reg, pa0, pa1, pa2, pa3); SBAR();                                                           \
        if ((t) + 1 < NT) { SLOAD_H(Kh, Vh, KBASE((t) + 1)); SBAR(); }                                                        \
        pv_tile<VB>(o, vb0, pa0, pa1, pa2, pa3); MASKT(PX0, PX1, (t)); partialSM(PX0, PX1, m_reg, mnX, alX, KEEPT(t));        \
        __syncthreads();                                                                                                      \
        if ((t) + 1 < NT) { VMW(); SWRITE_H(SB); }                                                                            \
        RESC(alX); __syncthreads(); } while (0)
    for (int t = 1; t + 1 < NT; t += 2) {
        HALF_STEP(pB0, pB1, mnB, alB, pA0, pA1, alA, t, 1, 0, 0);
        HALF_STEP(pA0, pA1, mnA, alA, pB0, pB1, alB, t + 1, 0, 1, 1);
    }
    SBAR(); qkt<1>(pB0, pB1, K_lds, r32, hi, S.qr, BIASP(NT - 1)); SBAR();
    SLOAD_H(nxt.kcol, nxt.vcol, ATT_REV ? nxt.P0 + QB - KVBLK : 0); SBAR();
#pragma unroll
    for (int d0 = 0; d0 < 8; ++d0) S.qr[d0] = load8(nxt.u + UOFF(nxt.tokb + nxt.P0 + wid * QBLK + r32, nxt.qcol + d0 * 16 + hi * 8, pitch));
    SBAR();
    finishSM(pA0, pA1, alA, l_reg, pa0, pa1, pa2, pa3); SBAR();
    pv_tile<0>(o, vb0, pa0, pa1, pa2, pa3);
    MASKT(pB0, pB1, NT - 1); partialSM(pB0, pB1, m_reg, mnB, alB, KEEPT(NT - 1)); __syncthreads(); RESC(alB);
    finishSM(pB0, pB1, alB, l_reg, pa0, pa1, pa2, pa3); SBAR(); pv_tile<1>(o, vb0, pa0, pa1, pa2, pa3);
    SBAR(); SEAM_K0();
#ifdef PROBE_ATT
    unsigned long long te_ = 0; if (threadIdx.x == 0) te_ = __builtin_amdgcn_s_memrealtime();
#endif
    if (hi == 0) li_l[r32] = l_reg; asm volatile("s_waitcnt lgkmcnt(0)" ::: "memory");
    float rli[16];
#pragma unroll
    for (int r = 0; r < 16; ++r) rli[r] = __builtin_amdgcn_rcpf(li_l[crow(r, hi)]);
    bf16* Ow = cur.O + (size_t)(wid * QBLK) * opitch;
#pragma unroll
    for (int r = 0; r < 16; ++r) { const int orow = crow(r, hi);
#pragma unroll
        for (int d0 = 0; d0 < 4; ++d0) { const float v = o[d0][r] * rli[r];
            const float vn = __shfl_xor(v, 1);
            if ((r32 & 1) == 0) *(unsigned*)(Ow + (size_t)orow * opitch + d0 * 32 + r32) = cvtpk_a(v, vn); } }
    __syncthreads();
#ifdef PROBE_ATT
    if (PROBE_ATT == 2 && threadIdx.x == 0) ((volatile unsigned*)(lds + MISC_OFF))[20] += (unsigned)(__builtin_amdgcn_s_memrealtime() - te_);
#endif
#undef RESC
#undef KBASE
#undef MASKT
#undef KEEPT
#undef BIASP
#undef SEAM_K0
#undef HALF_STEP
}
#undef ROW
#undef VMW
#undef VMWN
#undef SLOAD_H
#undef SWRITE_HK
#undef SWRITE_HV
#undef SWRITE_H

__device__ __forceinline__ void cfox_seq(char* lds, const float* ffl, const float* fbias, float* cfox, const int b, const int h) {
    const int tid = otid(), lane = tid & 63, wave = tid >> 6;
    float* scanw = (float*)(lds + OFF_SCAN);
    const float fb = fbias[h];
    float v[4]; float run = 0.f;
#pragma unroll
    for (int i = 0; i < 4; ++i) v[i] = ffl[(size_t)(b * SEQ + 4 * tid + i) * 8 + h];
    asm volatile("" ::: "memory");
#pragma unroll
    for (int i = 0; i < 4; ++i) { run += log_sigmoid(v[i] + fb); v[i] = run; }
    float incl = run;
#pragma unroll
    for (int o = 1; o < 64; o <<= 1) { const float t = __shfl_up(incl, o); if (lane >= o) incl += t; }
    __syncthreads();
    if (lane == 63) scanw[wave] = incl;
    __syncthreads();
    float off = incl - run;
    for (int w = 0; w < wave; ++w) off += scanw[w];
    *(f32x4*)(cfox + (size_t)(b * 8 + h) * SEQ + 4 * tid) = (f32x4){v[0] + off, v[1] + off, v[2] + off, v[3] + off};
}
__device__ __forceinline__ void setup(char* lds, const int mode, const Blk& cur, const int pitch, const int b, const int h, const float* kmean, const float* ff, const float* fbias, const int pass) {
    const int tid = otid(), lane = tid & 63, wave = tid >> 6;
    float* biasL = (float*)(lds + OFF_BIAS); unsigned* selm = (unsigned*)(lds + OFF_SEL); float* kms = (float*)(lds + OFF_KM); float* scanw = (float*)(lds + OFF_SCAN);
    const int qb = cur.P0 >> 8;
    if (mode == 0) {
        const float slope = exp2f(-(float)(h + 1)) * INV_SCALE;
        if (qb > 3) for (int i = tid; i < qb * 128; i += 512) kms[i] = kmean[(size_t)((b * 8 + h) * 8) * 128 + i];
        for (int s = tid; s < cur.P0 + 256; s += 512) biasL[s] = slope * (float)(s - cur.P0);
        __syncthreads();
        const int row = tid >> 1, dh = tid & 1;
        unsigned bits = (1u << qb) - 1u;
        if (qb > 3) {
            float acc[7] = {0.f, 0.f, 0.f, 0.f, 0.f, 0.f, 0.f};
            bf16x8 qv8[8];
#pragma unroll
            for (int c = 0; c < 8; ++c) qv8[c] = load8(cur.u + UOFF(cur.tokb + cur.P0 + row, cur.qcol + 64 * dh + 8 * c, pitch));
            asm volatile("" ::: "memory");
#pragma unroll
            for (int c = 0; c < 8; ++c) { const bf16x8 qv = qv8[c];
#pragma unroll
                for (int e = 0; e < 8; ++e) { const float qf = bf2f((unsigned short)qv[e]);
#pragma unroll
                    for (int n = 0; n < 7; ++n) acc[n] += qf * kms[n * 128 + 64 * dh + 8 * c + e]; } }
#pragma unroll
            for (int n = 0; n < 7; ++n) acc[n] += __shfl_xor(acc[n], 1);
            bits = 0u;
#pragma unroll
            for (int pick = 0; pick < 3; ++pick) { float best = -__builtin_inff(); int bi = 0;
#pragma unroll
                for (int n = 0; n < 7; ++n) if (n < qb && !((bits >> n) & 1u) && acc[n] > best) { best = acc[n]; bi = n; }
                bits |= 1u << bi; }
        }
        if (dh == 0) selm[row] = bits;
        __syncthreads();
    } else if (pass != 0) {
        const float bref = biasL[cur.P0];
        __syncthreads();
#pragma unroll
        for (int i = 0; i < 4; ++i) biasL[4 * tid + i] -= bref;
        __syncthreads();
    } else {
#if FOX_CSUM_EARLY
        (void)fbias; (void)scanw; (void)lane; (void)wave;
        float v[4]; { const f32x4 c4 = *(const f32x4*)(ff + (size_t)(b * 8 + h) * SEQ + 4 * tid); v[0] = c4[0]; v[1] = c4[1]; v[2] = c4[2]; v[3] = c4[3]; }
#pragma unroll
        for (int i = 0; i < 4; ++i) biasL[4 * tid + i] = v[i];
        __syncthreads();
#else
        const float fb = fbias[h];
        float v[4]; float run = 0.f;
#pragma unroll
        for (int i = 0; i < 4; ++i) v[i] = ff[(size_t)(b * SEQ + 4 * tid + i) * 8 + h];
        asm volatile("" ::: "memory");
#pragma unroll
        for (int i = 0; i < 4; ++i) { run += log_sigmoid(v[i] + fb); v[i] = run; }
        float incl = run;
#pragma unroll
        for (int o = 1; o < 64; o <<= 1) { const float t = __shfl_up(incl, o); if (lane >= o) incl += t; }
        if (lane == 63) scanw[wave] = incl;
        __syncthreads();
        float off = incl - run;
        for (int w = 0; w < wave; ++w) off += scanw[w];
#pragma unroll
        for (int i = 0; i < 4; ++i) { v[i] += off; biasL[4 * tid + i] = v[i]; }
        __syncthreads();
#endif
        const float cref = biasL[cur.P0];
        __syncthreads();
#pragma unroll
        for (int i = 0; i < 4; ++i) biasL[4 * tid + i] = (cref - v[i]) * INV_SCALE;
        if (tid < 256) selm[tid] = 0xffu;
        __syncthreads();
    }
}
__device__ __forceinline__ void pair_item(char* lds, const int item, const int mode, const bf16* u, const int pitch, const int qoff, const int koff, const int voff,
                                          bf16* mix, const int mixoff, const float* kmean, const float* ff, const float* fbias) {
    const int bh = item >> 2, x = item & 3, b = bh >> 3, h = bh & 7;
    bf16* obase = mix + (size_t)(b * SEQ) * 2048 + mixoff + h * 128;
    const float* biasL = (const float*)(lds + OFF_BIAS); const unsigned* selm = (const unsigned*)(lds + OFF_SEL);
    Blk cur;
    cur.P0 = x * 256; cur.u = u; cur.tokb = b * SEQ; cur.qcol = qoff + h * 128; cur.kcol = koff + h * 128; cur.vcol = voff + h * 128; cur.O = obase + (size_t)cur.P0 * 2048;
    Seam S;
    for (int pass = 0; pass < 2; ++pass) {
#ifdef PROBE_ATT
        unsigned long long ta_ = 0; if (threadIdx.x == 0) ta_ = __builtin_amdgcn_s_memrealtime();
#endif
        setup(lds, mode, cur, pitch, b, h, kmean, ff, fbias, pass);
#ifdef PROBE_ATT
        if (threadIdx.x == 0) { const unsigned long long tb_ = __builtin_amdgcn_s_memrealtime(); if (PROBE_ATT == 0 && mode == PROBE_ATT_MODE) ((volatile unsigned*)(lds + MISC_OFF))[20] += (unsigned)(tb_ - ta_); ta_ = tb_; }
#endif
        if (pass == 0) prime(cur, lds, S, pitch);
        Blk nxt = cur;
        if (pass == 0) { nxt.P0 = (7 - x) * 256; nxt.O = obase + (size_t)nxt.P0 * 2048; }
        const int t_ = otid();
        const unsigned sel = selm[(t_ >> 6) * 32 + (t_ & 31)];
        block(cur, nxt, lds, S, pitch, 2048, sel, biasL);
#ifdef PROBE_ATT
        if (threadIdx.x == 0) { const unsigned long long tb_ = __builtin_amdgcn_s_memrealtime(); if (PROBE_ATT == 1 && mode == PROBE_ATT_MODE) ((volatile unsigned*)(lds + MISC_OFF))[20] += (unsigned)(tb_ - ta_); }
#endif
        cur = nxt;
    }
}
}

template <int DV, bool HGRN>
__device__ __forceinline__ void ref_lin(LAS unsigned char* lds, const int tid, const int G, const bf16* u, const int pitch, const int qoff, const int koff, const int voff, const int goff,
                                        const float* glr, const float* w2, const float* gb, const float* lbraw, const float* gain, bf16* mix, const int mixoff) {
    constexpr int NDP = 512 / DV, DPP = 128 / NDP, NHEADS = HGRN ? 8 : 4, TPG = 16 / NDP, NWG = DV / 64;
    LAS float* qs = (LAS float*)lds; LAS float* ks = qs + 16 * 128; LAS float* dcs = ks + 16 * 128; LAS float* ored = dcs + 16 * 128; LAS float* wred = ored + NDP * 16 * DV;
    const int e = tid % DV, dp = tid / DV, lane = tid & 63, wave = tid >> 6;
    for (int unit = blockIdx.x; unit < NB * NHEADS; unit += G) {
        const int b = unit / NHEADS, head = unit % NHEADS;
        float S[DPP];
#pragma unroll
        for (int i = 0; i < DPP; ++i) S[i] = 0.f;
        for (int t0 = 0; t0 < SEQ; t0 += 16) {
            for (int idx = tid; idx < 16 * 128; idx += 512) { const int tt = idx >> 7, d = idx & 127; const size_t tok = (size_t)(b * SEQ + t0 + tt);
                float q, k, dc;
                if (!HGRN) { float z = gb[head * 128 + d]; for (int r = 0; r < 16; ++r) z += glr[tok * 16 + r] * w2[r * 512 + head * 128 + d];
                    dc = expf(log_sigmoid(z) * (1.0f / 16.0f)); q = bf2f(u[UOFF((int)tok, qoff + head * 128 + d, pitch)]) * QSCALE; k = bf2f(u[UOFF((int)tok, koff + head * 128 + d, pitch)]); }
                else { const float lb = sigmoidf(lbraw[1024 + head * 128 + d] - lbraw[head * 128 + d]); const float f = lb + (1.f - lb) * sigmoidf(bf2f(u[UOFF((int)tok, koff + head * 128 + d, pitch)]));
                    dc = f; k = 1.f - f; const float hq = bf2f(u[UOFF((int)tok, qoff + head * 128 + d, pitch)]); q = hq * sigmoidf(hq); }
                qs[idx] = q; ks[idx] = k; dcs[idx] = dc; }
            __syncthreads();
            for (int tt = 0; tt < 16; ++tt) { const size_t tok = (size_t)(b * SEQ + t0 + tt); const float v = bf2f(u[UOFF((int)tok, voff + head * DV + e, pitch)]); float op = 0.f;
#pragma unroll
                for (int i = 0; i < DPP; ++i) { const int d = dp * DPP + i; S[i] = dcs[tt * 128 + d] * S[i] + ks[tt * 128 + d] * v; op += S[i] * qs[tt * 128 + d]; }
                ored[(dp * 16 + tt) * DV + e] = op; }
            __syncthreads();
            float ov[TPG];
#pragma unroll
            for (int j = 0; j < TPG; ++j) { const int tt = dp * TPG + j; float o = 0.f;
#pragma unroll
                for (int p = 0; p < NDP; ++p) o += ored[(p * 16 + tt) * DV + e];
                ov[j] = o; const float sq = wave_sum(o * o); if (lane == 0) wred[wave * TPG + j] = sq; }
            __syncthreads();
#pragma unroll
            for (int j = 0; j < TPG; ++j) { const int tt = dp * TPG + j; float tot = 0.f;
#pragma unroll
                for (int w = 0; w < NWG; ++w) tot += wred[(dp * NWG + w) * TPG + j];
                const float rs = 1.0f / sqrtf(tot * (1.0f / DV) + EPS); const size_t tok = (size_t)(b * SEQ + t0 + tt);
                const float g = bf2f(u[UOFF((int)tok, goff + head * DV + e, pitch)]);
                mix[tok * 2048 + mixoff + head * DV + e] = f2bf(ov[j] * rs * gain[e] * (g * sigmoidf(g))); }
            __syncthreads();
        }
    }
}
__device__ __forceinline__ void ref_cfox(const float* ff, const float* fbias, float* cfox, const int G, const int tid) {
    const int gid = blockIdx.x * 512 + tid;
    if (gid < 64) { const int b = gid >> 3, h = gid & 7; float run = 0.f;
        for (int s = 0; s < SEQ; ++s) { run += log_sigmoid(ff[(size_t)(b * SEQ + s) * 8 + h] + fbias[h]); cfox[(size_t)gid * SEQ + s] = run; } }
}
__device__ __forceinline__ void ref_att(LAS unsigned char* lds, const int tid, const int G, const int mode, const bf16* u, const int pitch, const int qoff, const int koff, const int voff,
                                        bf16* mix, const int mixoff, const float* kmean, const float* cfox) {
    const int lane = tid & 63, wave = tid >> 6;
    LAS float* qf = (LAS float*)lds + wave * 128;
    for (int rowid = blockIdx.x * NWAVES + wave; rowid < NB * 8 * SEQ; rowid += G * NWAVES) {
        const int b = rowid >> 14, h = (rowid >> 11) & 7, t = rowid & 2047, j = t >> 8;
        const unsigned qq = *(const unsigned*)(u + UOFF(b * SEQ + t, qoff + h * 128 + 2 * lane, pitch));
        const float q0 = __uint_as_float(qq << 16), q1 = __uint_as_float(qq & 0xffff0000u);
        qf[2 * lane] = q0; qf[2 * lane + 1] = q1;
        unsigned bits = 0xffu;
        if (mode == 0) {
            float gate[7];
#pragma unroll
            for (int n = 0; n < 7; ++n) { const float* km = kmean + (size_t)((b * 8 + h) * 8 + n) * 128; gate[n] = wave_sum(q0 * km[2 * lane] + q1 * km[2 * lane + 1]); }
            if (j <= 3) bits = (1u << j) - 1u;
            else { bits = 0u;
#pragma unroll
                for (int pick = 0; pick < 3; ++pick) { float best = -__builtin_inff(); int bi = 0;
#pragma unroll
                    for (int n = 0; n < 7; ++n) if (n < j && !((bits >> n) & 1u) && gate[n] > best) { best = gate[n]; bi = n; }
                    bits |= 1u << bi; } }
        }
        const float slope = exp2f(-(float)(h + 1));
        const float ct = mode ? cfox[(size_t)(b * 8 + h) * SEQ + t] : 0.f;
        float m = -1e30f, l = 0.f, o0 = 0.f, o1 = 0.f;
        for (int kb = 0; kb <= t; kb += 64) {
            const int s = kb + lane; const int sc = s <= t ? s : t;
            bool valid = s <= t;
            if (mode == 0 && valid) { const int n = s >> 8; valid = (n == j) || ((bits >> n) & 1u); }
            float dot = 0.f;
            for (int c = 0; c < 16; ++c) { const bf16x8 kv = *(const bf16x8*)(u + UOFF(b * SEQ + sc, koff + h * 128 + 8 * c, pitch));
#pragma unroll
                for (int e = 0; e < 8; ++e) dot += qf[8 * c + e] * bf2f((unsigned short)kv[e]); }
            const float bias = mode ? (ct - cfox[(size_t)(b * 8 + h) * SEQ + sc]) : -slope * (float)(t - sc);
            const float logit = valid ? dot * QSCALE + bias : -__builtin_inff();
            const float mx = wave_max(logit), mnew = fmaxf(m, mx), alpha = expf(m - mnew);
            const float p = valid ? expf(logit - mnew) : 0.f;
            l = l * alpha + wave_sum(p); o0 *= alpha; o1 *= alpha; m = mnew;
            const int nk = (t - kb + 1) < 64 ? (t - kb + 1) : 64;
            for (int jj = 0; jj < nk; ++jj) { const float pj = __shfl(p, jj); const unsigned vv = *(const unsigned*)(u + UOFF(b * SEQ + kb + jj, voff + h * 128 + 2 * lane, pitch));
                o0 += pj * __uint_as_float(vv << 16); o1 += pj * __uint_as_float(vv & 0xffff0000u); }
        }
        const float inv = 1.0f / l;
        *(unsigned*)(mix + (size_t)(b * SEQ + t) * 2048 + mixoff + h * 128 + 2 * lane) = cvtpk(o0 * inv, o1 * inv);
    }
}

#ifndef ONE_LAUNCH
#define ONE_LAUNCH 1
#endif
#ifndef REF_LIN0
#define REF_LIN0 0
#endif
#ifndef REF_LIN1
#define REF_LIN1 0
#endif
#ifndef REF_ATT0
#define REF_ATT0 0
#endif
#ifndef REF_ATT1
#define REF_ATT1 0
#endif
#ifndef PROBES
#define PROBES 0
#endif
#if PROBES
#define KV(x) (K->variant & (x))
#else
#define KV(x) 0
#endif
#ifndef PG_SP2
#define PG_SP2 true
#endif
#ifndef PG_ALIGN
#define PG_ALIGN true
#endif
#ifndef STAGGER_STEPS
#define STAGGER_STEPS 0
#endif
#define STAGGER() do { if (STAGGER_STEPS > 0) { const int n_ = (int)((blockIdx.x >> 3) & 15u); for (int i_ = 0; i_ < n_; ++i_) __builtin_amdgcn_s_sleep(STAGGER_STEPS); } } while (0)
constexpr int N_PHASES = 20;
__global__ void __launch_bounds__(NWAVES * 64, 2) fwd(Args a_unused) {
    extern __shared__ __attribute__((aligned(16))) unsigned char lds_raw[];
    LAS unsigned char* lds = (LAS unsigned char*)lds_raw;
    volatile LAS unsigned* MISC = (volatile LAS unsigned*)(lds + MISC_OFF);
    const int G = gridDim.x;
    if (threadIdx.x < 64) MISC[threadIdx.x] = 0u;
#ifdef PROBE_WAIT
    if (threadIdx.x == 22) { MISC[22] = (unsigned)__builtin_amdgcn_s_memrealtime(); MISC[21] = MISC[22]; }
#endif
    __syncthreads();
    int lo, hi;
    XcdBarrier bar;
    { KArgsP K = kargs(); lo = K->ph_lo; hi = K->ph_hi; unsigned char* ws = K->ws;
      bar.bar = (unsigned*)(ws + WS_CTL) + CW_BAR; bar.x = 0; bar.st = nullptr;
      if (hi - lo > 1) bar = xcd_barrier_post((unsigned*)(ws + WS_CTL) + CW_BAR, MISC + 8); }
#define PH(k) (lo <= (k) && (k) < hi)
#ifndef SEAM_REPS
#define SEAM_REPS 1
#endif
#ifndef PROBE_WAIT_MASK
#define PROBE_WAIT_MASK 0xffffffffu
#endif
#ifdef PROBE_WAIT
#ifndef PROBE_PHASE
#define PROBE_PHASE (-1)
#endif
#define SEAM(k) do { if (PH(k) && PH((k) + 1)) { unsigned long long t0_ = 0; if (threadIdx.x == 0) { t0_ = __builtin_amdgcn_s_memrealtime(); if ((k) == PROBE_PHASE) MISC[20] += (unsigned)t0_ - MISC[22]; } xcd_barrier(bar); \
        if (threadIdx.x == 0) { const unsigned long long t1_ = __builtin_amdgcn_s_memrealtime(); MISC[22] = (unsigned)t1_; if ((PROBE_WAIT_MASK >> (k)) & 1u) MISC[20] += (unsigned)(t1_ - t0_); } } } while (0)
#else
#define SEAM(k) do { if (PH(k) && PH((k) + 1)) { for (int r_ = 0; r_ < SEAM_REPS; ++r_) xcd_barrier(bar); } } while (0)
#endif
#define WSP(T, off) ((T*)(ws + (off)))
#if XCD_AFFINE
#define MIXIDX(w) ((((w) & 7) << 5) | ((w) >> 3))
#else
#define MIXIDX(w) (w)
#endif

    if (PH(0)) { KArgsP K = kargs(); const int tid = otid(), lane = tid & 63, wave = __builtin_amdgcn_readfirstlane(tid >> 6); (void)lane; (void)wave; if (!KV(32)) phase_transposes(lds, K, G, (int)blockIdx.x, wave, lane, 0, (CONV_WGS > 0 && G == 256) ? TR_P0 : TR_TOTAL, 12288, TR_STATIC); __syncthreads();
#ifdef PROBE_N0
        unsigned long long tn_ = 0; if (threadIdx.x == 0) tn_ = __builtin_amdgcn_s_memrealtime();
#endif
        if (!KV(64)) phase_norm0(lds, K, G, tid, wave, lane); __syncthreads();
#ifdef PROBE_N0
        if (threadIdx.x == 0) MISC[20] += (unsigned)(__builtin_amdgcn_s_memrealtime() - tn_);
#endif
        }
    SEAM(0);
    for (int layer = 0; layer < 2; ++layer) {
        const int pb = 1 + 9 * layer;
        if (PH(pb + 0)) {
            KArgsP K = kargs(); const int tid = otid(), lane = tid & 63, wave = __builtin_amdgcn_readfirstlane(tid >> 6); (void)lane; (void)wave; unsigned char* ws = K->ws; const int NU = layer ? NU1 : NU0;
            const bf16* h16 = (const bf16*)((unsigned char*)K->out + OUT_H16);
#ifdef PROBE_FF
            unsigned long long tf_ = 0; if (layer == 1 && threadIdx.x == 0) tf_ = __builtin_amdgcn_s_memrealtime();
#endif
            if (layer == 1) phase_ff(lds, K->in[11], K->in[10], h16, WSP(float, WS_ROWSS2), WSP(float, WS_FF), G, tid, wave, lane);
#ifdef PROBE_FF
            if (layer == 1) { __syncthreads(); if (threadIdx.x == 0) MISC[20] += (unsigned)(__builtin_amdgcn_s_memrealtime() - tf_); }
#endif
            const int GG = (layer == 0 && CONV_WGS > 0 && G == 256) ? 256 - CONV_WGS : G;
            if (CONV_WGS > 0 && (int)blockIdx.x >= GG) { if (!KV(32)) phase_transposes_deep(lds, K, G - GG, (int)blockIdx.x - GG, wave, lane, TR_P0, TR_TOTAL); }
            else {
            pg8::Gemm g{h16, WSP(bf16, layer ? WS_WIN1 : WS_WIN0), MTOK, NU, DM, KV(4), 1, WTILED}; pg8::StaticOrder S; S.init(MTOK, NU, GG, (int)blockIdx.x);
            int pm0 = -1; { pg8::Unit u0; if (S.next(0, u0)) pm0 = u0.pm; }
            LAS float* rtab = (LAS float*)(lds + 131072);
            if (pm0 >= 0 && tid < 256) { const f32x4* pp = (const f32x4*)(WSP(float, layer ? WS_ROWSS2 : WS_ROWSS) + (size_t)(pm0 * 256 + tid) * 32); float sq = 0.f;
#pragma unroll
                for (int q = 0; q < 8; ++q) { const f32x4 t = pp[q]; sq += (t[0] + t[1]) + (t[2] + t[3]); }
                rtab[tid] = __builtin_amdgcn_rsqf(sq * (1.0f / 2048.0f) + EPS); }
            __syncthreads();
            pg8::EpiScale<0, UTILED != 0> E{WSP(bf16, WS_U), NU, WSP(float, layer ? WS_ROWSS2 : WS_ROWSS), 0, rtab, pm0};
            STAGGER();
            pg8::gemm_phase<pg8::EpiScale<0, UTILED != 0>, pg8::StaticOrder, PG_ALIGN, PG_SP2>(lds, g, S, E);
            }
        }
        SEAM(pb + 0);
        if (PH(pb + 1)) {
            KArgsP K = kargs(); const int tid = otid(), lane = tid & 63, wave = __builtin_amdgcn_readfirstlane(tid >> 6); (void)lane; (void)wave; unsigned char* ws = K->ws;
            if (layer == 0) {
#ifdef PROBE_KMEAN
                unsigned long long tk_ = 0; if (threadIdx.x == 0) tk_ = __builtin_amdgcn_s_memrealtime();
#endif
                phase_kmean(lds, WSP(bf16, WS_U), WSP(float, WS_KMEAN), G, tid);
#ifdef PROBE_KMEAN
                __syncthreads(); if (threadIdx.x == 0) MISC[20] += (unsigned)(__builtin_amdgcn_s_memrealtime() - tk_);
#endif
#if !REF_LIN0
                LinArgs L{WSP(bf16, WS_U), NU0, C0_GQ, C0_GK, C0_GV, C0_GG, WSP(float, WS_BCUM), nullptr, K->in[5], WSP(float, WS_P), WSP(float, WS_DSC), WSP(bf16, WS_S), WSP(bf16, WS_P), 0};
                for (int w = blockIdx.x; w < 256; w += G) { const int unit = MIXIDX(w), sc = unit & 7; if (sc < 7) lin_unit<256, 8, false, false>(lds, tid, L, unit >> 5, (unit >> 3) & 3, sc); }
#endif
            } else {
#if !REF_LIN1
                LinArgs L{WSP(bf16, WS_U), NU1, C1_HQ, C1_HF, C1_HI, C1_HG, nullptr, K->in[18], K->in[13], WSP(float, WS_P), WSP(float, WS_DSC), WSP(bf16, WS_S), WSP(bf16, WS_P), 1024};
                for (int w = blockIdx.x; w < 256; w += G) { const int unit = MIXIDX(w), sc = unit & 7; if (sc < 7) lin_unit<128, 4, true, false>(lds, tid, L, unit >> 5, 2 * ((unit >> 3) & 3), sc);
#if FOX_CSUM_EARLY
                    else { att::cfox_seq((char*)lds_raw, WSP(float, WS_FF), K->in[12], WSP(float, WS_CFOX), unit >> 5, 2 * ((unit >> 3) & 3)); att::cfox_seq((char*)lds_raw, WSP(float, WS_FF), K->in[12], WSP(float, WS_CFOX), unit >> 5, 2 * ((unit >> 3) & 3) + 1); }
#endif
                }
#endif
            }
        }
        SEAM(pb + 1);
        if (PH(pb + 2)) {
            KArgsP K = kargs(); const int tid = otid(), lane = tid & 63, wave = __builtin_amdgcn_readfirstlane(tid >> 6); (void)lane; (void)wave; unsigned char* ws = K->ws; (void)ws;
#ifdef PROBE_BURN
            if (KV(16)) {
                const bf16x8 a0 = *(const bf16x8*)(WSP(bf16, WS_U) + (size_t)tid * 64), b0 = *(const bf16x8*)(WSP(bf16, WS_U) + (size_t)tid * 64 + 8);
                const bf16x8 a1 = *(const bf16x8*)(WSP(bf16, WS_U) + (size_t)tid * 64 + 16), b1 = *(const bf16x8*)(WSP(bf16, WS_U) + (size_t)tid * 64 + 24);
                f32x4 acc[16];
#pragma unroll
                for (int i = 0; i < 16; ++i) acc[i] = (f32x4){0.f, 0.f, 0.f, 0.f};
                for (int it = 0; it < 32768 / 16; ++it) {
#pragma unroll
                    for (int i = 0; i < 16; ++i) acc[i] = __builtin_amdgcn_mfma_f32_16x16x32_bf16((i & 1) ? a1 : a0, (i & 2) ? b1 : b0, acc[i], 0, 0, 0);
                }
                float sum = 0.f;
#pragma unroll
                for (int i = 0; i < 16; ++i) sum += acc[i][0] + acc[i][1] + acc[i][2] + acc[i][3];
                if (sum == 1.2345f) WSP(float, WS_CFOX)[tid] = sum;
            } else
#endif
            if (layer == 0) {
#if !REF_LIN0
                phase_scan<256>(WSP(float, WS_P), WSP(float, WS_DSC), WSP(bf16, WS_S), G, tid);
#endif
            } else {
#if !REF_LIN1
                phase_scan<128>(WSP(float, WS_P), WSP(float, WS_DSC), WSP(bf16, WS_S), G, tid);
#endif
#if REF_ATT1
                ref_cfox(WSP(float, WS_FF), K->in[12], WSP(float, WS_CFOX), G, tid);
#endif
            }
        }
        SEAM(pb + 2);
        if (PH(pb + 3)) {
            KArgsP K = kargs(); const int tid = otid(), lane = tid & 63, wave = __builtin_amdgcn_readfirstlane(tid >> 6); (void)lane; (void)wave; unsigned char* ws = K->ws;
            const int variant = KV(0xff);
            if (variant & 1) {} else
            if (layer == 0) {
#if REF_LIN0
                ref_lin<256, false>(lds, tid, G, WSP(bf16, WS_U), NU0, C0_GQ, C0_GK, C0_GV, C0_GG, WSP(float, WS_GLR), K->in[3], K->in[4], nullptr, K->in[5], WSP(bf16, WS_P), 0);
#else
                { LinArgs L{WSP(bf16, WS_U), NU0, C0_GQ, C0_GK, C0_GV, C0_GG, WSP(float, WS_BCUM), nullptr, K->in[5], WSP(float, WS_P), WSP(float, WS_DSC), WSP(bf16, WS_S), WSP(bf16, WS_P), 0};
#ifdef PROBE_LINB
                  unsigned long long tl_ = 0; if (PROBE_LINB == 0 && threadIdx.x == 0) tl_ = __builtin_amdgcn_s_memrealtime();
#endif
                  for (int w = blockIdx.x; w < 256; w += G) { const int unit = MIXIDX(w); lin_unit<256, 8, false, true>(lds, tid, L, unit >> 5, (unit >> 3) & 3, unit & 7); }
#ifdef PROBE_LINB
                if (PROBE_LINB == 0 && threadIdx.x == 0) MISC[20] += (unsigned)(__builtin_amdgcn_s_memrealtime() - tl_);
#endif
                }
#endif
#if REF_ATT0
                ref_att(lds, tid, G, 0, WSP(bf16, WS_U), NU0, C0_MQ, C0_MK, C0_MV, WSP(bf16, WS_P), 1024, WSP(float, WS_KMEAN), nullptr);
#endif
            } else {
#if REF_LIN1
                ref_lin<128, true>(lds, tid, G, WSP(bf16, WS_U), NU1, C1_HQ, C1_HF, C1_HI, C1_HG, nullptr, nullptr, nullptr, K->in[18], K->in[13], WSP(bf16, WS_P), 1024);
#else
                { LinArgs L{WSP(bf16, WS_U), NU1, C1_HQ, C1_HF, C1_HI, C1_HG, nullptr, K->in[18], K->in[13], WSP(float, WS_P), WSP(float, WS_DSC), WSP(bf16, WS_S), WSP(bf16, WS_P), 1024};
#ifdef PROBE_LINB
                  unsigned long long tl_ = 0; if (PROBE_LINB == 1 && threadIdx.x == 0) tl_ = __builtin_amdgcn_s_memrealtime();
#endif
                  for (int w = blockIdx.x; w < 256; w += G) { const int unit = MIXIDX(w); lin_unit<128, 4, true, true>(lds, tid, L, unit >> 5, 2 * ((unit >> 3) & 3), unit & 7); }
#ifdef PROBE_LINB
                if (PROBE_LINB == 1 && threadIdx.x == 0) MISC[20] += (unsigned)(__builtin_amdgcn_s_memrealtime() - tl_);
#endif
                }
#endif
#if REF_ATT1
                ref_att(lds, tid, G, 1, WSP(bf16, WS_U), NU1, C1_FQ, C1_FK, C1_FV, WSP(bf16, WS_P), 0, nullptr, WSP(float, WS_CFOX));
#endif
            }
            if (!(variant & 2) && ((layer == 0 && !REF_ATT0) || (layer == 1 && !REF_ATT1))) {
                const int pitch = layer ? NU1 : NU0, qoff = layer ? C1_FQ : C0_MQ, koff = layer ? C1_FK : C0_MK, voff = layer ? C1_FV : C0_MV, mixoff = layer ? 0 : 1024;
                for (int w = blockIdx.x; w < 256; w += G) att::pair_item((char*)lds_raw, MIXIDX(w), layer, WSP(bf16, WS_U), pitch, qoff, koff, voff, WSP(bf16, WS_P), mixoff, WSP(float, WS_KMEAN), WSP(float, FOX_CSUM_EARLY ? WS_CFOX : WS_FF), K->in[12]);
            }
        }
        SEAM(pb + 3);
        if (PH(pb + 4)) {
            KArgsP K = kargs(); const int tid = otid(), lane = tid & 63, wave = __builtin_amdgcn_readfirstlane(tid >> 6); (void)lane; (void)wave; unsigned char* ws = K->ws;
            pg8::Gemm g{WSP(bf16, WS_P), WSP(bf16, layer ? WS_WOUT1 : WS_WOUT0), MTOK, DM, DM, 0, 0, WTILED}; pg8::StaticOrder S; S.init(MTOK, DM, G, (int)blockIdx.x);
            bf16* h16 = (bf16*)((unsigned char*)K->out + OUT_H16);
#if RESID0_F32
            if (layer == 0) { pg8::EpiResid<true, false> E{K->in[0], h16, WSP(float, WS_ROWSS), 0, nullptr}; pg8::gemm_phase<pg8::EpiResid<true, false>, pg8::StaticOrder, PG_ALIGN, PG_SP2>(lds, g, S, E); }
#else
            if (false) {}
#endif
            else { pg8::EpiResid<false, false> E{h16, h16, WSP(float, WS_ROWSS), 0, nullptr}; pg8::gemm_phase<pg8::EpiResid<false, false>, pg8::StaticOrder, PG_ALIGN, PG_SP2>(lds, g, S, E); }
        }
        SEAM(pb + 4);
        for (int half = 0; half < MLP_SPLIT; ++half) {
            if (PH(pb + 5 + 2 * half)) {
                KArgsP K = kargs(); const int tid = otid(), lane = tid & 63, wave = __builtin_amdgcn_readfirstlane(tid >> 6); (void)lane; (void)wave; unsigned char* ws = K->ws;
                pg8::Gemm g{(const bf16*)((unsigned char*)K->out + OUT_H16) + (size_t)half * MHALF * DM, WSP(bf16, layer ? WS_WUP1 : WS_WUP0), MHALF, DFF, DM, KV(4), 1, WTILED}; pg8::StaticOrder S; S.init(MHALF, DFF, G, (int)blockIdx.x);
                pg8::EpiSqRelu E{WSP(bf16, WS_HID + (size_t)half * HID_STRIDE), DFF};
                STAGGER();
#ifdef PROBE_EPINULL
                if (KV(8)) { pg8::EpiSqReluNS E0{WSP(bf16, WS_HID), DFF}; pg8::gemm_phase<pg8::EpiSqReluNS, pg8::StaticOrder, PG_ALIGN, PG_SP2>(lds, g, S, E0); } else
#endif
                pg8::gemm_phase<pg8::EpiSqRelu, pg8::StaticOrder, PG_ALIGN, PG_SP2>(lds, g, S, E);
            }
            SEAM(pb + 5 + 2 * half);
            if (PH(pb + 6 + 2 * half)) {
                KArgsP K = kargs(); const int tid = otid(), lane = tid & 63, wave = __builtin_amdgcn_readfirstlane(tid >> 6); (void)lane; (void)wave; unsigned char* ws = K->ws;
                pg8::Gemm g{WSP(bf16, WS_HID + (size_t)half * HID_STRIDE), WSP(bf16, layer ? WS_WDN1 : WS_WDN0), MHALF, DM, DFF, 0, 1, WTILED}; pg8::StaticOrder S; S.init(MHALF, DM, G, (int)blockIdx.x);
                bf16* h16 = (bf16*)((unsigned char*)K->out + OUT_H16);
                pg8::EpiResid<false, true> E{h16, layer ? WSP(bf16, WS_HFIN) : h16, WSP(float, WS_ROWSS2), half * MHALF, WSP(float, WS_ROWSS)};
                pg8::gemm_phase<pg8::EpiResid<false, true>, pg8::StaticOrder, PG_ALIGN, PG_SP2>(lds, g, S, E);
            }
            if (!HID_DB || half == MLP_SPLIT - 1) SEAM(pb + 6 + 2 * half);
        }
    }
#ifdef PROBE_WAIT
    float probe_scale = 1.f;
    if (PH(19)) { KArgsP K = kargs(); unsigned* acc = (unsigned*)(K->ws + WS_CTL) + 64;
        if (threadIdx.x == 0 && PROBE_PHASE == 99) MISC[20] = (unsigned)__builtin_amdgcn_s_memrealtime() - MISC[21];
        if (threadIdx.x == 0) atomicAdd(acc, MISC[20]);
        xcd_barrier(bar);
        const unsigned tot = __hip_atomic_load(acc, __ATOMIC_RELAXED, __HIP_MEMORY_SCOPE_AGENT);
        const float avg_us = (float)tot * 0.01f / (float)G;
        probe_scale = 1.f + sqrtf(avg_us * PROBE_WAIT_UNIT); }
#endif
#ifndef FINAL_REPS
#define FINAL_REPS 1
#endif
    if (PH(19)) for (int rep_ = 0; rep_ < FINAL_REPS; ++rep_) { KArgsP K = kargs(); const int tid = otid(), lane = tid & 63, wave = __builtin_amdgcn_readfirstlane(tid >> 6); (void)lane; (void)wave; unsigned char* ws = K->ws; phase_final_norm(WSP(bf16, WS_HFIN), K->out, K->in[19], WSP(float, WS_ROWSS2), G, wave, lane
#ifdef PROBE_WAIT
        , probe_scale
#endif
        ); }
#undef PH
#undef SEAM
#undef WSP
}

extern "C" void kernel_launch(void* const* d_in, const int* in_sizes, int n_in, void* d_out, int out_size, void* d_ws, size_t ws_size, hipStream_t stream) {
    static int grid = 0;
    if (grid == 0) {
        if (n_in != 20 || in_sizes[0] != MTOK * DM || out_size != MTOK * DM || ws_size < WS_END) {
            fprintf(stderr, "kernel_launch: unexpected problem (n_in %d, in0 %d, out %d, ws %zu; need ws >= %zu); nothing launched\n", n_in, n_in > 0 ? in_sizes[0] : -1, out_size, ws_size, (size_t)WS_END); grid = -1; return; }
        int dev = 0, cus = 0, per_cu = 0;
        if (hipGetDevice(&dev) != hipSuccess || hipDeviceGetAttribute(&cus, hipDeviceAttributeMultiprocessorCount, dev) != hipSuccess) { fprintf(stderr, "kernel_launch: device query failed\n"); grid = -1; return; }
        if (hipFuncSetAttribute((const void*)fwd, hipFuncAttributeMaxDynamicSharedMemorySize, LDS_BYTES) != hipSuccess) { fprintf(stderr, "kernel_launch: hipFuncSetAttribute failed\n"); grid = -1; return; }
        if (hipOccupancyMaxActiveBlocksPerMultiprocessor(&per_cu, (const void*)fwd, NWAVES * 64, LDS_BYTES) != hipSuccess || per_cu < 1)
            fprintf(stderr, "kernel_launch: note: occupancy query reports %d workgroups per CU\n", per_cu);
        (void)hipGetLastError();
        grid = cus;
    }
    if (grid < 0) return;
    if (hipMemsetAsync((char*)d_ws + WS_CTL, 0, CTL_ZERO_BYTES, stream) != hipSuccess) { fprintf(stderr, "kernel_launch: memset failed\n"); return; }
#ifdef PROBE_MEMSET2
    for (int r_ = 0; r_ < PROBE_MEMSET2; ++r_) (void)hipMemsetAsync((char*)d_ws + WS_CTL, 0, CTL_ZERO_BYTES, stream);
#endif
    Args a{};
    for (int i = 0; i < 20; ++i) a.in[i] = (const float*)d_in[i];
    a.out = (float*)d_out; a.ws = (unsigned char*)d_ws;
#if ONE_LAUNCH
    a.ph_lo = 0; a.ph_hi = N_PHASES;
    hipLaunchKernelGGL(fwd, dim3(grid), dim3(NWAVES * 64), LDS_BYTES, stream, a);
#else
#ifndef REPEAT_MASK
#define REPEAT_MASK 0u
#endif
#ifndef REPEAT_VARIANT
#define REPEAT_VARIANT 0
#endif
    for (int p = 0; p < N_PHASES; ++p) { a.ph_lo = p; a.ph_hi = p + 1;
        if ((REPEAT_MASK >> p) & 1u) { a.variant = REPEAT_VARIANT; hipLaunchKernelGGL(fwd, dim3(grid), dim3(NWAVES * 64), LDS_BYTES, stream, a); a.variant = 0; }
        hipLaunchKernelGGL(fwd, dim3(grid), dim3(NWAVES * 64), LDS_BYTES, stream, a); }
#endif
    const hipError_t le = hipPeekAtLastError();
    if (le != hipSuccess) fprintf(stderr, "kernel_launch: launch failed: %s\n", hipGetErrorName(le));
}
```
